# Optimizing an MI355X kernel written in HIP

```python
import math
import jax, jax.numpy as jnp
from jax import lax
import numpy as np

D_MODEL = 1024
BATCH = 4
SEQ = 8192
DEPTH = 2

GRID_W = 64
CTX_LEN = 256
EPS = 1e-6
ROPE_BASE = 10000.0
NEG_INF = -1e30
BLOCK_Q = 128

DA_HEADS = 4
DA_DIM = 64
RET_HEADS = 4
RET_QK = 64
RET_V = 128
RET_CHUNK = 128
DA_QK_W = DA_HEADS * 2 * DA_DIM
DA_V_W = DA_HEADS * 2 * DA_DIM
RET_QK_W = RET_HEADS * RET_QK
RET_V_W = RET_HEADS * RET_V
EVEN_WIDTHS = (DA_QK_W, DA_QK_W, DA_V_W, RET_QK_W, RET_QK_W, RET_V_W, RET_V_W)
EVEN_IN = DA_QK_W * 2 + DA_V_W + RET_QK_W * 2 + RET_V_W * 2
EVEN_OUT = DA_V_W + RET_V_W

SW_Q_HEADS = 16
SW_KV_HEADS = 2
SW_DIM = 64
WINDOW = 128
ODD_IN = (SW_Q_HEADS + 2 * SW_KV_HEADS) * SW_DIM
ODD_OUT = SW_Q_HEADS * SW_DIM

N_EXPERTS = 32
TOP_K = 4
D_FF = 1024
SWIGLU_ALPHA = 1.702
SWIGLU_LIMIT = 7.0
MOE_BLOCK = 128

kernel_name = 'hybrid_diffattn_retention_swa_moe_dit'


def rmsnorm(x, w):
    xf = x.astype(jnp.float32)
    y = xf * lax.rsqrt(jnp.mean(xf * xf, axis=-1, keepdims=True) + EPS)
    return (y * w.astype(jnp.float32)).astype(x.dtype)


def adaln(cvec, w, b):
    m = (jax.nn.silu(cvec) @ w + b)[..., None, :]
    return jnp.split(m, 6, axis=-1)


def axial_rope(x, row, col):
    hd = x.shape[-1]
    p = hd // 2
    f = p // 2
    inv = ROPE_BASE ** (-jnp.arange(f, dtype=jnp.float32) / f)
    xf = x.astype(jnp.float32)

    def rot(part, pos):
        ang = pos[:, None] * inv[None, :]
        cos = jnp.cos(ang)[:, None, :]
        sin = jnp.sin(ang)[:, None, :]
        a, b = part[..., :f], part[..., f:]
        return jnp.concatenate([a * cos - b * sin, a * sin + b * cos], axis=-1)

    out = jnp.concatenate([rot(xf[..., :p], row), rot(xf[..., p:], col)], axis=-1)
    return out.astype(x.dtype)


def split_heads(t, n_heads):
    B, N, _ = t.shape
    return t.reshape(B, N, n_heads, -1).transpose(0, 2, 1, 3)


def diff_attention(lat, ctx, lam, need_ctx):
    q, k, v = lat
    qc, kc, vc = ctx
    B, H, _, S, d = q.shape
    scale = d ** -0.5
    k_all = jnp.concatenate([kc, k], axis=3)
    v_all = jnp.concatenate([vc, v], axis=2)

    def attend(qb, keys, vals):
        s = jnp.einsum('bhcqd,bhckd->bhcqk', qb, keys).astype(jnp.float32) * scale
        p = jax.nn.softmax(s, axis=-1)
        a = p[:, :, 0] - lam * p[:, :, 1]
        return jnp.einsum('bhqk,bhke->bhqe', a.astype(vals.dtype), vals)

    nb = S // BLOCK_Q
    qb = jnp.moveaxis(q.reshape(B, H, 2, nb, BLOCK_Q, d), 3, 0)
    o = lax.map(lambda blk: attend(blk, k_all, v_all), qb)
    o_lat = jnp.moveaxis(o, 0, 2).reshape(B, H, S, 2 * d)
    o_ctx = attend(qc, kc, vc) if need_ctx else None
    return o_lat, o_ctx


def retention_chunkwise(q, k, v, log_gamma, state0):
    B, H, N, dk = q.shape
    dv = v.shape[-1]
    C = RET_CHUNK
    nc = N // C
    qc = q.reshape(B, H, nc, C, dk).astype(jnp.float32)
    kc = k.reshape(B, H, nc, C, dk).astype(jnp.float32)
    vc = v.reshape(B, H, nc, C, dv).astype(jnp.float32)
    i = jnp.arange(C, dtype=jnp.float32)
    lg = log_gamma[:, None, None]
    diff = i[:, None] - i[None, :]
    decay_in = jnp.where(diff >= 0, jnp.exp(lg * jnp.maximum(diff, 0.0)), 0.0)
    scores = jnp.einsum('bhnid,bhnjd->bhnij', qc, kc) * decay_in[:, None]
    inner = jnp.einsum('bhnij,bhnje->bhnie', scores, vc)
    k_dec = kc * jnp.exp(lg * (C - 1 - i))[..., None]
    chunk_kv = jnp.einsum('bhnjd,bhnje->nbhde', k_dec, vc)
    gamma_c = jnp.exp(log_gamma * C)[None, :, None, None]

    def step(state, kv):
        return gamma_c * state + kv, state

    final, prev_states = lax.scan(step, state0, chunk_kv)
    q_dec = qc * jnp.exp(lg * (i + 1))[..., None]
    cross = jnp.einsum('bhnid,nbhde->bhnie', q_dec, prev_states)
    return (inner + cross).reshape(B, H, N, dv), final


def bidir_retention(lat, ctx, decay_logit, need_ctx):
    q, k, v = lat
    qc, kc, vc = ctx
    B, H, _, dk = q.shape
    dv = v.shape[-1]
    log_gamma = jax.nn.log_sigmoid(decay_logit.astype(jnp.float32))
    zero = jnp.zeros((B, H, dk, dv), jnp.float32)
    flip = lambda t: t[:, :, ::-1]
    o_cf, s_f = retention_chunkwise(qc, kc, vc, log_gamma[0], zero)
    o_cb, s_b = retention_chunkwise(flip(qc), flip(kc), flip(vc), log_gamma[1], zero)
    o_lf, _ = retention_chunkwise(q, k, v, log_gamma[0], s_f)
    o_lb, _ = retention_chunkwise(flip(q), flip(k), flip(v), log_gamma[1], s_b)
    o_lat = (o_lf + flip(o_lb)).astype(v.dtype)
    o_ctx = (o_cf + flip(o_cb)).astype(v.dtype) if need_ctx else None
    return o_lat, o_ctx


def even_mixer(a_lat, a_ctx, w_in, w_out, lam_p, dnorm_w, decay_logit, rnorm_w, lam_init, row, col, need_ctx):
    cuts = np.cumsum(EVEN_WIDTHS)[:-1].tolist()

    def project(a, rope):
        B, N, _ = a.shape
        dq, dk, dv, rq, rk, rv, rg = jnp.split(a @ w_in, cuts, axis=-1)
        dq = dq.reshape(B, N, 2 * DA_HEADS, DA_DIM)
        dk = dk.reshape(B, N, 2 * DA_HEADS, DA_DIM)
        if rope:
            dq = axial_rope(dq, row, col)
            dk = axial_rope(dk, row, col)
        dq = dq.reshape(B, N, DA_HEADS, 2, DA_DIM).transpose(0, 2, 3, 1, 4)
        dk = dk.reshape(B, N, DA_HEADS, 2, DA_DIM).transpose(0, 2, 3, 1, 4)
        dv = split_heads(dv, DA_HEADS)
        rq = split_heads(rq, RET_HEADS) * (RET_QK ** -0.5)
        rk = split_heads(rk, RET_HEADS)
        rv = split_heads(rv, RET_HEADS)
        return (dq, dk, dv), (rq, rk, rv), rg

    da_lat, rt_lat, g_lat = project(a_lat, True)
    da_ctx, rt_ctx, g_ctx = project(a_ctx, False)
    lam = (jnp.exp(jnp.sum(lam_p[0] * lam_p[1])) - jnp.exp(jnp.sum(lam_p[2] * lam_p[3]))).astype(jnp.float32) + lam_init
    d_lat, d_ctx = diff_attention(da_lat, da_ctx, lam, need_ctx)
    r_lat, r_ctx = bidir_retention(rt_lat, rt_ctx, decay_logit, need_ctx)

    def finish(d, r, g):
        B, H, N, _ = d.shape
        d = rmsnorm(d, dnorm_w) * (1.0 - lam_init)
        r = rmsnorm(r, rnorm_w)
        d = d.transpose(0, 2, 1, 3).reshape(B, N, -1)
        r = r.transpose(0, 2, 1, 3).reshape(B, N, -1) * jax.nn.silu(g)
        return jnp.concatenate([d, r], axis=-1) @ w_out

    out_ctx = finish(d_ctx, r_ctx, g_ctx) if need_ctx else None
    return finish(d_lat, r_lat, g_lat), out_ctx


def window_attention(lat, ctx, sinks, need_ctx):
    q, k, v = lat
    qc, kc, vc = ctx
    B, Hkv, G, S, dh = q.shape
    scale = dh ** -0.5
    span = BLOCK_Q + 2 * WINDOW
    nb = S // BLOCK_Q
    pad = ((0, 0), (0, 0), (WINDOW, WINDOW), (0, 0))
    k_pad = jnp.pad(k, pad)
    v_pad = jnp.pad(v, pad)
    sink = sinks.astype(jnp.float32)[None, :, :, None, None]

    def softmax_with_sink(logits):
        full = jnp.concatenate([logits, jnp.broadcast_to(sink, logits.shape[:-1] + (1,))], axis=-1)
        return jax.nn.softmax(full, axis=-1)[..., :-1]

    def block(args):
        qb, n = args
        start = n * BLOCK_Q
        kb = lax.dynamic_slice_in_dim(k_pad, start, span, axis=2)
        vb = lax.dynamic_slice_in_dim(v_pad, start, span, axis=2)
        qpos = start + jnp.arange(BLOCK_Q)
        kpos = start - WINDOW + jnp.arange(span)
        valid = (jnp.abs(qpos[:, None] - kpos[None, :]) <= WINDOW) & (kpos >= 0) & (kpos < S)
        s_band = jnp.einsum('bhgqd,bhkd->bhgqk', qb, kb).astype(jnp.float32) * scale
        s_band = jnp.where(valid, s_band, NEG_INF)
        s_ctx = jnp.einsum('bhgqd,bhkd->bhgqk', qb, kc).astype(jnp.float32) * scale
        p = softmax_with_sink(jnp.concatenate([s_band, s_ctx], axis=-1)).astype(v.dtype)
        return (jnp.einsum('bhgqk,bhkd->bhgqd', p[..., :span], vb)
                + jnp.einsum('bhgqk,bhkd->bhgqd', p[..., span:], vc))

    qb = jnp.moveaxis(q.reshape(B, Hkv, G, nb, BLOCK_Q, dh), 3, 0)
    o = lax.map(block, (qb, jnp.arange(nb)))
    o_lat = jnp.moveaxis(o, 0, 3).reshape(B, Hkv, G, S, dh)
    o_ctx = None
    if need_ctx:
        s = jnp.einsum('bhgqd,bhkd->bhgqk', qc, kc).astype(jnp.float32) * scale
        o_ctx = jnp.einsum('bhgqk,bhkd->bhgqd', softmax_with_sink(s).astype(vc.dtype), vc)
    return o_lat, o_ctx


def odd_mixer(a_lat, a_ctx, w_qkv, w_out, sinks, row, col, need_ctx):
    G = SW_Q_HEADS // SW_KV_HEADS
    cuts = [SW_Q_HEADS * SW_DIM, (SW_Q_HEADS + SW_KV_HEADS) * SW_DIM]

    def project(a, rope):
        B, N, _ = a.shape
        q, k, v = jnp.split(a @ w_qkv, cuts, axis=-1)
        q = q.reshape(B, N, SW_Q_HEADS, SW_DIM)
        k = k.reshape(B, N, SW_KV_HEADS, SW_DIM)
        if rope:
            q = axial_rope(q, row, col)
            k = axial_rope(k, row, col)
        q = q.reshape(B, N, SW_KV_HEADS, G, SW_DIM).transpose(0, 2, 3, 1, 4)
        k = k.transpose(0, 2, 1, 3)
        v = split_heads(v, SW_KV_HEADS)
        return q, k, v

    o_lat, o_ctx = window_attention(project(a_lat, True), project(a_ctx, False),
                                    sinks.reshape(SW_KV_HEADS, G), need_ctx)

    def finish(o):
        B, _, _, N, _ = o.shape
        return o.transpose(0, 3, 1, 2, 4).reshape(B, N, -1) @ w_out

    return finish(o_lat), (finish(o_ctx) if need_ctx else None)


def moe(x, router_w, router_b, w1, b1, w2, b2):
    T, D = x.shape
    logits = (x @ router_w).astype(jnp.float32) + router_b.astype(jnp.float32)
    top_v, top_i = lax.top_k(logits, TOP_K)
    gate = jax.nn.softmax(top_v, axis=-1)
    M = T * TOP_K
    e_flat = top_i.reshape(M)
    tok_flat = jnp.repeat(jnp.arange(T, dtype=jnp.int32), TOP_K)
    order = jnp.argsort(e_flat)
    e_sorted = e_flat[order]
    counts = jnp.bincount(e_flat, length=N_EXPERTS)
    starts = jnp.cumsum(counts) - counts
    padded = ((counts + MOE_BLOCK - 1) // MOE_BLOCK) * MOE_BLOCK
    pad_ends = jnp.cumsum(padded)
    pad_starts = pad_ends - padded
    dest = pad_starts[e_sorted] + (jnp.arange(M) - starts[e_sorted])
    n_blocks = -(-M // MOE_BLOCK) + N_EXPERTS
    P = n_blocks * MOE_BLOCK
    src = jnp.full((P,), T, jnp.int32).at[dest].set(tok_flat[order])
    row_gate = jnp.zeros((P,), jnp.float32).at[dest].set(gate.reshape(M)[order])
    x_buf = jnp.concatenate([x, jnp.zeros((1, D), x.dtype)], axis=0)[src]
    block_expert = jnp.minimum(jnp.searchsorted(pad_ends, jnp.arange(n_blocks) * MOE_BLOCK, side='right'),
                               N_EXPERTS - 1)

    def expert_block(args):
        xb, e = args
        h = xb @ w1[e] + b1[e]
        glu = jnp.minimum(h[:, :D_FF], SWIGLU_LIMIT)
        lin = jnp.clip(h[:, D_FF:], -SWIGLU_LIMIT, SWIGLU_LIMIT)
        act = glu * jax.nn.sigmoid(SWIGLU_ALPHA * glu) * (lin + 1.0)
        return act @ w2[e] + b2[e]

    y_buf = lax.map(expert_block, (x_buf.reshape(n_blocks, MOE_BLOCK, D), block_expert))
    y = y_buf.reshape(P, D) * row_gate[:, None].astype(y_buf.dtype)
    return jax.ops.segment_sum(y, src, num_segments=T + 1)[:T]


def setup_inputs(seed: int = 0) -> dict:
    key = jax.random.key(seed)
    ks = list(jax.random.split(key, 32))
    n_even = (DEPTH + 1) // 2
    n_odd = DEPTH // 2

    def nrm(idx, shape, scale):
        return jax.random.normal(ks[idx], shape, jnp.float32) * scale

    g0 = 1.0 - 2.0 ** (-5.0 - np.arange(RET_HEADS))
    base_logit = jnp.asarray(np.log(g0 / (1.0 - g0)), jnp.float32)
    return {
        'x': nrm(0, (BATCH, SEQ, D_MODEL), 1.0),
        'c': nrm(1, (BATCH, D_MODEL), 1.0),
        'ctx': nrm(2, (BATCH, CTX_LEN, D_MODEL), 1.0),
        'c_ctx': nrm(3, (D_MODEL,), 1.0),
        'mod_w': nrm(4, (DEPTH, D_MODEL, 6 * D_MODEL), 0.5 * D_MODEL ** -0.5),
        'mod_b': nrm(5, (DEPTH, 6 * D_MODEL), 0.02),
        'norm1_w': 1.0 + nrm(6, (DEPTH, D_MODEL), 0.02),
        'norm2_w': 1.0 + nrm(7, (DEPTH, D_MODEL), 0.02),
        'even_w_in': nrm(8, (n_even, D_MODEL, EVEN_IN), D_MODEL ** -0.5),
        'even_w_out': nrm(9, (n_even, EVEN_OUT, D_MODEL), EVEN_OUT ** -0.5),
        'diff_lam': nrm(10, (n_even, 4, DA_DIM), 0.1),
        'diff_norm_w': 1.0 + nrm(11, (n_even, 2 * DA_DIM), 0.02),
        'ret_decay_logit': base_logit[None, None, :] + nrm(12, (n_even, 2, RET_HEADS), 0.05),
        'ret_norm_w': 1.0 + nrm(13, (n_even, RET_V), 0.02),
        'odd_w_qkv': nrm(14, (n_odd, D_MODEL, ODD_IN), D_MODEL ** -0.5),
        'odd_w_out': nrm(15, (n_odd, ODD_OUT, D_MODEL), ODD_OUT ** -0.5),
        'odd_sinks': nrm(16, (n_odd, SW_Q_HEADS), 0.5),
        'router_w': nrm(17, (DEPTH, D_MODEL, N_EXPERTS), D_MODEL ** -0.5),
        'router_b': nrm(18, (DEPTH, N_EXPERTS), 0.01),
        'moe_w1': nrm(19, (DEPTH, N_EXPERTS, D_MODEL, 2 * D_FF), D_MODEL ** -0.5),
        'moe_b1': nrm(20, (DEPTH, N_EXPERTS, 2 * D_FF), 0.01),
        'moe_w2': nrm(21, (DEPTH, N_EXPERTS, D_FF, D_MODEL), D_FF ** -0.5),
        'moe_b2': nrm(22, (DEPTH, N_EXPERTS, D_MODEL), 0.01),
        'final_norm_w': 1.0 + nrm(23, (D_MODEL,), 0.02),
    }


def reference(x, c, ctx, c_ctx, mod_w, mod_b, norm1_w, norm2_w,
              even_w_in, even_w_out, diff_lam, diff_norm_w, ret_decay_logit, ret_norm_w,
              odd_w_qkv, odd_w_out, odd_sinks,
              router_w, router_b, moe_w1, moe_b1, moe_w2, moe_b2, final_norm_w):
    B, S, D = x.shape
    L = ctx.shape[1]
    n_rows = S // GRID_W
    t = jnp.arange(n_rows * GRID_W)
    row = (t // GRID_W).astype(jnp.float32)
    col = (t % GRID_W).astype(jnp.float32)

    h_lat, h_ctx = x, ctx
    for layer in range(DEPTH):
        last = layer == DEPTH - 1
        sh1, sc1, g1, sh2, sc2, g2 = adaln(c, mod_w[layer], mod_b[layer])
        csh1, csc1, cg1, csh2, csc2, cg2 = adaln(c_ctx, mod_w[layer], mod_b[layer])
        a_lat = rmsnorm(h_lat, norm1_w[layer]) * (1.0 + sc1) + sh1
        a_ctx = rmsnorm(h_ctx, norm1_w[layer]) * (1.0 + csc1) + csh1
        if layer % 2 == 0:
            i = layer // 2
            lam_init = 0.8 - 0.6 * math.exp(-0.3 * layer)
            m_lat, m_ctx = even_mixer(a_lat, a_ctx, even_w_in[i], even_w_out[i], diff_lam[i], diff_norm_w[i],
                                      ret_decay_logit[i], ret_norm_w[i], lam_init, row, col, not last)
        else:
            i = layer // 2
            m_lat, m_ctx = odd_mixer(a_lat, a_ctx, odd_w_qkv[i], odd_w_out[i], odd_sinks[i], row, col, not last)
        h_lat = h_lat + g1 * m_lat
        f_lat = rmsnorm(h_lat, norm2_w[layer]) * (1.0 + sc2) + sh2
        if last:
            y = moe(f_lat.reshape(B * S, D), router_w[layer], router_b[layer],
                    moe_w1[layer], moe_b1[layer], moe_w2[layer], moe_b2[layer])
            h_lat = h_lat + g2 * y.reshape(B, S, D)
        else:
            h_ctx = h_ctx + cg1 * m_ctx
            f_ctx = rmsnorm(h_ctx, norm2_w[layer]) * (1.0 + csc2) + csh2
            tokens = jnp.concatenate([f_lat.reshape(B * S, D), f_ctx.reshape(B * L, D)], axis=0)
            y = moe(tokens, router_w[layer], router_b[layer],
                    moe_w1[layer], moe_b1[layer], moe_w2[layer], moe_b2[layer])
            h_lat = h_lat + g2 * y[:B * S].reshape(B, S, D)
            h_ctx = h_ctx + cg2 * y[B * S:].reshape(B, L, D)
    return rmsnorm(h_lat, final_norm_w)
```

```cpp
#include <hip/hip_runtime.h>
#include <hip/hip_bf16.h>
#include <cstdio>
#include <cstdint>

#ifndef ATTN_FP8PV
#define ATTN_FP8PV 1
#endif
#ifndef QKV1_FP8
#define QKV1_FP8 1
#endif
#ifndef RET_V2
#define RET_V2 1
#endif
#ifndef SWA_FP8
#define SWA_FP8 1
#endif
#ifndef ATTN_QK8
#define ATTN_QK8 1
#endif
#ifndef Y_FP8
#define Y_FP8 1
#endif
#ifndef ATTN_FASTEXP
#define ATTN_FASTEXP 1
#endif
#ifndef MK_ONE_LAUNCH
#define MK_ONE_LAUNCH 1
#endif

#define GAS __attribute__((address_space(1)))
#define LAS __attribute__((address_space(3)))
typedef unsigned short bf16;
typedef unsigned v4u __attribute__((ext_vector_type(4)));
typedef unsigned v2u __attribute__((ext_vector_type(2)));
typedef float f32x4 __attribute__((ext_vector_type(4)));
typedef float f32x2 __attribute__((ext_vector_type(2)));
typedef float f32x16 __attribute__((ext_vector_type(16)));
typedef short bf16x8 __attribute__((ext_vector_type(8)));
typedef short s16x4 __attribute__((ext_vector_type(4)));
typedef int v8i __attribute__((ext_vector_type(8)));
typedef int v4i __attribute__((ext_vector_type(4)));
typedef GAS unsigned gu32;
#define RLX_AGENT __ATOMIC_RELAXED, __HIP_MEMORY_SCOPE_AGENT
#define LDS_WAIT() asm volatile("s_waitcnt lgkmcnt(0)" ::: "memory")
#define VM_WAIT() asm volatile("s_waitcnt vmcnt(0)" ::: "memory")

constexpr int NB = 4, SEQ = 8192, CTXL = 256, D = 1024;
constexpr int RB = SEQ + CTXL;
constexpr int M = NB * RB;
constexpr int TPB = RB / 256;
constexpr int MT = M / 256;
constexpr int NEXP = 32, DFF = 1024;
constexpr int N_IN0 = 3072, N_QKV1 = 1280;
constexpr int NCH = RB / 128;
constexpr float EPS = 1e-6f;
constexpr float LOG2E = 1.4426950408889634f;
constexpr float C2 = 0.125f * LOG2E;
constexpr int C_DQ = 0, C_DK = 512, C_DV = 1024, C_RQ = 1536, C_RK = 1792, C_RV = 2048, C_RG = 2560;
constexpr int C_Q1 = 0, C_K1 = 1024, C_V1 = 1152;
constexpr int MOE_CAP_ROWS = 143360;
constexpr int LIST_CAP = M;

constexpr size_t MiB = 1u << 20;
constexpr size_t WS_CTL = 0, CTL_ZERO_BYTES = 1 * MiB;
constexpr size_t WS_MODP = 1 * MiB;
constexpr size_t WS_MOD = 5 * MiB;
constexpr size_t WS_LIST = 6 * MiB;
constexpr size_t WS_POS = 11 * MiB;
constexpr size_t WS_GATE = 12 * MiB;
constexpr size_t WS_WIN = 13 * MiB;
constexpr size_t WS_WOUT0 = 19 * MiB;
constexpr size_t WS_WQKV1 = 21 * MiB;
constexpr size_t WS_WOUT1 = 24 * MiB;
constexpr size_t WS_H = 26 * MiB;
constexpr size_t WS_A = 158 * MiB;
constexpr size_t WS_QKV = 224 * MiB;
constexpr size_t WS_OD = 422 * MiB;
constexpr size_t WS_CAT = 488 * MiB;
constexpr size_t WS_CKV = 554 * MiB;
constexpr size_t WS_PREV = 620 * MiB;
constexpr size_t WS_ACT = 653 * MiB;
constexpr size_t WS_QK8 = 820 * MiB;
constexpr size_t WS_RVT = 880 * MiB;
constexpr size_t WS_RKT = 914 * MiB;
constexpr size_t WS_K81 = 860 * MiB;
constexpr size_t WS_VT81 = 870 * MiB;
constexpr size_t WS_VT8 = 800 * MiB;
constexpr size_t WS_Y = 933 * MiB;
constexpr size_t WS_W1T = 1213 * MiB;
constexpr size_t WS_W2T = 1469 * MiB;
constexpr size_t WS_END = 1597 * MiB;
static_assert(WS_H + (size_t)M * D * 4 <= WS_A && WS_A + (size_t)M * D * 2 <= WS_QKV && WS_QKV + (size_t)M * 3072 * 2 <= WS_OD, "ws map");
static_assert(WS_ACT + (size_t)MOE_CAP_ROWS * 1024 * 2 <= WS_Y && WS_Y + (size_t)MOE_CAP_ROWS * 1024 * 2 <= WS_W1T, "ws map 2");
constexpr int CW_TMO = 0;
constexpr int CW_MODC = 6144;
constexpr int CW_CNT = 1024;
constexpr int CW_BAR = 8192;

constexpr int RING_BYTES = 131072;
constexpr int ROUTER_LDS = 1024 * 36 * 4;
constexpr int MISC_OFF = ROUTER_LDS;
constexpr int LDS_BYTES = MISC_OFF + 1024;
constexpr int MW_TST = 16, MW_CNT = 64, MW_LCNT = 96, MW_BASE = 128;
constexpr int TILE_E_OFF = 131072 + 4096;

__device__ __forceinline__ int lane_id() { const int l = (int)__builtin_amdgcn_mbcnt_hi(~0u, __builtin_amdgcn_mbcnt_lo(~0u, 0u)); __builtin_assume(l >= 0 && l < 64); return l; }
__device__ __forceinline__ unsigned f2bf(float f) { unsigned u = __builtin_bit_cast(unsigned, f); return (u + 0x7fffu + ((u >> 16) & 1u)) >> 16; }
__device__ __forceinline__ float bf2f(unsigned b) { return __builtin_bit_cast(float, b << 16); }
__device__ __forceinline__ unsigned pk2(float lo, float hi) { return f2bf(lo) | (f2bf(hi) << 16); }
__device__ __forceinline__ unsigned cvt_pk_bf16(float lo, float hi) { unsigned r; asm volatile("v_cvt_pk_bf16_f32 %0, %1, %2" : "=v"(r) : "v"(lo), "v"(hi)); return r; }
__device__ __forceinline__ f32x4 ld4bf(const bf16* p) { const v2u u = *(const GAS v2u*)p; return (f32x4){bf2f(u.x & 0xffffu), bf2f(u.x >> 16), bf2f(u.y & 0xffffu), bf2f(u.y >> 16)}; }
__device__ __forceinline__ void st4bf(bf16* p, f32x4 v) { v2u u; u.x = pk2(v.x, v.y); u.y = pk2(v.z, v.w); *(GAS v2u*)p = u; }
template <int X> __device__ __forceinline__ float dpp_xor(float x) {
    const int v = __float_as_int(x);
    if (X == 1) return __int_as_float(__builtin_amdgcn_update_dpp(v, v, 0xB1, 0xF, 0xF, false));
    if (X == 2) return __int_as_float(__builtin_amdgcn_update_dpp(v, v, 0x4E, 0xF, 0xF, false));
    if (X == 8) return __int_as_float(__builtin_amdgcn_update_dpp(v, v, 0x128, 0xF, 0xF, false));
    const int m = __builtin_amdgcn_update_dpp(v, v, 0x141, 0xF, 0xF, false);
    return __int_as_float(__builtin_amdgcn_update_dpp(m, m, 0x1B, 0xF, 0xF, false));
}
__device__ __forceinline__ float wave_sum(float v) {
    v += dpp_xor<1>(v); v += dpp_xor<2>(v); v += dpp_xor<4>(v); v += dpp_xor<8>(v);
    { const auto rr = __builtin_amdgcn_permlane16_swap(__float_as_uint(v), __float_as_uint(v), false, false); v = __uint_as_float(rr[0]) + __uint_as_float(rr[1]); }
    { const auto rr = __builtin_amdgcn_permlane32_swap(__float_as_uint(v), __float_as_uint(v), false, false); v = __uint_as_float(rr[0]) + __uint_as_float(rr[1]); }
    return v;
}
__device__ __forceinline__ int cvt4_fp8(float a, float b, float c, float d) {
    int w = 0;
    w = __builtin_amdgcn_cvt_pk_fp8_f32(__builtin_amdgcn_fmed3f(a, -448.f, 448.f), __builtin_amdgcn_fmed3f(b, -448.f, 448.f), w, false);
    w = __builtin_amdgcn_cvt_pk_fp8_f32(__builtin_amdgcn_fmed3f(c, -448.f, 448.f), __builtin_amdgcn_fmed3f(d, -448.f, 448.f), w, true);
    return w;
}
constexpr float W8_SCALE = 256.0f, W8_INV = 1.0f / 256.0f;
__device__ __forceinline__ float fast_exp2(float x) { return __builtin_amdgcn_exp2f(x); }
__device__ __forceinline__ float sigmoidf_(float x) { return __builtin_amdgcn_rcpf(1.0f + __builtin_amdgcn_exp2f(-1.4426950408889634f * x)); }

namespace pg8 {
constexpr int BM = 256, BK = 64, HALF = 128, HTB = HALF * BK * 2, STAGE_BYTES = 8 * HTB, NXCD = 8, WGM = 8, BIAS_LDS_OFF = STAGE_BYTES;
__host__ __device__ __forceinline__ int lds_byte(int r, int c) { const int st = (r >> 4) * 2 + (c >> 5), rr = r & 15, cc = c & 31, ob = rr * 64 + cc * 2; return st * 1024 + (ob ^ (((ob >> 9) & 1) << 5)); }
__host__ __device__ __forceinline__ void stage_rc(int b, int& R, int& C) { const int st = b / 1024, sb = b % 1024, swz = sb ^ (((sb >> 9) & 1) << 5); R = (st >> 1) * 16 + swz / 64; C = (st & 1) * 32 + (swz % 64) / 2; }
__host__ __device__ __forceinline__ int perm32(int rho) { const int n = rho >> 4, i = rho & 15; return 8 * (i >> 2) + 4 * n + (i & 3); }
struct Unit { int pm, pn, e; };

template <class P>
__device__ __forceinline__ void gemm_phase(LAS unsigned char* lds, const P& S, const int wid) {
    __builtin_assume(wid >= 0 && wid < 8);
    const int lane = lane_id(), tid = wid * 64 + lane, wr = wid >> 2, wc = wid & 3, fr = lane & 15, fq = lane >> 4;
    const int K = S.K, nt = K / BK;
    int R[2], C[2]; unsigned voffB[2];
#pragma unroll
    for (int i = 0; i < 2; ++i) { stage_rc(tid * 16 + i * 8192, R[i], C[i]); const int Rb = P::PERM ? ((R[i] & ~31) + perm32(R[i] & 31)) : R[i]; voffB[i] = (unsigned)(Rb * K + C[i]) * 2u; }
    const size_t kstep = (size_t)(BK * 2);
    const size_t hstep = (size_t)HALF * K * 2;
    const unsigned ldsw = (unsigned)wid * 1024u;
    const int aoff = lds_byte(wr * 64 + fr, fq * 8), boff = lds_byte(wc * 32 + fr, fq * 8);
#define PG8_SA(b, h) (((b) * 2 + (h)) * HTB)
#define PG8_SB(b, h) ((4 + (b) * 2 + (h)) * HTB)
#define PG8_STAGE(bufoff, gbase, voff) do { _Pragma("unroll") for (int _i = 0; _i < 2; ++_i) \
        __builtin_amdgcn_global_load_lds((const unsigned*)((const char*)(gbase) + (voff)[_i]), (LAS unsigned*)(lds + (bufoff) + ldsw + _i * 8192), 16, 0, 0); } while (0)
#define PG8_LD8(p) ({ const v4i lo_ = *(const LAS v4i*)(p), hi_ = *(const LAS v4i*)((p) + 1024); (v8i){lo_[0], lo_[1], lo_[2], lo_[3], hi_[0], hi_[1], hi_[2], hi_[3]}; })
#define PG8_LDA(dst, b, h) do { if constexpr (P::FP8) { _Pragma("unroll") for (int m = 0; m < 4; ++m) dst##8[m] = PG8_LD8(lds + PG8_SA(b, h) + aoff + m * 2048); } \
        else { _Pragma("unroll") for (int m = 0; m < 4; ++m) _Pragma("unroll") for (int k = 0; k < 2; ++k) dst[m][k] = *(const LAS bf16x8*)(lds + PG8_SA(b, h) + aoff + m * 2048 + k * 1024); } } while (0)
#define PG8_LDB(dst, b, h) do { if constexpr (P::FP8) { _Pragma("unroll") for (int n = 0; n < 2; ++n) dst##8[n] = PG8_LD8(lds + PG8_SB(b, h) + boff + n * 2048); } \
        else { _Pragma("unroll") for (int n = 0; n < 2; ++n) _Pragma("unroll") for (int k = 0; k < 2; ++k) dst[n][k] = *(const LAS bf16x8*)(lds + PG8_SB(b, h) + boff + n * 2048 + k * 1024); } } while (0)
#define PG8_MMA(ai, bj, At, Bt) do { __builtin_amdgcn_s_setprio(1); \
        if constexpr (P::FP8) { _Pragma("unroll") for (int m = 0; m < 4; ++m) _Pragma("unroll") for (int n = 0; n < 2; ++n) \
            asm volatile("v_mfma_f32_16x16x128_f8f6f4 %0, %1, %2, %0" : "+v"(acc[ai][bj][m][n]) : "v"(Bt##8[n]), "v"(At##8[m]), "v"(scale1)); } \
        else { _Pragma("unroll") for (int m = 0; m < 4; ++m) _Pragma("unroll") for (int n = 0; n < 2; ++n) _Pragma("unroll") for (int k = 0; k < 2; ++k) \
            acc[ai][bj][m][n] = __builtin_amdgcn_mfma_f32_16x16x32_bf16(Bt[n][k], At[m][k], acc[ai][bj][m][n], 0, 0, 0); } \
        __builtin_amdgcn_s_setprio(0); } while (0)
#define PG8_WAIT_V(n) asm volatile("s_waitcnt vmcnt(" #n ")" ::: "memory")
#define PG8_WAIT_L(n) asm volatile("s_waitcnt lgkmcnt(" #n ")" ::: "memory")
#define PG8_BAR __builtin_amdgcn_s_barrier()
#define PG8_SCHED __builtin_amdgcn_sched_barrier(0)
    Unit cur, nxt; int ui = 0;
    if (!S.next(0, cur)) return;
    f32x4 acc[2][2][4][2];
#pragma unroll
    for (int a = 0; a < 2; ++a)
#pragma unroll
        for (int b = 0; b < 2; ++b)
#pragma unroll
            for (int m = 0; m < 4; ++m)
#pragma unroll
                for (int n = 0; n < 2; ++n) acc[a][b][m][n] = (f32x4){0.f, 0.f, 0.f, 0.f};
    const int scale1 = 0x7F7F7F7F;
    bf16x8 At[4][2], B0[2][2], B1[2][2]; v8i At8[4], B08[2], B18[2];
    unsigned aoc[2][2], aon[2][2];
    S.a_offs(cur, R, C, aoc);
#pragma unroll
    for (int h = 0; h < 2; ++h)
#pragma unroll
        for (int i = 0; i < 2; ++i) aoc[h][i] = S.a_fix(aoc[h][i], C[i]);
    const char* Ab = S.a_base();
    const char* cB = S.b_base(cur);
    if constexpr (P::NBIAS > 0) { if (wid == 0) __builtin_amdgcn_global_load_lds((const unsigned*)S.bias_src(cur, lane), (LAS unsigned*)(lds + BIAS_LDS_OFF), 16, 0, 0); }
    PG8_STAGE(PG8_SB(0, 0), cB, voffB); PG8_STAGE(PG8_SB(0, 1), cB + hstep, voffB); PG8_STAGE(PG8_SA(0, 0), Ab, aoc[0]); PG8_STAGE(PG8_SA(0, 1), Ab, aoc[1]);
    if (wr == 1) PG8_BAR;
    PG8_WAIT_V(2); PG8_BAR;
    PG8_STAGE(PG8_SB(1, 0), cB + kstep, voffB); PG8_STAGE(PG8_SA(1, 0), Ab + kstep, aoc[0]); PG8_STAGE(PG8_SB(1, 1), cB + hstep + kstep, voffB);
    PG8_WAIT_V(6); PG8_BAR;
    for (;;) {
        const bool has_next = S.next(ui + 1, nxt);
        if (has_next) S.a_offs(nxt, R, C, aon);
        else { aon[0][0] = aoc[0][0]; aon[0][1] = aoc[0][1]; aon[1][0] = aoc[1][0]; aon[1][1] = aoc[1][1]; }
        if constexpr (P::NBIAS > 0) { if (has_next && wid == 0) __builtin_amdgcn_global_load_lds((const unsigned*)S.bias_src(nxt, lane), (LAS unsigned*)(lds + BIAS_LDS_OFF + ((ui + 1) % 3) * 1024), 16, 0, 0); }
        const char* nB = has_next ? S.b_base(nxt) : cB;
#pragma unroll 1
        for (int t = 0; t < nt; t += 2) {
            const bool last = (t == nt - 2);
            const char* a1 = Ab + (size_t)(t + 1) * kstep;
            const char* a2 = last ? Ab : Ab + (size_t)(t + 2) * kstep; const char* b2 = last ? nB : cB + (size_t)(t + 2) * kstep;
            const char* a3 = a2 + kstep; const char* b3 = b2 + kstep;
            unsigned o2[2][2];
            o2[0][0] = aoc[0][0]; o2[0][1] = aoc[0][1]; o2[1][0] = aoc[1][0]; o2[1][1] = aoc[1][1];
            if (last && has_next) {
#pragma unroll
                for (int h = 0; h < 2; ++h)
#pragma unroll
                    for (int i = 0; i < 2; ++i) { unsigned x = aon[h][i]; asm volatile("" : "+v"(x)); aon[h][i] = S.a_fix(x, C[i]); o2[h][i] = aon[h][i]; }
            }
            PG8_LDB(B0, 0, 0); PG8_LDB(B1, 0, 1); PG8_SCHED; PG8_LDA(At, 0, 0); PG8_STAGE(PG8_SA(1, 1), a1, aoc[1]);
            PG8_WAIT_V(8); PG8_WAIT_L(0); PG8_BAR; PG8_MMA(0, 0, At, B0); PG8_MMA(0, 1, At, B1); PG8_BAR; PG8_SCHED;
            PG8_LDA(At, 0, 1); PG8_STAGE(PG8_SB(0, 0), b2, voffB); PG8_STAGE(PG8_SB(0, 1), b2 + hstep, voffB); PG8_STAGE(PG8_SA(0, 0), a2, o2[0]);
            PG8_WAIT_V(8); PG8_WAIT_L(0); PG8_BAR; PG8_MMA(1, 0, At, B0); PG8_MMA(1, 1, At, B1); PG8_BAR; PG8_SCHED;
            PG8_LDB(B0, 1, 0); PG8_LDB(B1, 1, 1); PG8_SCHED; PG8_LDA(At, 1, 0); PG8_STAGE(PG8_SA(0, 1), a2, o2[1]);
            PG8_WAIT_V(8); PG8_WAIT_L(0); PG8_BAR; PG8_MMA(0, 0, At, B0); PG8_MMA(0, 1, At, B1); PG8_BAR; PG8_SCHED;
            PG8_LDA(At, 1, 1); PG8_STAGE(PG8_SB(1, 0), b3, voffB); PG8_STAGE(PG8_SB(1, 1), b3 + hstep, voffB); PG8_STAGE(PG8_SA(1, 0), a3, o2[0]);
            PG8_WAIT_V(8); PG8_WAIT_L(0); PG8_BAR; PG8_MMA(1, 0, At, B0); PG8_MMA(1, 1, At, B1); PG8_BAR; PG8_SCHED;
        }
        if (wr == 0) PG8_BAR;
        if constexpr (P::FP8) asm volatile("s_nop 15\n\ts_nop 15" ::: "memory");
        S.epi(acc, cur, wr, wc, fr, fq, (const LAS float*)(lds + BIAS_LDS_OFF + (ui % 3) * 1024));
        if (!has_next) break;
#pragma unroll
        for (int a = 0; a < 2; ++a)
#pragma unroll
            for (int b = 0; b < 2; ++b)
#pragma unroll
                for (int m = 0; m < 4; ++m)
#pragma unroll
                    for (int n = 0; n < 2; ++n) acc[a][b][m][n] = (f32x4){0.f, 0.f, 0.f, 0.f};
        cur = nxt; cB = nB; ++ui;
        aoc[0][0] = aon[0][0]; aoc[0][1] = aon[0][1]; aoc[1][0] = aon[1][0]; aoc[1][1] = aon[1][1];
        if (wr == 1) PG8_BAR;
    }
    PG8_WAIT_V(0);
    PG8_BAR;
#undef PG8_SA
#undef PG8_SB
#undef PG8_STAGE
#undef PG8_LDA
#undef PG8_LDB
#undef PG8_MMA
#undef PG8_WAIT_V
#undef PG8_WAIT_L
#undef PG8_BAR
#undef PG8_SCHED
}
}

namespace attn_body {
constexpr int NW = 8, QBLK = 32, QB = QBLK * NW, KVBLK = 64;
__device__ __forceinline__ int crow(int r, int hi) { return (r & 3) + 8 * (r >> 2) + 4 * hi; }
#define SBAR() __builtin_amdgcn_sched_barrier(0)
__device__ __forceinline__ void wmask(f32x16& p0, f32x16& p1, int dbase, int hi) {
    const float NEG = -INFINITY; const int kb = dbase + 4 * hi;
#pragma unroll
    for (int r = 0; r < 16; ++r) { const int d0 = kb + (r & 3) + 8 * (r >> 2); if (d0 > 128 || d0 < -128) p0[r] = NEG; const int d1 = d0 + 32; if (d1 > 128 || d1 < -128) p1[r] = NEG; }
}
constexpr int NSLOT = 3, SLOTB = 8192;
constexpr int LDS_K = 0, LDS_V = NSLOT * SLOTB, LDS_WS = 2 * NSLOT * SLOTB, LDS_OST = LDS_WS + NW * 64 * 4, LDS_BYTES = LDS_OST + NW * 4096;
__device__ __forceinline__ void glds16(const void* gsrc, unsigned lds_dst) { unsigned keep;
    asm volatile("s_mov_b32 %0, m0\n\ts_mov_b32 m0, %2\n\ts_nop 0\n\tglobal_load_lds_dwordx4 %1, off\n\ts_mov_b32 m0, %0" : "=&s"(keep) : "v"(gsrc), "s"(lds_dst) : "memory"); }
__device__ __forceinline__ float max3f(float a, float b, float c) { float r; asm("v_max3_f32 %0, %1, %2, %3" : "=v"(r) : "v"(a), "v"(b), "v"(c)); return r; }
__device__ __forceinline__ float max2f(float a, float b) { float r; asm("v_max_f32_e32 %0, %1, %2" : "=v"(r) : "v"(a), "v"(b)); return r; }
__device__ __forceinline__ float fadd_s(float a, float b) { float r; asm("v_add_f32_e32 %0, %1, %2" : "=v"(r) : "v"(a), "v"(b)); return r; }
__device__ __forceinline__ float fsub_s(float a, float b) { float r; asm("v_sub_f32_e32 %0, %1, %2" : "=v"(r) : "v"(a), "v"(b)); return r; }
typedef float f32x2_t __attribute__((ext_vector_type(2))); typedef __bf16 bf16x2_t __attribute__((ext_vector_type(2)));
__device__ __forceinline__ unsigned cvtpk_s(float lo, float hi) { f32x2_t v = {lo, hi}; bf16x2_t b = __builtin_convertvector(v, bf16x2_t); return __builtin_bit_cast(unsigned, b); }
#define WAIT_BAR(N) asm volatile("s_waitcnt vmcnt(" #N ") lgkmcnt(0)\n\ts_barrier" ::: "memory")

__device__ __forceinline__ void qkt(f32x16& p0, f32x16& p1, const char* Kslot, const bf16x8* qr, const f32x16& negm, int r32, int hi) {
    const char* kb = Kslot + hi * 1024 + r32 * 16;
#pragma unroll
    for (int d0 = 0; d0 < 4; ++d0) {
        const bf16x8 b0 = *reinterpret_cast<const bf16x8*>(kb + d0 * 2048);
        const bf16x8 b1 = *reinterpret_cast<const bf16x8*>(kb + d0 * 2048 + 512);
        if (d0 == 0) { p0 = __builtin_amdgcn_mfma_f32_32x32x16_bf16(b0, qr[0], negm, 0, 0, 0); p1 = __builtin_amdgcn_mfma_f32_32x32x16_bf16(b1, qr[0], negm, 0, 0, 0); }
        else { p0 = __builtin_amdgcn_mfma_f32_32x32x16_bf16(b0, qr[d0], p0, 0, 0, 0); p1 = __builtin_amdgcn_mfma_f32_32x32x16_bf16(b1, qr[d0], p1, 0, 0, 0); } }
}
typedef __attribute__((address_space(3))) const char* lds_cptr;
typedef short v4i16_t __attribute__((ext_vector_type(4)));
__device__ __forceinline__ void kload8(bf16x8* kf, lds_cptr kp) {
    kf[0] = *(const LAS bf16x8*)(kp);        kf[1] = *(const LAS bf16x8*)(kp + 512);
    kf[2] = *(const LAS bf16x8*)(kp + 2048); kf[3] = *(const LAS bf16x8*)(kp + 2560);
    kf[4] = *(const LAS bf16x8*)(kp + 4096); kf[5] = *(const LAS bf16x8*)(kp + 4608);
    kf[6] = *(const LAS bf16x8*)(kp + 6144); kf[7] = *(const LAS bf16x8*)(kp + 6656);
}
__device__ __forceinline__ void kload2(bf16x8* kf, lds_cptr kp, int j) { kf[2 * j] = *(const LAS bf16x8*)(kp + j * 2048); kf[2 * j + 1] = *(const LAS bf16x8*)(kp + j * 2048 + 512); }
__device__ __forceinline__ s16x4 vtr(lds_cptr p) { return __builtin_bit_cast(s16x4, __builtin_amdgcn_ds_read_tr16_b64_v4i16((LAS v4i16_t*)p)); }
__device__ __forceinline__ float rowmax(const f32x16& p0, const f32x16& p1) {
    float a = max3f(p0[0], p0[1], p1[0]), b = max3f(p0[2], p0[3], p1[1]); a = max3f(a, p1[2], p1[3]);
#pragma unroll
    for (int r = 4; r < 16; r += 4) { a = max3f(a, p0[r], p0[r + 1]); b = max3f(b, p0[r + 2], p0[r + 3]); a = max3f(a, p1[r], p1[r + 1]); b = max3f(b, p1[r + 2], p1[r + 3]); }
    const float m = max2f(a, b);
    auto rr = __builtin_amdgcn_permlane32_swap(__float_as_uint(m), __float_as_uint(m), false, false);
    return max2f(__uint_as_float(rr[0]), __uint_as_float(rr[1]));
}
__device__ __forceinline__ void pv(f32x16* o, int vb, bf16x8 pa0, bf16x8 pa1, bf16x8 pa2, bf16x8 pa3) {
#pragma unroll
    for (int d0 = 0; d0 < 2; ++d0) { s16x4 lo[4], hi[4];
#pragma unroll
        for (int ks = 0; ks < 4; ++ks) {
            asm volatile("ds_read_b64_tr_b16 %0,%1 offset:%c2" : "=&v"(lo[ks]) : "v"(vb), "i"(d0 * 4096 + ks * 1024) : "memory");
            asm volatile("ds_read_b64_tr_b16 %0,%1 offset:%c2" : "=&v"(hi[ks]) : "v"(vb), "i"(d0 * 4096 + ks * 1024 + 512) : "memory"); }
        asm volatile("s_waitcnt lgkmcnt(0)" ::: "memory"); SBAR();
#define PK(k) (bf16x8){lo[k][0], lo[k][1], lo[k][2], lo[k][3], hi[k][0], hi[k][1], hi[k][2], hi[k][3]}
        o[d0] = __builtin_amdgcn_mfma_f32_32x32x16_bf16(pa0, PK(0), o[d0], 0, 0, 0);
        o[d0] = __builtin_amdgcn_mfma_f32_32x32x16_bf16(pa1, PK(1), o[d0], 0, 0, 0);
        o[d0] = __builtin_amdgcn_mfma_f32_32x32x16_bf16(pa2, PK(2), o[d0], 0, 0, 0);
        o[d0] = __builtin_amdgcn_mfma_f32_32x32x16_bf16(pa3, PK(3), o[d0], 0, 0, 0);
#undef PK
    }
}

template <int PITCH, int OPITCH, bool SWA, int THRL>
__device__ __forceinline__ void attn_unit(const bf16* Q0, const bf16* __restrict__ Kh, const bf16* __restrict__ Vh, bf16* O0, int NT, int boff, int qrow0, float sinkl2, char* shm, const int wid) {
    const int lane = lane_id(), tid = wid * 64 + lane, r32 = lane & 31, hi = lane >> 5;
    const bf16* Qw = Q0 + (long)(wid * QBLK) * PITCH;
    const unsigned lds0 = (unsigned)(uintptr_t)shm;
    float* wsf = (float*)(shm + LDS_WS) + wid * 64;
    const bf16* ksrc = Kh + (long)lane * PITCH + wid * 8;
    const bf16* vsrc = Vh + (long)(16 * (wid & 3) + (lane >> 2)) * PITCH + (wid >> 2) * 32 + (lane & 3) * 8;
    const unsigned kdst = lds0 + LDS_K + wid * 1024, vdst = lds0 + LDS_V + wid * 1024;
#define TILE(t) (((t) < 4) ? (t) : ((t) + boff))
#define DMA_K(t, slot) glds16(ksrc + (long)TILE(t) * KVBLK * PITCH, (unsigned)__builtin_amdgcn_readfirstlane(kdst + (slot)))
#define DMA_V(t, slot) glds16(vsrc + (long)TILE(t) * KVBLK * PITCH, (unsigned)__builtin_amdgcn_readfirstlane(vdst + (slot)))
    const int vb0 = (int)(lds0 + LDS_V) + ((lane >> 4) & 1) * 32 + (lane & 3) * 8 + (4 * hi + ((lane & 15) >> 2)) * 64;
    const char* Kbase = shm + LDS_K; bf16x8 kf[8];
    const lds_cptr shm3 = (lds_cptr)shm; const lds_cptr kp0 = shm3 + LDS_K + hi * 1024 + r32 * 16; const lds_cptr vp0 = shm3 + LDS_V + ((lane >> 4) & 1) * 32 + (lane & 3) * 8 + (4 * hi + ((lane & 15) >> 2)) * 64;
    DMA_K(0, 0); DMA_V(0, 0); DMA_K(1, SLOTB);
    bf16x8 qr[4];
#pragma unroll
    for (int d0 = 0; d0 < 4; ++d0) qr[d0] = *reinterpret_cast<const bf16x8*>(&Qw[(long)r32 * PITCH + d0 * 16 + hi * 8]);
    float mhat = 0.f, l_reg = 0.f; f32x16 o[2]; o[0] = f32x16{}; o[1] = f32x16{}; f32x16 negm = f32x16{}; asm volatile("" : "+v"(negm));
    const int qrel = qrow0 + wid * QBLK + r32;
#define AMASK(P0, P1, t) do { if (SWA) { if ((t) >= 4) wmask(P0, P1, 64 * TILE(t) - qrel, hi); } } while (0)
    bool resc = false;
#define START(P0, P1) do { const float rm = rowmax(P0, P1); resc = false; \
    { const float dl = rm; mhat = fadd_s(mhat, dl); \
      _Pragma("unroll") for (int r = 0; r < 16; ++r) { P0[r] = fsub_s(P0[r], dl); P1[r] = fsub_s(P1[r], dl); } \
      _Pragma("unroll") for (int r = 0; r < 16; ++r) negm[r] = -mhat; asm volatile("" : "+v"(negm)); } \
    _Pragma("unroll") for (int r = 0; r < 16; ++r) P0[r] = __builtin_amdgcn_exp2f(P0[r]); } while (0)
#define RESC() do { if (resc) { asm volatile("s_waitcnt lgkmcnt(0)" ::: "memory"); \
      _Pragma("unroll") for (int d_ = 0; d_ < 2; ++d_) _Pragma("unroll") for (int r = 0; r < 16; ++r) o[d_][r] *= wsf[crow(r, hi)]; } } while (0)
    f32x16 pA0, pA1, pB0, pB1;
    int sl_prev = 0, sl_cur = 0, sl_next = SLOTB;
#define ROT() do { sl_prev = sl_cur; sl_cur = sl_next; sl_next = (sl_next == (NSLOT - 1) * SLOTB) ? 0 : sl_next + SLOTB; } while (0)
    DMA_K(2, 2 * SLOTB);
    WAIT_BAR(3);
    qkt(pA0, pA1, Kbase, qr, negm, r32, hi); asm volatile("s_nop 15\n\ts_nop 7" : "+v"(pA0), "+v"(pA1)); AMASK(pA0, pA1, 0);
    START(pA0, pA1);
    _Pragma("unroll") for (int r = 0; r < 16; ++r) pA1[r] = __builtin_amdgcn_exp2f(pA1[r]);
    WAIT_BAR(0);
    DMA_K(3, 0); DMA_V(1, SLOTB);
    ROT();
    kload8(kf, kp0 + sl_cur);
    WAIT_BAR(2);
    s16x4 vlo[8], vhi[8]; v4u pw0, pw1, pw2, pw3;
#define PKW(P, B) cvtpk_s(P[B], P[B + 1])
#define PAF(k) __builtin_bit_cast(bf16x8, pw##k)
#define VFR(i) (bf16x8){vlo[i][0], vlo[i][1], vlo[i][2], vlo[i][3], vhi[i][0], vhi[i][1], vhi[i][2], vhi[i][3]}
#define PIN(x) asm volatile("" : "+v"(x))
#define MX3(a, b, c) __builtin_fmaxf(__builtin_fmaxf((a), (b)), (c))
#define GAPA(MF, A0, A1, A2, A3, W0, W1, PW) do { MF; sacc += A0; sacc += A1; sacc += A2; sacc += A3; PIN(sacc); W0; W1; PIN(PW); SBAR(); } while (0)
#define EX(v) __builtin_amdgcn_exp2f(v)
#define GAPB(MF, X, B) do { MF; X[B] = EX(X[B]); X[B + 1] = EX(X[B + 1]); X[B + 2] = EX(X[B + 2]); X[B + 3] = EX(X[B + 3]); PIN(X); SBAR(); } while (0)
#define VRD(i) do { vlo[i] = vtr(vp_ + (((i) >> 2) * 4096 + ((i) & 3) * 1024)); vhi[i] = vtr(vp_ + (((i) >> 2) * 4096 + ((i) & 3) * 1024 + 512)); } while (0)
#define KRD(G, j) do { if (G) { kload2(kf, kp0 + sl_next, j); SBAR(); } } while (0)
#define STEP(C0, C1, P0, P1, t, GK, GV, GL) do { SBAR(); \
    const lds_cptr vp_ = vp0 + sl_prev; \
    VRD(0); SBAR(); float sacc = (P0[0] + P0[1]); \
    GAPA(C0 = __builtin_amdgcn_mfma_f32_32x32x16_bf16(kf[0], qr[0], negm, 0, 0, 0), P0[2], P0[3], P0[4], P0[5],     pw0[0] = PKW(P0, 0), pw0[1] = PKW(P0, 2), pw0); \
    VRD(4); SBAR(); GAPA(C1 = __builtin_amdgcn_mfma_f32_32x32x16_bf16(kf[1], qr[0], negm, 0, 0, 0), P0[6], P0[7], P0[8], P0[9],     pw0[2] = PKW(P0, 4), pw0[3] = PKW(P0, 6), pw0); \
    VRD(1); SBAR(); GAPA(C0 = __builtin_amdgcn_mfma_f32_32x32x16_bf16(kf[2], qr[1], C0, 0, 0, 0),   P0[10], P0[11], P0[12], P0[13], pw1[0] = PKW(P0, 8), pw1[1] = PKW(P0, 10), pw1); \
    VRD(5); SBAR(); GAPA(C1 = __builtin_amdgcn_mfma_f32_32x32x16_bf16(kf[3], qr[1], C1, 0, 0, 0),   P0[14], P0[15], P1[0], P1[1],   pw1[2] = PKW(P0, 12), pw1[3] = PKW(P0, 14), pw1); \
    VRD(2); SBAR(); GAPA(C0 = __builtin_amdgcn_mfma_f32_32x32x16_bf16(kf[4], qr[2], C0, 0, 0, 0),   P1[2], P1[3], P1[4], P1[5],     pw2[0] = PKW(P1, 0), pw2[1] = PKW(P1, 2), pw2); \
    VRD(6); SBAR(); GAPA(C1 = __builtin_amdgcn_mfma_f32_32x32x16_bf16(kf[5], qr[2], C1, 0, 0, 0),   P1[6], P1[7], P1[8], P1[9],     pw2[2] = PKW(P1, 4), pw2[3] = PKW(P1, 6), pw2); \
    VRD(3); SBAR(); GAPA(C0 = __builtin_amdgcn_mfma_f32_32x32x16_bf16(kf[6], qr[3], C0, 0, 0, 0),   P1[10], P1[11], P1[12], P1[13], pw3[0] = PKW(P1, 8), pw3[1] = PKW(P1, 10), pw3); \
    VRD(7); SBAR(); GAPA(C1 = __builtin_amdgcn_mfma_f32_32x32x16_bf16(kf[7], qr[3], C1, 0, 0, 0),   P1[14], P1[15], 0.f, 0.f,       pw3[2] = PKW(P1, 12), pw3[3] = PKW(P1, 14), pw3); \
    l_reg += sacc; \
    if (GK) { DMA_K((t) + 3, sl_cur); } if (GV) { DMA_V((t) + 1, sl_next); } \
    AMASK(C0, C1, t); \
    { float a = MX3(C0[0], C0[1], C1[0]), b = MX3(C0[2], C0[3], C1[1]); a = MX3(a, C1[2], C1[3]); \
      _Pragma("unroll") for (int r = 4; r < 16; r += 4) { a = MX3(a, C0[r], C0[r + 1]); b = MX3(b, C0[r + 2], C0[r + 3]); a = MX3(a, C1[r], C1[r + 1]); b = MX3(b, C1[r + 2], C1[r + 3]); } \
      float rm = __builtin_fmaxf(a, b); { auto rr = __builtin_amdgcn_permlane32_swap(__float_as_uint(rm), __float_as_uint(rm), false, false); rm = __builtin_fmaxf(__uint_as_float(rr[0]), __uint_as_float(rr[1])); } \
      resc = false; \
      if (__builtin_expect(__any(rm > (float)THRL), 0)) { const float dl = __builtin_fmaxf(rm, 0.f); mhat += dl; \
        _Pragma("unroll") for (int r = 0; r < 16; ++r) { C0[r] -= dl; C1[r] -= dl; } \
        _Pragma("unroll") for (int r = 0; r < 16; ++r) negm[r] = -mhat; asm volatile("" : "+v"(negm)); \
        const float f = __builtin_amdgcn_exp2f(-dl); l_reg *= f; if (hi == 0) wsf[r32] = f; resc = true; } } \
    SBAR(); \
    GAPB(o[0] = __builtin_amdgcn_mfma_f32_32x32x16_bf16(PAF(0), VFR(0), o[0], 0, 0, 0), C0, 0); \
    GAPB(o[1] = __builtin_amdgcn_mfma_f32_32x32x16_bf16(PAF(0), VFR(4), o[1], 0, 0, 0), C0, 4); \
    KRD(GL, 0); GAPB(o[0] = __builtin_amdgcn_mfma_f32_32x32x16_bf16(PAF(1), VFR(1), o[0], 0, 0, 0), C0, 8); \
    KRD(GL, 1); GAPB(o[1] = __builtin_amdgcn_mfma_f32_32x32x16_bf16(PAF(1), VFR(5), o[1], 0, 0, 0), C0, 12); \
    KRD(GL, 2); GAPB(o[0] = __builtin_amdgcn_mfma_f32_32x32x16_bf16(PAF(2), VFR(2), o[0], 0, 0, 0), C1, 0); \
    KRD(GL, 3); GAPB(o[1] = __builtin_amdgcn_mfma_f32_32x32x16_bf16(PAF(2), VFR(6), o[1], 0, 0, 0), C1, 4); \
    GAPB(o[0] = __builtin_amdgcn_mfma_f32_32x32x16_bf16(PAF(3), VFR(3), o[0], 0, 0, 0), C1, 8); \
    GAPB(o[1] = __builtin_amdgcn_mfma_f32_32x32x16_bf16(PAF(3), VFR(7), o[1], 0, 0, 0), C1, 12); \
    } while (0)
    int t = 1;
    for (; t + 5 < NT; t += 2) {
        STEP(pB0, pB1, pA0, pA1, t, true, true, true);     WAIT_BAR(2); RESC(); ROT();
        STEP(pA0, pA1, pB0, pB1, t + 1, true, true, true); WAIT_BAR(2); RESC(); ROT();
    }
#define ENDW(tt) do { if ((tt) + 3 < NT) { WAIT_BAR(2); } else if ((tt) + 2 < NT) { WAIT_BAR(1); } else { WAIT_BAR(0); } } while (0)
    for (; t + 1 < NT; t += 2) {
        STEP(pB0, pB1, pA0, pA1, t, (t + 3 < NT), (t + 1 < NT), (t + 1 < NT));       ENDW(t);     RESC(); ROT();
        STEP(pA0, pA1, pB0, pB1, t + 1, (t + 4 < NT), (t + 2 < NT), (t + 2 < NT));   ENDW(t + 1); RESC(); ROT();
    }
    STEP(pB0, pB1, pA0, pA1, NT - 1, false, false, false); RESC();
    { float sacc = pB0[0] + pB0[1]; _Pragma("unroll") for (int r = 2; r < 16; ++r) sacc += pB0[r]; _Pragma("unroll") for (int r = 0; r < 16; ++r) sacc += pB1[r]; l_reg += sacc;
      pw0 = (v4u){PKW(pB0, 0), PKW(pB0, 2), PKW(pB0, 4), PKW(pB0, 6)}; pw1 = (v4u){PKW(pB0, 8), PKW(pB0, 10), PKW(pB0, 12), PKW(pB0, 14)}; pw2 = (v4u){PKW(pB1, 0), PKW(pB1, 2), PKW(pB1, 4), PKW(pB1, 6)}; pw3 = (v4u){PKW(pB1, 8), PKW(pB1, 10), PKW(pB1, 12), PKW(pB1, 14)};
      SBAR(); pv(o, vb0 + sl_cur, PAF(0), PAF(1), PAF(2), PAF(3)); }
#undef PKW
#undef PAF
#undef VFR
#undef PIN
#undef MX3
#undef GAPA
#undef GAPB
#undef EX
#undef VRD
#undef KRD
#undef STEP
#undef ENDW
    { auto rr = __builtin_amdgcn_permlane32_swap(__float_as_uint(l_reg), __float_as_uint(l_reg), false, false); l_reg = __uint_as_float(rr[0]) + __uint_as_float(rr[1]); }
    if (SWA) l_reg += __builtin_amdgcn_exp2f(sinkl2 - mhat);
    if (hi == 0) wsf[32 + r32] = l_reg; asm volatile("s_waitcnt lgkmcnt(0)" ::: "memory");
    float rli[16];
#pragma unroll
    for (int r = 0; r < 16; ++r) rli[r] = __builtin_amdgcn_rcpf(wsf[32 + crow(r, hi)]);
    bf16* Ow = O0 + (long)(wid * QBLK) * OPITCH;
    { bf16* stg = (bf16*)(shm + LDS_OST) + wid * 2048;
#pragma unroll
      for (int r = 0; r < 16; ++r) { const int orow = crow(r, hi);
#pragma unroll
        for (int d0 = 0; d0 < 2; ++d0) stg[orow * 64 + d0 * 32 + r32] = (bf16)f2bf(o[d0][r] * rli[r]); }
      asm volatile("s_waitcnt lgkmcnt(0)" ::: "memory");
#pragma unroll
      for (int i = 0; i < 4; ++i) { const int row = i * 8 + (lane >> 3), ch = lane & 7; const v4u v = *(const v4u*)(stg + row * 64 + ch * 8); *(v4u*)(Ow + (long)row * OPITCH + ch * 8) = v; } }
    asm volatile("s_waitcnt lgkmcnt(0)\n\ts_barrier" ::: "memory");
#undef DMA_K
#undef DMA_V
#undef TILE
#undef AMASK
#undef START
#undef RESC
#undef ROT
}
#undef SBAR
#undef WAIT_BAR
}

namespace attn_dv {
constexpr int NW = 8, QBLK = 32, KVBLK = 64;
constexpr int SHM_V = KVBLK * 128 * 2, SHM_K = KVBLK * 64 * 2, SHM_ATTN = 2 * SHM_V + 2 * SHM_K + NW * 64 * 4;
constexpr float THR = 8.f;
#define KSWZ64(row, colB) ((row) * 128 + ((colB) ^ ((((row) >> 1) & 7) << 4)))
#define SBAR() __builtin_amdgcn_sched_barrier(0)
__device__ __forceinline__ int crow(int r, int hi) { return (r & 3) + 8 * (r >> 2) + 4 * hi; }
__device__ __forceinline__ unsigned cvtpk(float lo, float hi) { unsigned r; asm volatile("v_cvt_pk_bf16_f32 %0, %1, %2" : "=v"(r) : "v"(lo), "v"(hi)); return r; }
__device__ __forceinline__ void partialSM(f32x16& p0, f32x16& p1, float& m_reg, float& mn, float& alpha) {
    float pmax = p0[0];
#pragma unroll
    for (int r = 1; r < 16; ++r) pmax = fmaxf(pmax, p0[r]);
#pragma unroll
    for (int r = 0; r < 16; ++r) pmax = fmaxf(pmax, p1[r]);
    { auto rr = __builtin_amdgcn_permlane32_swap(__float_as_uint(pmax), __float_as_uint(pmax), false, false); pmax = fmaxf(__uint_as_float(rr[0]), __uint_as_float(rr[1])); }
    if (__builtin_expect(__all(pmax - m_reg <= THR), 1)) { mn = m_reg; alpha = 1.f; }
    else { mn = fmaxf(m_reg, pmax); alpha = __builtin_amdgcn_exp2f(m_reg - mn); m_reg = mn; }
#pragma unroll
    for (int r = 0; r < 16; ++r) p0[r] = p0[r] - mn;
#pragma unroll
    for (int r = 0; r < 16; ++r) p1[r] = p1[r] - mn;
#pragma unroll
    for (int r = 0; r < 16; ++r) p0[r] = __builtin_amdgcn_exp2f(p0[r]);
}
__device__ __forceinline__ void finishSM(f32x16& p0, f32x16& p1, float alpha, float& l_reg, bf16x8& pa0, bf16x8& pa1, bf16x8& pa2, bf16x8& pa3) {
#pragma unroll
    for (int r = 0; r < 16; ++r) p1[r] = __builtin_amdgcn_exp2f(p1[r]);
    float ps = 0;
#pragma unroll
    for (int r = 0; r < 16; ++r) ps += p0[r];
#pragma unroll
    for (int r = 0; r < 16; ++r) ps += p1[r];
    { auto rr = __builtin_amdgcn_permlane32_swap(__float_as_uint(ps), __float_as_uint(ps), false, false); ps = __uint_as_float(rr[0]) + __uint_as_float(rr[1]); }
    l_reg = l_reg * alpha + ps;
#define PK4(P, BASE, OUT) do { unsigned a0 = cvtpk(P[BASE + 0], P[BASE + 1]), a1 = cvtpk(P[BASE + 2], P[BASE + 3]);   \
    unsigned b0 = cvtpk(P[BASE + 4], P[BASE + 5]), b1 = cvtpk(P[BASE + 6], P[BASE + 7]);                              \
    auto r0 = __builtin_amdgcn_permlane32_swap(a0, b0, false, false); auto r1 = __builtin_amdgcn_permlane32_swap(a1, b1, false, false); \
    v4u w = {r0[0], r1[0], r0[1], r1[1]}; OUT = __builtin_bit_cast(bf16x8, w); } while (0)
    PK4(p0, 0, pa0); PK4(p0, 8, pa1); PK4(p1, 0, pa2); PK4(p1, 8, pa3);
#undef PK4
}
__device__ __forceinline__ void qkt(f32x16& p0, f32x16& p1, const char* Ks, const bf16x8* qr, int r32, int hi) {
    p0 = f32x16{}; p1 = f32x16{};
#pragma unroll
    for (int d0 = 0; d0 < 4; ++d0) { const int cb = (d0 * 16 + hi * 8) * 2;
        const bf16x8 b0 = *reinterpret_cast<const bf16x8*>(Ks + KSWZ64(r32, cb));
        const bf16x8 b1 = *reinterpret_cast<const bf16x8*>(Ks + KSWZ64(32 + r32, cb));
        p0 = __builtin_amdgcn_mfma_f32_32x32x16_bf16(b0, qr[d0], p0, 0, 0, 0);
        p1 = __builtin_amdgcn_mfma_f32_32x32x16_bf16(b1, qr[d0], p1, 0, 0, 0); }
}
__device__ __forceinline__ int v_st(int k, int c) { const int kk = (k & ~0xC) | ((k & 4) << 1) | ((k & 8) >> 1); return ((kk >> 3) * 4 + (c >> 5)) * 512 + ((kk & 7) * 32 + (c & 31)) * 2; }
__device__ __forceinline__ int v_rd_base(int lane) { return ((lane & 3) << 3) | (((lane >> 2) & 3) << 6) | (((lane >> 4) & 1) << 5) | (((lane >> 5) & 1) << 8); }
constexpr int v_rd_off(int d0, int ks, int half) { return d0 * 512 + ks * 4096 + half * 2048; }
template <int OFF> __device__ __forceinline__ s16x4 tr_read(int vb) { s16x4 r; asm volatile("ds_read_b64_tr_b16 %0, %1 offset:%2" : "=&v"(r) : "v"(vb), "i"(OFF) : "memory"); return r; }
template <int D0> __device__ __forceinline__ void pv_one(f32x16& od, int vb, bf16x8 pa0, bf16x8 pa1, bf16x8 pa2, bf16x8 pa3) {
    const s16x4 l0 = tr_read<v_rd_off(D0, 0, 0)>(vb), h0 = tr_read<v_rd_off(D0, 0, 1)>(vb), l1 = tr_read<v_rd_off(D0, 1, 0)>(vb), h1 = tr_read<v_rd_off(D0, 1, 1)>(vb);
    const s16x4 l2 = tr_read<v_rd_off(D0, 2, 0)>(vb), h2 = tr_read<v_rd_off(D0, 2, 1)>(vb), l3 = tr_read<v_rd_off(D0, 3, 0)>(vb), h3 = tr_read<v_rd_off(D0, 3, 1)>(vb);
    asm volatile("s_waitcnt lgkmcnt(0)" ::: "memory"); SBAR();
#define PK(L, H) (bf16x8){L[0], L[1], L[2], L[3], H[0], H[1], H[2], H[3]}
    od = __builtin_amdgcn_mfma_f32_32x32x16_bf16(pa0, PK(l0, h0), od, 0, 0, 0);
    od = __builtin_amdgcn_mfma_f32_32x32x16_bf16(pa1, PK(l1, h1), od, 0, 0, 0);
    od = __builtin_amdgcn_mfma_f32_32x32x16_bf16(pa2, PK(l2, h2), od, 0, 0, 0);
    od = __builtin_amdgcn_mfma_f32_32x32x16_bf16(pa3, PK(l3, h3), od, 0, 0, 0);
#undef PK
}
__device__ __forceinline__ void pv_d0(f32x16* o, int vb, bf16x8 pa0, bf16x8 pa1, bf16x8 pa2, bf16x8 pa3) {
    pv_one<0>(o[0], vb, pa0, pa1, pa2, pa3); pv_one<1>(o[1], vb, pa0, pa1, pa2, pa3); pv_one<2>(o[2], vb, pa0, pa1, pa2, pa3); pv_one<3>(o[3], vb, pa0, pa1, pa2, pa3);
}
constexpr int SHM_ATTN3 = 3 * SHM_V + 3 * SHM_K + NW * 64 * 4;
template <int LDP, int LDO>
__device__ __forceinline__ void attn_dense_body(const bf16* __restrict__ Qb, const bf16* __restrict__ Kh, const bf16* __restrict__ Vh, bf16* __restrict__ Ob, int seq, char* lds, const int wid) {
    const int lane = lane_id(), tid = wid * 64 + lane, r32 = lane & 31, hi = lane >> 5;
    char* V_lds = lds; char* K_lds = lds + 3 * SHM_V;
    float* ws = (float*)(lds + 3 * SHM_V + 3 * SHM_K) + wid * 64; float* li_l = ws; float* al_l = ws + 32;
    float m_reg = -1e30f, l_reg = 0; f32x16 o[4] = {}; bf16x8 qr[4];
    const bf16* Qw = Qb + (long)(wid * QBLK + r32) * LDP + hi * 8;
#pragma unroll
    for (int d0 = 0; d0 < 4; ++d0) qr[d0] = *reinterpret_cast<const bf16x8*>(Qw + d0 * 16);
    const int sr = tid >> 4, sc = (tid & 15) * 8, vst0 = v_st(sr, sc), vst1 = v_st(32 + sr, sc);
    const int kr = tid >> 3, kc = (tid & 7) * 8, kst = KSWZ64(kr, kc * 2);
    const int vb0 = (int)(uintptr_t)V_lds + v_rd_base(lane);
    bf16x8 vs0, vs1, ks0;
#define SLOAD(k0) do { vs0 = *reinterpret_cast<const bf16x8*>(&Vh[(long)((k0) + sr) * LDP + sc]); vs1 = *reinterpret_cast<const bf16x8*>(&Vh[(long)((k0) + 32 + sr) * LDP + sc]); \
    ks0 = *reinterpret_cast<const bf16x8*>(&Kh[(long)((k0) + kr) * LDP + kc]); } while (0)
#define SWRITE(s) do { *(bf16x8*)(V_lds + (s) * SHM_V + vst0) = vs0; *(bf16x8*)(V_lds + (s) * SHM_V + vst1) = vs1; *(bf16x8*)(K_lds + (s) * SHM_K + kst) = ks0; } while (0)
#define RESC(a) do { if (__any((a) < 1.f)) { if (hi == 0) al_l[r32] = (a); asm volatile("s_waitcnt lgkmcnt(0)" ::: "memory"); \
    _Pragma("unroll") for (int d = 0; d < 4; ++d) _Pragma("unroll") for (int r = 0; r < 16; ++r) o[d][r] *= al_l[crow(r, hi)]; } } while (0)
#define LBAR() do { asm volatile("s_waitcnt lgkmcnt(0)" ::: "memory"); __builtin_amdgcn_s_barrier(); asm volatile("" ::: "memory"); } while (0)
    f32x16 pA0, pA1, pB0, pB1; float mnA, mnB, alA, alB; bf16x8 pa0, pa1, pa2, pa3; const int NT = seq / KVBLK;
    int s0 = 0, s1 = 1, s2 = 2;
#define ROT3() do { const int t_ = s0; s0 = s1; s1 = s2; s2 = t_; } while (0)
    SLOAD(0); SWRITE(0); SLOAD(KVBLK); LBAR();
    qkt(pA0, pA1, K_lds, qr, r32, hi); partialSM(pA0, pA1, m_reg, mnA, alA);
    SWRITE(1); if (2 < NT) SLOAD(2 * KVBLK); LBAR();
#define STEP3(X0, X1, mnX, alX, Y0, Y1, alY, j) do { \
        if ((j) + 1 < NT) SWRITE(s2); SBAR(); \
        if ((j) + 2 < NT) SLOAD(((j) + 2) * KVBLK); SBAR(); \
        qkt(X0, X1, K_lds + s1 * SHM_K, qr, r32, hi); \
        finishSM(Y0, Y1, alY, l_reg, pa0, pa1, pa2, pa3); SBAR(); \
        pv_d0(o, vb0 + s0 * SHM_V, pa0, pa1, pa2, pa3); partialSM(X0, X1, m_reg, mnX, alX); \
        RESC(alX); LBAR(); ROT3(); } while (0)
    int j = 1;
    for (; j + 1 < NT; j += 2) {
        STEP3(pB0, pB1, mnB, alB, pA0, pA1, alA, j);
        STEP3(pA0, pA1, mnA, alA, pB0, pB1, alB, j + 1);
    }
    STEP3(pB0, pB1, mnB, alB, pA0, pA1, alA, NT - 1);
    finishSM(pB0, pB1, alB, l_reg, pa0, pa1, pa2, pa3); SBAR();
    pv_d0(o, vb0 + s0 * SHM_V, pa0, pa1, pa2, pa3);
    if (hi == 0) li_l[r32] = l_reg; asm volatile("s_waitcnt lgkmcnt(0)" ::: "memory");
    float rli[16];
#pragma unroll
    for (int r = 0; r < 16; ++r) rli[r] = __builtin_amdgcn_rcpf(li_l[crow(r, hi)]);
    bf16* Ow = Ob + (long)(wid * QBLK) * LDO;
#pragma unroll
    for (int r = 0; r < 16; ++r) { const int orow = crow(r, hi);
#pragma unroll
        for (int d0 = 0; d0 < 4; ++d0) Ow[(long)orow * LDO + d0 * 32 + r32] = (bf16)f2bf(o[d0][r] * rli[r]); }
    LBAR();
#undef SLOAD
#undef SWRITE
#undef RESC
#undef LBAR
#undef ROT3
#undef STEP3
}

constexpr int SHM_V8 = 128 * 80, SHM_ATTN8 = 3 * SHM_V8 + 3 * SHM_K + NW * 64 * 4;
__device__ __forceinline__ int cvt4_nc(float a, float b, float c, float d) { int w = 0; w = __builtin_amdgcn_cvt_pk_fp8_f32(a, b, w, false); w = __builtin_amdgcn_cvt_pk_fp8_f32(c, d, w, true); return w; }
__device__ __forceinline__ int vt8_slot(int ko) { const int k5 = ko & 31, hi = (k5 >> 2) & 1, r = (k5 & 3) + 4 * (k5 >> 3); return hi * 32 + (ko >> 5) * 16 + r; }
__device__ __forceinline__ void finishSM8(f32x16& p0, f32x16& p1, float alpha, float& l_reg, v8i& pa) {
#pragma unroll
    for (int r = 0; r < 16; ++r) p1[r] = __builtin_amdgcn_exp2f(p1[r]);
    float ps = 0;
#pragma unroll
    for (int r = 0; r < 16; ++r) ps += p0[r];
#pragma unroll
    for (int r = 0; r < 16; ++r) ps += p1[r];
    { auto rr = __builtin_amdgcn_permlane32_swap(__float_as_uint(ps), __float_as_uint(ps), false, false); ps = __uint_as_float(rr[0]) + __uint_as_float(rr[1]); }
    l_reg = l_reg * alpha + ps;
    pa = (v8i){cvt4_nc(p0[0], p0[1], p0[2], p0[3]), cvt4_nc(p0[4], p0[5], p0[6], p0[7]), cvt4_nc(p0[8], p0[9], p0[10], p0[11]), cvt4_nc(p0[12], p0[13], p0[14], p0[15]),
               cvt4_nc(p1[0], p1[1], p1[2], p1[3]), cvt4_nc(p1[4], p1[5], p1[6], p1[7]), cvt4_nc(p1[8], p1[9], p1[10], p1[11]), cvt4_nc(p1[12], p1[13], p1[14], p1[15])};
}
__device__ __forceinline__ void pv8(f32x16* o, const char* Vs, v8i pa, int r32, int hi, int scale1) {
    v8i vb[4];
#pragma unroll
    for (int d0 = 0; d0 < 4; ++d0) { const char* p = Vs + (d0 * 32 + r32) * 80 + hi * 32; const v4i lo = *reinterpret_cast<const v4i*>(p), hh = *reinterpret_cast<const v4i*>(p + 16);
        vb[d0] = (v8i){lo[0], lo[1], lo[2], lo[3], hh[0], hh[1], hh[2], hh[3]}; }
    asm volatile("s_waitcnt lgkmcnt(0)\n\ts_nop 3" ::: "memory"); SBAR();
#pragma unroll
    for (int d0 = 0; d0 < 4; ++d0)
        asm volatile("v_mfma_f32_32x32x64_f8f6f4 %0, %1, %2, %0" : "+v"(o[d0]) : "v"(pa), "v"(vb[d0]), "v"(scale1));
    SBAR();
}
template <int LDP, int LDO>
__device__ __forceinline__ void attn_dense_body8(const bf16* __restrict__ Qb, const bf16* __restrict__ Kh, const unsigned char* __restrict__ Vt, bf16* __restrict__ Ob, int seq, char* lds, const int wid) {
    const int lane = lane_id(), tid = wid * 64 + lane, r32 = lane & 31, hi = lane >> 5;
    char* V_lds = lds; char* K_lds = lds + 3 * SHM_V8;
    float* ws = (float*)(lds + 3 * SHM_V8 + 3 * SHM_K) + wid * 64; float* li_l = ws; float* al_l = ws + 32;
    float m_reg = -1e30f, l_reg = 0; f32x16 o[4] = {}; bf16x8 qr[4];
    const int scale1 = 0x7F7F7F7F;
    const bf16* Qw = Qb + (long)(wid * QBLK + r32) * LDP + hi * 8;
#pragma unroll
    for (int d0 = 0; d0 < 4; ++d0) qr[d0] = *reinterpret_cast<const bf16x8*>(Qw + d0 * 16);
    const int vcol = tid >> 2, vq = tid & 3, vst = vcol * 80 + vq * 16;
    const unsigned char* vsrc = Vt + (long)vcol * RB + vq * 16;
    const int kr = tid >> 3, kc = (tid & 7) * 8, kst = KSWZ64(kr, kc * 2);
    v4i vs0; bf16x8 ks0;
#define SLOAD(k0) do { vs0 = *reinterpret_cast<const v4i*>(vsrc + (k0)); ks0 = *reinterpret_cast<const bf16x8*>(&Kh[(long)((k0) + kr) * LDP + kc]); } while (0)
#define SWRITE(s) do { *(v4i*)(V_lds + (s) * SHM_V8 + vst) = vs0; *(bf16x8*)(K_lds + (s) * SHM_K + kst) = ks0; } while (0)
#define RESC(a) do { if (__any((a) < 1.f)) { if (hi == 0) al_l[r32] = (a); asm volatile("s_waitcnt lgkmcnt(0)" ::: "memory"); \
    _Pragma("unroll") for (int d = 0; d < 4; ++d) _Pragma("unroll") for (int r = 0; r < 16; ++r) o[d][r] *= al_l[crow(r, hi)]; } } while (0)
#define LBAR() do { asm volatile("s_waitcnt lgkmcnt(0)" ::: "memory"); __builtin_amdgcn_s_barrier(); asm volatile("" ::: "memory"); } while (0)
    f32x16 pA0, pA1, pB0, pB1; float mnA, mnB, alA, alB; v8i pa; const int NT = seq / KVBLK;
    int s0 = 0, s1 = 1, s2 = 2;
#define ROT3() do { const int t_ = s0; s0 = s1; s1 = s2; s2 = t_; } while (0)
    SLOAD(0); SWRITE(0); SLOAD(KVBLK); LBAR();
    qkt(pA0, pA1, K_lds, qr, r32, hi); partialSM(pA0, pA1, m_reg, mnA, alA);
    SWRITE(1); if (2 < NT) SLOAD(2 * KVBLK); LBAR();
#define STEP3(X0, X1, mnX, alX, Y0, Y1, alY, j) do { \
        if ((j) + 1 < NT) SWRITE(s2); SBAR(); \
        if ((j) + 2 < NT) SLOAD(((j) + 2) * KVBLK); SBAR(); \
        qkt(X0, X1, K_lds + s1 * SHM_K, qr, r32, hi); \
        finishSM8(Y0, Y1, alY, l_reg, pa); SBAR(); \
        pv8(o, V_lds + s0 * SHM_V8, pa, r32, hi, scale1); partialSM(X0, X1, m_reg, mnX, alX); \
        RESC(alX); LBAR(); ROT3(); } while (0)
    int j = 1;
    for (; j + 1 < NT; j += 2) {
        STEP3(pB0, pB1, mnB, alB, pA0, pA1, alA, j);
        STEP3(pA0, pA1, mnA, alA, pB0, pB1, alB, j + 1);
    }
    STEP3(pB0, pB1, mnB, alB, pA0, pA1, alA, NT - 1);
    finishSM8(pB0, pB1, alB, l_reg, pa); SBAR();
    pv8(o, V_lds + s0 * SHM_V8, pa, r32, hi, scale1);
    if (hi == 0) li_l[r32] = l_reg; asm volatile("s_waitcnt lgkmcnt(0)\n\ts_nop 15\n\ts_nop 15\n\ts_nop 15\n\ts_nop 15\n\ts_nop 15" ::: "memory");
    float rli[16];
#pragma unroll
    for (int r = 0; r < 16; ++r) rli[r] = __builtin_amdgcn_rcpf(li_l[crow(r, hi)]);
    bf16* Ow = Ob + (long)(wid * QBLK) * LDO;
#pragma unroll
    for (int r = 0; r < 16; ++r) { const int orow = crow(r, hi);
#pragma unroll
        for (int d0 = 0; d0 < 4; ++d0) Ow[(long)orow * LDO + d0 * 32 + r32] = (bf16)f2bf(o[d0][r] * rli[r]); }
    LBAR();
#undef SLOAD
#undef SWRITE
#undef RESC
#undef LBAR
#undef ROT3
#undef STEP3
}

__device__ __forceinline__ void pack8x(const f32x16& p0, const f32x16& p1, v8i& pa) {
    unsigned w[8];
#pragma unroll
    for (int g = 0; g < 4; ++g) { unsigned a = 0, b = 0;
#pragma unroll
        for (int i = 0; i < 4; ++i) { a = __builtin_amdgcn_cvt_pk_u8_f32(p0[4 * g + i], i, a); b = __builtin_amdgcn_cvt_pk_u8_f32(p1[4 * g + i], i, b); }
        w[g] = a; w[4 + g] = b; }
    pa = (v8i){(int)w[0], (int)w[1], (int)w[2], (int)w[3], (int)w[4], (int)w[5], (int)w[6], (int)w[7]};
}
template <int LDP, int LDO>
__device__ __forceinline__ void attn_dense_body8x(const bf16* __restrict__ Qb, const bf16* __restrict__ Kh, const unsigned char* __restrict__ Vt, bf16* __restrict__ Ob, int seq, char* lds, const int wid) {
    const int lane = lane_id(), tid = wid * 64 + lane, r32 = lane & 31, hi = lane >> 5;
    char* V_lds = lds; char* K_lds = lds + 3 * SHM_V8;
    float* ws = (float*)(lds + 3 * SHM_V8 + 3 * SHM_K) + wid * 64; float* al_l = ws + 32;
    f32x16 o[5] = {}; bf16x8 qr[4];
    f32x16 cvec; { _Pragma("unroll") for (int r = 0; r < 16; ++r) cvec[r] = 56.5f; }
    const int scale1 = 0x7F7F7F7F;
    const bf16* Qw = Qb + (long)(wid * QBLK + r32) * LDP + hi * 8;
#pragma unroll
    for (int d0 = 0; d0 < 4; ++d0) qr[d0] = *reinterpret_cast<const bf16x8*>(Qw + d0 * 16);
    const int vcol = tid >> 2, vq = tid & 3, vst = vcol * 80 + vq * 16;
    const unsigned char* vsrc = Vt + (long)vcol * RB + vq * 16;
    const int kr = tid >> 3, kc = (tid & 7) * 8, kst = KSWZ64(kr, kc * 2);
    v4i vs0; bf16x8 ks0;
#define SLOAD(k0) do { vs0 = *reinterpret_cast<const v4i*>(vsrc + (k0)); ks0 = *reinterpret_cast<const bf16x8*>(&Kh[(long)((k0) + kr) * LDP + kc]); } while (0)
#define SWRITE(s) do { *(v4i*)(V_lds + (s) * SHM_V8 + vst) = vs0; *(bf16x8*)(K_lds + (s) * SHM_K + kst) = ks0; } while (0)
#define RESC(a) do { if (__any((a) < 1.f)) { if (hi == 0) al_l[r32] = (a); asm volatile("s_waitcnt lgkmcnt(0)" ::: "memory"); \
    _Pragma("unroll") for (int d = 0; d < 5; ++d) _Pragma("unroll") for (int r = 0; r < 16; ++r) o[d][r] *= al_l[crow(r, hi)]; } } while (0)
#define LBAR() do { asm volatile("s_waitcnt lgkmcnt(0)" ::: "memory"); __builtin_amdgcn_s_barrier(); asm volatile("" ::: "memory"); } while (0)
#define REFUPD(X0, X1, alX, FIRST) do { float pmax_ = X0[0]; \
        _Pragma("unroll") for (int r = 1; r < 16; ++r) pmax_ = fmaxf(pmax_, X0[r]); \
        _Pragma("unroll") for (int r = 0; r < 16; ++r) pmax_ = fmaxf(pmax_, X1[r]); \
        { auto rr = __builtin_amdgcn_permlane32_swap(__float_as_uint(pmax_), __float_as_uint(pmax_), false, false); pmax_ = fmaxf(__uint_as_float(rr[0]), __uint_as_float(rr[1])); } \
        alX = 1.f; \
        if ((FIRST) || !__all(pmax_ <= 56.5f + 8.0f * THR)) { const float d8_ = (FIRST) ? pmax_ - 56.5f : fmaxf(pmax_ - 56.5f, 0.f); \
            _Pragma("unroll") for (int r = 0; r < 16; ++r) { X0[r] -= d8_; X1[r] -= d8_; cvec[r] -= d8_; } \
            alX = __builtin_amdgcn_exp2f(-0.125f * d8_); } } while (0)
#define PV5(Vs) do { v8i vb_[4]; \
        _Pragma("unroll") for (int d0 = 0; d0 < 4; ++d0) { const char* p_ = (Vs) + (d0 * 32 + r32) * 80 + hi * 32; const v4i lo_ = *reinterpret_cast<const v4i*>(p_), hh_ = *reinterpret_cast<const v4i*>(p_ + 16); \
            vb_[d0] = (v8i){lo_[0], lo_[1], lo_[2], lo_[3], hh_[0], hh_[1], hh_[2], hh_[3]}; } \
        asm volatile("s_waitcnt lgkmcnt(0)\n\ts_nop 3" ::: "memory"); SBAR(); \
        _Pragma("unroll") for (int d0 = 0; d0 < 4; ++d0) asm volatile("v_mfma_f32_32x32x64_f8f6f4 %0, %1, %2, %0" : "+v"(o[d0]) : "v"(pa), "v"(vb_[d0]), "v"(scale1)); \
        { int k38_ = 0x38383838; asm volatile("" : "+v"(k38_)); const v8i ones_ = {k38_, k38_, k38_, k38_, k38_, k38_, k38_, k38_};        \
          asm volatile("s_nop 1\n\tv_mfma_f32_32x32x64_f8f6f4 %0, %1, %2, %0" : "+v"(o[4]) : "v"(pa), "v"(ones_), "v"(scale1)); } SBAR(); } while (0)
    f32x16 pA0, pA1, pB0, pB1; float alA, alB; v8i pa; const int NT = seq / KVBLK;
    int s0 = 0, s1 = 1, s2 = 2;
#define ROT3() do { const int t_ = s0; s0 = s1; s1 = s2; s2 = t_; } while (0)
#define QKT8(P0, P1, Ks) do { const char* kb_ = (Ks); \
        _Pragma("unroll") for (int d0 = 0; d0 < 4; ++d0) { const int cb = (d0 * 16 + hi * 8) * 2; \
            const bf16x8 b0 = *reinterpret_cast<const bf16x8*>(kb_ + KSWZ64(r32, cb)); const bf16x8 b1 = *reinterpret_cast<const bf16x8*>(kb_ + KSWZ64(32 + r32, cb)); \
            if (d0 == 0) { P0 = __builtin_amdgcn_mfma_f32_32x32x16_bf16(b0, qr[0], cvec, 0, 0, 0); P1 = __builtin_amdgcn_mfma_f32_32x32x16_bf16(b1, qr[0], cvec, 0, 0, 0); } \
            else { P0 = __builtin_amdgcn_mfma_f32_32x32x16_bf16(b0, qr[d0], P0, 0, 0, 0); P1 = __builtin_amdgcn_mfma_f32_32x32x16_bf16(b1, qr[d0], P1, 0, 0, 0); } } } while (0)
    SLOAD(0); SWRITE(0); SLOAD(KVBLK); LBAR();
    QKT8(pA0, pA1, K_lds); REFUPD(pA0, pA1, alA, true);
    SWRITE(1); if (2 < NT) SLOAD(2 * KVBLK); LBAR();
#define STEP3(X0, X1, alX, Y0, Y1, j) do { \
        if ((j) + 1 < NT) SWRITE(s2); SBAR(); \
        if ((j) + 2 < NT) SLOAD(((j) + 2) * KVBLK); SBAR(); \
        QKT8(X0, X1, K_lds + s1 * SHM_K); \
        pack8x(Y0, Y1, pa); SBAR(); \
        PV5(V_lds + s0 * SHM_V8); \
        REFUPD(X0, X1, alX, false); \
        RESC(alX); LBAR(); ROT3(); } while (0)
    int j = 1;
    for (; j + 1 < NT; j += 2) {
        STEP3(pB0, pB1, alB, pA0, pA1, j);
        STEP3(pA0, pA1, alA, pB0, pB1, j + 1);
    }
    STEP3(pB0, pB1, alB, pA0, pA1, NT - 1);
    pack8x(pB0, pB1, pa); SBAR();
    PV5(V_lds + s0 * SHM_V8);
    asm volatile("s_nop 15\n\ts_nop 15\n\ts_nop 15\n\ts_nop 15\n\ts_nop 15\n\ts_nop 15" ::: "memory");
    asm volatile("" : "+v"(o[0]), "+v"(o[1]), "+v"(o[2]), "+v"(o[3]), "+v"(o[4]));
    bf16* Ow = Ob + (long)(wid * QBLK) * LDO;
#pragma unroll
    for (int r = 0; r < 16; ++r) { const int orow = crow(r, hi); const float rl = __builtin_amdgcn_rcpf(o[4][r]);
#pragma unroll
        for (int d0 = 0; d0 < 4; ++d0) Ow[(long)orow * LDO + d0 * 32 + r32] = (bf16)f2bf(o[d0][r] * rl); }
    LBAR();
#undef SLOAD
#undef SWRITE
#undef RESC
#undef LBAR
#undef REFUPD
#undef PV5
#undef QKT8
#undef ROT3
#undef STEP3
}
template <int N> struct VStage { typedef v4i T; };
template <> struct VStage<2> { typedef v2u T; };
template <int NDB, int KP, int LDO, bool SWA>
__device__ __forceinline__ void attn8(const unsigned char* __restrict__ Qb, const unsigned char* __restrict__ Kh, const unsigned char* __restrict__ Vt, bf16* __restrict__ Ob, const int NT, const int boff, const int qrow0, const float sinkl2, char* lds, const int wid) {
    const int lane = lane_id(), tid = wid * 64 + lane, r32 = lane & 31, hi = lane >> 5;
    constexpr int SHM_K8 = 64 * 80;
    constexpr int SHM_VT = 32 * NDB * 80;
    char* V_lds = lds; char* K_lds = lds + 4 * SHM_VT;
    float* ws = (float*)(lds + 4 * SHM_VT + 4 * SHM_K8) + wid * 64; float* al_l = ws + 32;
    f32x16 o[NDB + 1] = {}; v8i qf;
    f32x16 cvec; { _Pragma("unroll") for (int r = 0; r < 16; ++r) cvec[r] = 56.5f; }
    const int scale1 = 0x7F7F7F7F;
    { const unsigned char* Qw = Qb + (long)(wid * QBLK + r32) * 1024 + hi * 32; const v4i lo_ = *reinterpret_cast<const v4i*>(Qw), hh_ = *reinterpret_cast<const v4i*>(Qw + 16);
      qf = (v8i){lo_[0], lo_[1], lo_[2], lo_[3], hh_[0], hh_[1], hh_[2], hh_[3]}; }
    constexpr int VW = NDB * 4, VPR = 64 / VW;
    typedef typename VStage<NDB>::T vst_t;
    const int vcol = tid / VPR, vq = tid % VPR, vst = vcol * 80 + vq * VW;
    const unsigned char* vsrc = Vt + (long)vcol * RB + vq * VW;
    const int kr = tid >> 3, kst = kr * 80 + (tid & 7) * 8;
    const unsigned char* ksrc = Kh + (long)kr * KP + (tid & 7) * 8;
    vst_t vs0, vs1; v2u ks0, ks1;
#define TILE(t) (((t) < 4) ? (t) : ((t) + boff))
#define SLOADX(t, VS, KS) do { const int t_ = (t) < NT ? (t) : NT - 1; const int k0_ = TILE(t_) * KVBLK; VS = *reinterpret_cast<const vst_t*>(vsrc + k0_); KS = *reinterpret_cast<const v2u*>(ksrc + (long)k0_ * KP); } while (0)
#define SWRITEX(s, VS, KS) do { *(vst_t*)(V_lds + (s) * SHM_VT + vst) = VS; *(v2u*)(K_lds + (s) * SHM_K8 + kst) = KS; } while (0)
#define SLOAD(t) SLOADX(t, vs0, ks0)
#define SWRITE(s) SWRITEX(s, vs0, ks0)
#define RESC(a) do { if (__any((a) < 1.f)) { if (hi == 0) al_l[r32] = (a); asm volatile("s_waitcnt lgkmcnt(0)" ::: "memory"); \
    _Pragma("unroll") for (int d = 0; d < NDB + 1; ++d) _Pragma("unroll") for (int r = 0; r < 16; ++r) o[d][r] *= al_l[crow(r, hi)]; } } while (0)
#define LBAR() do { asm volatile("s_waitcnt lgkmcnt(0)" ::: "memory"); __builtin_amdgcn_s_barrier(); asm volatile("" ::: "memory"); } while (0)
#define REFUPD(X0, X1, alX, FIRST) do { float pmax_ = X0[0]; \
        _Pragma("unroll") for (int r = 1; r < 16; ++r) pmax_ = fmaxf(pmax_, X0[r]); \
        _Pragma("unroll") for (int r = 0; r < 16; ++r) pmax_ = fmaxf(pmax_, X1[r]); \
        { auto rr = __builtin_amdgcn_permlane32_swap(__float_as_uint(pmax_), __float_as_uint(pmax_), false, false); pmax_ = fmaxf(__uint_as_float(rr[0]), __uint_as_float(rr[1])); } \
        alX = 1.f; \
        if ((FIRST) || !__all(pmax_ <= 56.5f + 8.0f * THR)) { const float d8_ = (FIRST) ? pmax_ - 56.5f : fmaxf(pmax_ - 56.5f, 0.f); \
            _Pragma("unroll") for (int r = 0; r < 16; ++r) { X0[r] -= d8_; X1[r] -= d8_; cvec[r] -= d8_; } \
            alX = __builtin_amdgcn_exp2f(-0.125f * d8_); } } while (0)
    v8i vb[NDB], kf0, kf1;
#define VREAD(d0, Vs) do { const char* p_ = (Vs) + ((d0) * 32 + r32) * 80 + hi * 32; const v4i lo_ = *reinterpret_cast<const v4i*>(p_), hh_ = *reinterpret_cast<const v4i*>(p_ + 16); \
        vb[d0] = (v8i){lo_[0], lo_[1], lo_[2], lo_[3], hh_[0], hh_[1], hh_[2], hh_[3]}; } while (0)
#define KREAD(Ks) do { const char* kb_ = (Ks) + r32 * 80 + hi * 32; \
        const v4i a0_ = *reinterpret_cast<const v4i*>(kb_), a1_ = *reinterpret_cast<const v4i*>(kb_ + 16), b0_ = *reinterpret_cast<const v4i*>(kb_ + 32 * 80), b1_ = *reinterpret_cast<const v4i*>(kb_ + 32 * 80 + 16); \
        kf0 = (v8i){a0_[0], a0_[1], a0_[2], a0_[3], a1_[0], a1_[1], a1_[2], a1_[3]}; kf1 = (v8i){b0_[0], b0_[1], b0_[2], b0_[3], b1_[0], b1_[1], b1_[2], b1_[3]}; } while (0)
#define QKM(P0, P1) do { asm volatile("s_nop 1\n\tv_mfma_f32_32x32x64_f8f6f4 %0, %2, %4, %5\n\tv_mfma_f32_32x32x64_f8f6f4 %1, %3, %4, %5" \
                     : "=&v"(P0), "=&v"(P1) : "v"(kf0), "v"(kf1), "v"(qf), "v"(cvec), "v"(scale1)); SBAR(); } while (0)
#define PVM() do { asm volatile("s_nop 3" ::: "memory"); \
        _Pragma("unroll") for (int d0 = 0; d0 < NDB; ++d0) asm volatile("v_mfma_f32_32x32x64_f8f6f4 %0, %1, %2, %0" : "+v"(o[d0]) : "v"(pa), "v"(vb[d0]), "v"(scale1)); \
        { int k38_ = 0x38383838; asm volatile("" : "+v"(k38_)); const v8i ones_ = {k38_, k38_, k38_, k38_, k38_, k38_, k38_, k38_};        \
          asm volatile("s_nop 1\n\tv_mfma_f32_32x32x64_f8f6f4 %0, %1, %2, %0" : "+v"(o[NDB]) : "v"(pa), "v"(ones_), "v"(scale1)); } SBAR(); } while (0)
    f32x16 X0, X1; float al; v8i pa; unsigned pn[8];
    const int q0w = qrow0 + wid * QBLK, qrel = q0w + r32;
#define AMASK(X0, X1, t) do { if (SWA) { if ((t) >= 4) { const int kv0_ = 64 * TILE(t); if (!((kv0_ + 63 - q0w <= 128) && (q0w + 31 - kv0_ <= 128))) attn_body::wmask(X0, X1, kv0_ - qrel, hi); } } } while (0)
#define PVONE(d0) asm volatile("v_mfma_f32_32x32x64_f8f6f4 %0, %1, %2, %0" : "+v"(o[d0]) : "v"(pa), "v"(vb[d0]), "v"(scale1))
#define PVSUM() do { int k38_ = 0x38383838; asm volatile("" : "+v"(k38_)); const v8i ones_ = {k38_, k38_, k38_, k38_, k38_, k38_, k38_, k38_};        \
          asm volatile("s_nop 1\n\tv_mfma_f32_32x32x64_f8f6f4 %0, %1, %2, %0" : "+v"(o[NDB]) : "v"(pa), "v"(ones_), "v"(scale1)); } while (0)
#define PACKH(X, base) do { _Pragma("unroll") for (int g = 0; g < 4; ++g) { unsigned a_ = 0; _Pragma("unroll") for (int i = 0; i < 4; ++i) a_ = __builtin_amdgcn_cvt_pk_u8_f32(X[4 * g + i], i, a_); pn[(base) + g] = a_; } } while (0)
    int s0 = 0, s1 = 1, s2 = 2, s3 = 3;
#define ROT4() do { const int t_ = s0; s0 = s1; s1 = s2; s2 = s3; s3 = t_; } while (0)
    { vst_t vsA, vsB; v2u ksA, ksB;
      SLOADX(0, vs0, ks0); SLOADX(1, vsA, ksA); SLOADX(2, vsB, ksB); SBAR();
      SWRITEX(0, vs0, ks0); SWRITEX(1, vsA, ksA); SWRITEX(2, vsB, ksB); SBAR();
      SLOADX(3, vs0, ks0); SLOADX(4, vs1, ks1); LBAR(); }
    KREAD(K_lds); SBAR();
    QKM(X0, X1);
    KREAD(K_lds + SHM_K8); SBAR();
    asm volatile("s_nop 15\n\ts_nop 15\n\ts_nop 15\n\ts_nop 15\n\ts_nop 15\n\ts_nop 15\n\ts_nop 15\n\ts_nop 15\n\ts_nop 15" : "+v"(X0), "+v"(X1)); REFUPD(X0, X1, al, true);
    pack8x(X0, X1, pa); SBAR();
#define STEP5(j, VS, KS) do { \
        SBAR(); \
        _Pragma("unroll") for (int d0 = 0; d0 < NDB / 2; ++d0) VREAD(d0, V_lds + s0 * SHM_VT); \
        SBAR(); \
        SWRITEX(s3, VS, KS);                         \
        SBAR(); \
        SLOADX((j) + 4, VS, KS); \
        SBAR(); \
        QKM(X0, X1); \
        _Pragma("unroll") for (int d0 = NDB / 2; d0 < NDB; ++d0) VREAD(d0, V_lds + s0 * SHM_VT); \
        SBAR(); \
        asm volatile("s_nop 3" ::: "memory"); \
        _Pragma("unroll") for (int d0 = 0; d0 < NDB / 2; ++d0) PVONE(d0); \
        SBAR(); \
        if ((j) + 1 < NT) KREAD(K_lds + s2 * SHM_K8); \
        SBAR(); \
        AMASK(X0, X1, (j)); \
        float pmax_ = X0[0]; \
        _Pragma("unroll") for (int r = 1; r < 16; ++r) pmax_ = fmaxf(pmax_, X0[r]); \
        SBAR(); \
        PVONE(NDB / 2); \
        SBAR(); \
        _Pragma("unroll") for (int r = 0; r < 16; ++r) pmax_ = fmaxf(pmax_, X1[r]); \
        { auto rr = __builtin_amdgcn_permlane32_swap(__float_as_uint(pmax_), __float_as_uint(pmax_), false, false); pmax_ = fmaxf(__uint_as_float(rr[0]), __uint_as_float(rr[1])); } \
        al = 1.f; \
        if (!__all(pmax_ <= 56.5f + 8.0f * THR)) { const float d8_ = fmaxf(pmax_ - 56.5f, 0.f); \
            _Pragma("unroll") for (int r = 0; r < 16; ++r) { X0[r] -= d8_; X1[r] -= d8_; cvec[r] -= d8_; } \
            al = __builtin_amdgcn_exp2f(-0.125f * d8_); } \
        SBAR(); \
        if (NDB == 4) { PVONE(NDB - 1); SBAR(); } \
        PACKH(X0, 0); \
        asm volatile("" : "+v"(pn[0]), "+v"(pn[1]), "+v"(pn[2]), "+v"(pn[3])); \
        SBAR(); \
        PVSUM(); \
        SBAR(); \
        PACKH(X1, 4); \
        asm volatile("" : "+v"(pn[4]), "+v"(pn[5]), "+v"(pn[6]), "+v"(pn[7])); \
        SBAR(); \
        if (__any(al < 1.f)) { if (hi == 0) al_l[r32] = al; \
            asm volatile("s_nop 15\n\ts_nop 15\n\ts_nop 15\n\ts_nop 15\n\ts_nop 15\n\ts_nop 15\n\ts_nop 15\n\ts_nop 15\n\ts_waitcnt lgkmcnt(0)" ::: "memory"); \
            _Pragma("unroll") for (int d = 0; d < NDB + 1; ++d) asm volatile("" : "+v"(o[d])); \
            _Pragma("unroll") for (int d = 0; d < NDB + 1; ++d) _Pragma("unroll") for (int r = 0; r < 16; ++r) o[d][r] *= al_l[crow(r, hi)]; } \
        pa = (v8i){(int)pn[0], (int)pn[1], (int)pn[2], (int)pn[3], (int)pn[4], (int)pn[5], (int)pn[6], (int)pn[7]}; \
        LBAR(); ROT4(); \
    } while (0)
    { int j = 1;
      for (; j + 1 < NT; j += 2) { STEP5(j, vs0, ks0); STEP5(j + 1, vs1, ks1); }
      STEP5(NT - 1, vs0, ks0); }
    _Pragma("unroll") for (int d0 = 0; d0 < NDB; ++d0) VREAD(d0, V_lds + s0 * SHM_VT);
    SBAR();
    PVM();
    asm volatile("s_nop 15\n\ts_nop 15\n\ts_nop 15\n\ts_nop 15\n\ts_nop 15\n\ts_nop 15" ::: "memory");
    _Pragma("unroll") for (int d = 0; d < NDB + 1; ++d) asm volatile("" : "+v"(o[d]));
    if (SWA) { if (hi == 0) ws[r32] = sinkl2 - (56.5f - cvec[0]) * 0.125f; asm volatile("s_waitcnt lgkmcnt(0)" ::: "memory");
        _Pragma("unroll") for (int r = 0; r < 16; ++r) o[NDB][r] += __builtin_amdgcn_exp2f(ws[crow(r, hi)]); }
    bf16* Ow = Ob + (long)(wid * QBLK) * LDO;
#pragma unroll
    for (int r = 0; r < 16; ++r) { const int orow = crow(r, hi); const float rl = __builtin_amdgcn_rcpf(o[NDB][r]);
#pragma unroll
        for (int d0 = 0; d0 < NDB; ++d0) Ow[(long)orow * LDO + d0 * 32 + r32] = (bf16)f2bf(o[d0][r] * rl); }
    LBAR();
#undef SLOAD
#undef SLOADX
#undef TILE
#undef AMASK
#undef SWRITE
#undef SWRITEX
#undef RESC
#undef LBAR
#undef REFUPD
#undef PVM
#undef QKM
#undef VREAD
#undef KREAD
#undef ROT4
#undef PVONE
#undef STEP5
#undef PVSUM
#undef PACKH
}
#undef SBAR
#undef KSWZ64
}

#define XB_TMO      128
#define XB_XCNT(j)  (256  + 64 * (j))
#define XB_XSUB(j)  (1280 + 64 * (j))
#define XB_XGEN(j)  (2304 + 64 * (j))
#define XB_TOP      3328
#define XB_TOPGEN   3392
#define XCD_BAR_WORDS 3456
#define XB_SPIN_CAP (1u << 18)
__device__ __forceinline__ unsigned xb_ld(unsigned* p)              { return __hip_atomic_load(p, __ATOMIC_RELAXED, __HIP_MEMORY_SCOPE_AGENT); }
__device__ __forceinline__ unsigned xb_add(unsigned* p, unsigned v) { return __hip_atomic_fetch_add(p, v, __ATOMIC_RELAXED, __HIP_MEMORY_SCOPE_AGENT); }
__device__ __forceinline__ unsigned xb_xcc_id() { return (unsigned)__builtin_amdgcn_s_getreg((3 << 11) | 20) & 0xFu; }
#define XB_SPIN(cond, bar) do { unsigned _sp = 0; while (cond) { __builtin_amdgcn_s_sleep(1); \
    if ((++_sp & 255u) == 0u) { if (xb_ld(&(bar)[XB_TMO])) break; if (_sp > XB_SPIN_CAP) { atomicAdd(&(bar)[XB_TMO], 1u); break; } } } } while (0)
struct XcdBarrier { unsigned* bar; unsigned x; volatile LAS unsigned* st; int wave; };
__device__ __forceinline__ XcdBarrier xcd_barrier_post(unsigned* bar, volatile LAS unsigned* st) {
    XcdBarrier b; b.bar = bar; b.x = xb_xcc_id(); b.st = st; b.wave = 0;
    if (threadIdx.x == 0) (void)xb_add(&bar[XB_XCNT(b.x)], 1u);
    return b;
}
__device__ __forceinline__ void xcd_barrier_complete(unsigned* bar, unsigned x, unsigned& nloc, unsigned& nx) {
    const unsigned G = gridDim.x * gridDim.y * gridDim.z;
    unsigned sum, cnt, mine, sp = 0u;
    for (;;) {
        sum = 0u; cnt = 0u; mine = 0u;
#pragma unroll
        for (unsigned j = 0; j < 16; ++j) { const unsigned c = xb_ld(&bar[XB_XCNT(j)]); sum += c; cnt += (c > 0u) ? 1u : 0u; mine = (j == x) ? c : mine; }
        if (sum == G) break;
        __builtin_amdgcn_s_sleep(1);
        if ((++sp & 255u) == 0u) { if (xb_ld(&bar[XB_TMO])) break; if (sp > XB_SPIN_CAP) { atomicAdd(&bar[XB_TMO], 1u); break; } }
    }
    nloc = mine > 0u ? mine : 1u; nx = cnt > 0u ? cnt : 1u;
}
__device__ __forceinline__ void xcd_barrier(const XcdBarrier& b) {
    asm volatile("s_waitcnt vmcnt(0)" ::: "memory");
    __syncthreads();
    if (b.wave == 0 && lane_id() == 0) {
        unsigned* bar = b.bar;
        __builtin_amdgcn_s_waitcnt(0);
        unsigned nloc = b.st[0], nx = b.st[1];
        if (nloc == 0u) { xcd_barrier_complete(bar, b.x, nloc, nx); b.st[0] = nloc; b.st[1] = nx; }
        const unsigned old = xb_add(&bar[XB_XSUB(b.x)], 1u);
        const unsigned gen = old / nloc;
        if (old + 1u == (gen + 1u) * nloc) {
            __builtin_amdgcn_fence(__ATOMIC_RELEASE, "agent");
            asm volatile("s_waitcnt vmcnt(0)" ::: "memory");
            const unsigned og = xb_add(&bar[XB_TOP], 1u);
            const unsigned tg = og / nx;
            if (og + 1u == (tg + 1u) * nx) xb_add(&bar[XB_TOPGEN], 1u);
            else XB_SPIN(xb_ld(&bar[XB_TOPGEN]) == tg, bar);
            __builtin_amdgcn_fence(__ATOMIC_ACQUIRE, "agent");
            xb_add(&bar[XB_XGEN(b.x)], 1u);
            asm volatile("s_waitcnt vmcnt(0)" ::: "memory");
        } else {
            XB_SPIN(xb_ld(&bar[XB_XGEN(b.x)]) == gen, bar);
            __builtin_amdgcn_fence(__ATOMIC_ACQUIRE, "agent");
            asm volatile("s_waitcnt vmcnt(0)" ::: "memory");
        }
    }
    __syncthreads();
}

constexpr int NWAVES = 8;
struct Args { const float* in[24]; float* out; unsigned char* ws; int ph_lo, ph_hi; };
typedef __attribute__((address_space(4))) const Args* kargs_t;
__device__ __forceinline__ kargs_t kargs() { kargs_t p = (kargs_t)__builtin_amdgcn_kernarg_segment_ptr(); asm volatile("" : "+s"(p)); return p; }
struct Frame {
    LAS unsigned char* lds;
    volatile LAS unsigned* MISC;
    int tid, lane, wave;
    int vcu, G;
    __device__ __forceinline__ const float* in(int k) const { return kargs()->in[k]; }
    __device__ __forceinline__ unsigned char* ws() const { return kargs()->ws; }
    __device__ __forceinline__ gu32* ctl() const { return (gu32*)(ws() + WS_CTL); }
#define FIN(name, k) __device__ __forceinline__ const float* name() const { return in(k); }
    FIN(x, 0) FIN(c, 1) FIN(ctx, 2) FIN(c_ctx, 3) FIN(mod_w, 4) FIN(mod_b, 5) FIN(norm1_w, 6) FIN(norm2_w, 7) FIN(w_in, 8) FIN(w_out0, 9) FIN(diff_lam, 10) FIN(diff_norm_w, 11)
    FIN(ret_decay, 12) FIN(ret_norm_w, 13) FIN(w_qkv1, 14) FIN(w_out1, 15) FIN(sinks, 16) FIN(router_w, 17) FIN(router_b, 18) FIN(moe_w1, 19) FIN(moe_b1, 20) FIN(moe_w2, 21) FIN(moe_b2, 22) FIN(final_norm_w, 23)
#undef FIN
    __device__ __forceinline__ float* out() const { return kargs()->out; }
#define FWS(type, name, off) __device__ __forceinline__ type* name() const { return (type*)(ws() + off); }
    FWS(float, MODP, WS_MODP) FWS(float, MOD, WS_MOD) FWS(bf16, H, WS_H) FWS(float, GATE, WS_GATE) FWS(float, CKV, WS_CKV) FWS(int, LIST, WS_LIST) FWS(int, POS, WS_POS)
    FWS(bf16, WIN, WS_WIN) FWS(bf16, WOUT0, WS_WOUT0) FWS(bf16, WQKV1, WS_WQKV1) FWS(bf16, WOUT1, WS_WOUT1) FWS(bf16, A, WS_A) FWS(bf16, QKV, WS_QKV) FWS(bf16, OD, WS_OD) FWS(bf16, CAT, WS_CAT)
    FWS(bf16, RVT, WS_RVT) FWS(bf16, RKT, WS_RKT) FWS(unsigned char, K81, WS_K81) FWS(unsigned char, VT81, WS_VT81) FWS(unsigned char, QK8, WS_QK8) FWS(unsigned char, VT8, WS_VT8) FWS(bf16, PREV, WS_PREV) FWS(bf16, ACT, WS_ACT) FWS(bf16, Y, WS_Y) FWS(bf16, W1T, WS_W1T) FWS(bf16, W2T, WS_W2T)
#undef FWS
};
__device__ __forceinline__ void phase_ids(Frame& F) { int l = lane_id(); asm volatile("" : "+v"(l)); F.lane = l; F.tid = F.wave * 64 + l; }
__device__ __forceinline__ int row_v(int r) { const int b = r / RB; return (r - b * RB) < CTXL ? 4 : b; }

__device__ __forceinline__ void p0_transpose_item(const float* W, int N, int K, bf16* wt_row0, float scale, LAS float* scr, int k0, int n0, int lane) {
    float v[32];
#pragma unroll
    for (int i = 0; i < 32; ++i) { const int kk = 2 * i + (lane >> 5); v[i] = W[(size_t)(k0 + kk) * N + n0 + (lane & 31)]; }
#pragma unroll
    for (int i = 0; i < 32; ++i) { const int kk = 2 * i + (lane >> 5); scr[kk * 33 + (lane & 31)] = v[i] * scale; }
    LDS_WAIT(); asm volatile("" ::: "memory");
    const int c = lane & 7;
#pragma unroll
    for (int j = 0; j < 4; ++j) { const int n = (lane >> 3) + 8 * j; const LAS float* s = scr + (8 * c) * 33 + n;
        v4u o; o.x = pk2(s[0 * 33], s[1 * 33]); o.y = pk2(s[2 * 33], s[3 * 33]); o.z = pk2(s[4 * 33], s[5 * 33]); o.w = pk2(s[6 * 33], s[7 * 33]);
        *(GAS v4u*)(wt_row0 + (size_t)n * K + k0 + 8 * c) = o; }
    LDS_WAIT(); asm volatile("" ::: "memory");
}
__device__ __forceinline__ void p0_transpose_item8(const float* W, int N, int K, unsigned char* wt_row0, float scale, LAS float* scr, int k0, int n0, int lane) {
    float v[32];
#pragma unroll
    for (int i = 0; i < 32; ++i) { const int kk = 2 * i + (lane >> 5); v[i] = W[(size_t)(k0 + kk) * N + n0 + (lane & 31)]; }
#pragma unroll
    for (int i = 0; i < 32; ++i) { const int kk = 2 * i + (lane >> 5); scr[kk * 33 + (lane & 31)] = v[i] * scale; }
    LDS_WAIT(); asm volatile("" ::: "memory");
    const int c = lane & 7;
#pragma unroll
    for (int j = 0; j < 4; ++j) { const int n = (lane >> 3) + 8 * j; const LAS float* s = scr + (8 * c) * 33 + n;
        v2u o; o.x = (unsigned)cvt4_fp8(s[0 * 33], s[1 * 33], s[2 * 33], s[3 * 33]); o.y = (unsigned)cvt4_fp8(s[4 * 33], s[5 * 33], s[6 * 33], s[7 * 33]);
        *(GAS v2u*)(wt_row0 + (size_t)n * K + k0 + 8 * c) = o; }
    LDS_WAIT(); asm volatile("" ::: "memory");
}
__device__ __forceinline__ void p0_prologue(Frame& F) {
    {
        LAS float* sl = (LAS float*)F.lds;
        const float* cvec = F.c(); const float* cctx = F.c_ctx(); const float* modw = F.mod_w(); float* MODPp = F.MODP(); gu32* ctlp = F.ctl(); const float* modb = F.mod_b(); float* MODo = F.MOD();
        for (int it = blockIdx.x; it < 2 * 16 * 12; it += F.G) {
            const int nc = it % 12, kc = (it / 12) % 16, l = it / (12 * 16);
            __syncthreads();
            if (F.tid < 320) { const int v = F.tid / 64, k = kc * 64 + (F.tid & 63); const float cv = (v < 4) ? cvec[v * D + k] : cctx[k]; sl[F.tid] = cv * sigmoidf_(cv); }
            __syncthreads();
            const int n = nc * 512 + F.tid;
            const float* wp = modw + ((size_t)l * D + kc * 64) * 6144 + n;
            float a0 = 0.f, a1 = 0.f, a2 = 0.f, a3 = 0.f, a4 = 0.f;
#pragma unroll 16
            for (int k = 0; k < 64; ++k) { const float w = wp[(size_t)k * 6144]; a0 += sl[k] * w; a1 += sl[64 + k] * w; a2 += sl[128 + k] * w; a3 += sl[192 + k] * w; a4 += sl[256 + k] * w; }
            float* o = MODPp + ((size_t)(kc * 2 + l) * 5) * 6144 + n;
            o[0] = a0; o[6144] = a1; o[2 * 6144] = a2; o[3 * 6144] = a3; o[4 * 6144] = a4;
        }
        __syncthreads();
    }
    const int gw = F.vcu * NWAVES + F.wave, NGW = F.G * NWAVES;
    LAS float* scr = (LAS float*)(F.lds + F.wave * 16384);
    constexpr int I_IN = 16 * (N_IN0 / 32), I_O = 16 * 32, I_QKV = 16 * (N_QKV1 / 32);
    constexpr int I_SMALL = I_IN + I_O + I_QKV + I_O;
    constexpr int I_W1 = 16 * 64, I_W2 = 16 * 32, I_EXP = I_W1 + I_W2;
    constexpr int NITEMS = I_SMALL + 2 * NEXP * I_EXP;
    for (int it = gw; it < NITEMS; it += NGW) {
        int r = it;
        if (r < I_IN) { const int nb = r % (N_IN0 / 32), kb = r / (N_IN0 / 32), n0 = nb * 32; const float sc = (n0 < 512) ? C2 * (ATTN_FASTEXP ? 8.0f : 1.0f) : ((n0 >= C_RQ && n0 < C_RK) ? 0.125f : 1.0f);
            p0_transpose_item(F.w_in(), N_IN0, D, F.WIN() + (size_t)n0 * D, sc, scr, kb * 64, n0, F.lane); continue; } r -= I_IN;
        if (r < I_O) { const int nb = r % 32, kb = r / 32; p0_transpose_item(F.w_out0(), D, D, F.WOUT0() + (size_t)nb * 32 * D, 1.0f, scr, kb * 64, nb * 32, F.lane); continue; } r -= I_O;
        if (r < I_QKV) { const int nb = r % (N_QKV1 / 32), kb = r / (N_QKV1 / 32), n0 = nb * 32; const float sc = (n0 < 1024) ? C2 * (SWA_FP8 ? 8.0f : 1.0f) : 1.0f;
            if (QKV1_FP8) p0_transpose_item8(F.w_qkv1(), N_QKV1, D, (unsigned char*)F.WQKV1() + (size_t)n0 * D, sc * W8_SCALE, scr, kb * 64, n0, F.lane);
            else p0_transpose_item(F.w_qkv1(), N_QKV1, D, F.WQKV1() + (size_t)n0 * D, sc, scr, kb * 64, n0, F.lane); continue; } r -= I_QKV;
        if (r < I_O) { const int nb = r % 32, kb = r / 32; p0_transpose_item(F.w_out1(), D, D, F.WOUT1() + (size_t)nb * 32 * D, 1.0f, scr, kb * 64, nb * 32, F.lane); continue; } r -= I_O;
        const int le = r / I_EXP; r -= le * I_EXP;
        if (r < I_W1) { const int nb = r % 64, kb = r / 64, n0 = nb * 32;
            const int nn = n0 & 1023, drow = (nn >> 7) * 256 + (n0 >= 1024 ? 128 : 0) + (nn & 127);
            p0_transpose_item8(F.moe_w1() + (size_t)le * D * 2048, 2048, D, (unsigned char*)F.W1T() + ((size_t)le * 2048 + drow) * D, W8_SCALE, scr, kb * 64, n0, F.lane); continue; } r -= I_W1;
        { const int nb = r % 32, kb = r / 32; p0_transpose_item8(F.moe_w2() + (size_t)le * DFF * D, D, DFF, (unsigned char*)F.W2T() + ((size_t)le * D + nb * 32) * DFF, W8_SCALE, scr, kb * 64, nb * 32, F.lane); }
    }
}
__device__ __forceinline__ void p1_mod_reduce(Frame& F) {
    const float* mb = F.mod_b(); const float* mp = F.MODP(); float* mo = F.MOD();
    for (int i = blockIdx.x * 512 + F.tid; i < 2 * 5 * 6144; i += F.G * 512) {
        const int n = i % 6144, l = i / (5 * 6144);
        float s = mb[l * 6144 + n];
#pragma unroll
        for (int kc = 0; kc < 16; ++kc) s += mp[(size_t)kc * (2 * 5 * 6144) + i];
        mo[i] = s;
    }
}

__device__ __forceinline__ void norm_mod_row(const f32x4 (&h)[4], const float* nw, const float* sc, const float* sh, bf16* orow, int lane, bool fp8out = false) {
    float s = 0.f;
#pragma unroll
    for (int j = 0; j < 4; ++j) s += (h[j].x * h[j].x + h[j].y * h[j].y) + (h[j].z * h[j].z + h[j].w * h[j].w);
    const float rs = 1.0f / sqrtf(wave_sum(s) * (1.0f / D) + EPS);
    GAS v2u* o8 = (GAS v2u*)orow + lane;
#pragma unroll
    for (int j = 0; j < 4; ++j) {
        const f32x4 w = ((const GAS f32x4*)nw)[lane + 64 * j], a = ((const GAS f32x4*)sc)[lane + 64 * j], b = ((const GAS f32x4*)sh)[lane + 64 * j];
        const f32x4 y = h[j] * rs * w * (1.0f + a) + b;
        if (fp8out) ((GAS unsigned*)orow)[lane + 64 * j] = (unsigned)cvt4_fp8(y.x, y.y, y.z, y.w);
        else { v2u o; o.x = pk2(y.x, y.y); o.y = pk2(y.z, y.w); o8[64 * j] = o; }
    }
}
__device__ __forceinline__ void p_norm1(Frame& F, int layer) {
    const int gw = F.vcu * NWAVES + F.wave, NGW = F.G * NWAVES;
    const float* MODp = F.MOD(); const float* xin = F.x(); const float* cin = F.ctx(); bf16* Ap = F.A(); const float* n1w = F.norm1_w() + layer * D;
    for (int r = gw; r < M; r += NGW) {
        const int v = row_v(r); const float* mod = MODp + ((size_t)layer * 5 + v) * 6144;
        const int b = r / RB, p = r - b * RB;
        const float* src = (p < CTXL) ? cin + ((size_t)b * CTXL + p) * D : xin + ((size_t)b * SEQ + (p - CTXL)) * D;
        f32x4 h[4]; const GAS f32x4* hp = (const GAS f32x4*)src + F.lane;
#pragma unroll
        for (int j = 0; j < 4; ++j) h[j] = hp[64 * j];
        norm_mod_row(h, n1w, mod + 1024, mod, Ap + (size_t)r * D, F.lane);
    }
}
template <int PITCH, int NHEADS>
__device__ __forceinline__ void p_rope(Frame& F, bf16* buf) {
    const int gw = F.vcu * NWAVES + F.wave, NGW = F.G * NWAVES;
    for (int i = gw; i < NB * SEQ; i += NGW) {
        const int b = i / SEQ, t = i - b * SEQ; const size_t r = (size_t)b * RB + CTXL + t;
        const float prow = (float)(t >> 6), pcol = (float)(t & 63);
#pragma unroll
        for (int pass = 0; pass < (NHEADS * 4 + 63) / 64; ++pass) {
            const int slot = pass * 64 + F.lane;
            if (slot < NHEADS * 4) {
                const int head = slot >> 2, part = (slot >> 1) & 1, jh = slot & 1;
                bf16* p = buf + r * PITCH + head * 64 + part * 32 + jh * 8;
                const v4u av = *(const GAS v4u*)p, bv = *(const GAS v4u*)(p + 16);
                const float pos = part ? pcol : prow;
                unsigned ao[4], bo[4];
#pragma unroll
                for (int q = 0; q < 4; ++q) {
                    float a0 = bf2f(av[q] & 0xffffu), a1 = bf2f(av[q] >> 16), b0 = bf2f(bv[q] & 0xffffu), b1 = bf2f(bv[q] >> 16);
                    const int j0 = jh * 8 + 2 * q;
                    const float ang0 = pos * exp2f(-(float)j0 * (13.287712379549449f / 16.0f)), ang1 = pos * exp2f(-(float)(j0 + 1) * (13.287712379549449f / 16.0f));
                    float s0, c0, s1, c1; __sincosf(ang0, &s0, &c0); __sincosf(ang1, &s1, &c1);
                    ao[q] = pk2(a0 * c0 - b0 * s0, a1 * c1 - b1 * s1); bo[q] = pk2(a0 * s0 + b0 * c0, a1 * s1 + b1 * c1);
                }
                *(GAS v4u*)p = (v4u){ao[0], ao[1], ao[2], ao[3]}; *(GAS v4u*)(p + 16) = (v4u){bo[0], bo[1], bo[2], bo[3]};
            }
        }
    }
}

__device__ __forceinline__ float ret_lg2(const Frame& F, int dir, int h) { const float x = F.ret_decay()[dir * 4 + h]; return -log1pf(__expf(-x)) * LOG2E; }
typedef __attribute__((address_space(3))) bf16 lbf16;
__device__ __forceinline__ void ret_stage_vt(const bf16* vbase, lbf16* Vt, int tid) {
#pragma unroll
    for (int pass = 0; pass < 4; ++pass) { const int j = tid & 127, c = (tid >> 7) + 4 * pass;
        const v4u v = *(const GAS v4u*)(vbase + (size_t)j * 3072 + c * 8);
#pragma unroll
        for (int q = 0; q < 4; ++q) { Vt[(c * 8 + 2 * q) * 136 + j] = (bf16)(v[q] & 0xffffu); Vt[(c * 8 + 2 * q + 1) * 136 + j] = (bf16)(v[q] >> 16); } }
}
__device__ __forceinline__ void ret_kv_item(Frame& F, int item) {
    const int n = item % NCH, h = (item / NCH) & 3, b = item / (NCH * 4);
    int lane = F.lane; asm volatile("" : "+v"(lane));
    const int w = F.wave, tid = w * 64 + lane, fr = lane & 15, fq = lane >> 4;
    lbf16* Vt = (lbf16*)F.lds; lbf16* Kft = (lbf16*)(F.lds + 34816); lbf16* Kbt = (lbf16*)(F.lds + 34816 + 17408);
    const bf16* base = F.QKV() + (size_t)(b * RB + n * 128) * 3072;
    const float lgf = ret_lg2(F, 0, h), lgb = ret_lg2(F, 1, h);
    ret_stage_vt(base + C_RV + h * 128, Vt, tid);
#pragma unroll
    for (int pass = 0; pass < 2; ++pass) { const int j = tid & 127, c = (tid >> 7) + 4 * pass;
        const v4u v = *(const GAS v4u*)(base + (size_t)j * 3072 + C_RK + h * 64 + c * 8);
        const float wf = fast_exp2(lgf * (float)(127 - j)), wb = fast_exp2(lgb * (float)j);
#pragma unroll
        for (int q = 0; q < 4; ++q) { const float k0 = bf2f(v[q] & 0xffffu), k1 = bf2f(v[q] >> 16);
            Kft[(c * 8 + 2 * q) * 136 + j] = (bf16)f2bf(k0 * wf); Kft[(c * 8 + 2 * q + 1) * 136 + j] = (bf16)f2bf(k1 * wf);
            Kbt[(c * 8 + 2 * q) * 136 + j] = (bf16)f2bf(k0 * wb); Kbt[(c * 8 + 2 * q + 1) * 136 + j] = (bf16)f2bf(k1 * wb); } }
    __syncthreads();
    const int dir = w & 1, eb = (w >> 1) * 32;
    lbf16* Kt = dir ? Kbt : Kft;
    f32x4 acc[2][4];
#pragma unroll
    for (int a = 0; a < 2; ++a)
#pragma unroll
        for (int d = 0; d < 4; ++d) acc[a][d] = (f32x4){0.f, 0.f, 0.f, 0.f};
#pragma unroll
    for (int ks = 0; ks < 4; ++ks) {
        bf16x8 af[2], bfr[4];
#pragma unroll
        for (int a = 0; a < 2; ++a) af[a] = *(const LAS bf16x8*)(Vt + (eb + a * 16 + fr) * 136 + ks * 32 + fq * 8);
#pragma unroll
        for (int d = 0; d < 4; ++d) bfr[d] = *(const LAS bf16x8*)(Kt + (d * 16 + fr) * 136 + ks * 32 + fq * 8);
#pragma unroll
        for (int a = 0; a < 2; ++a)
#pragma unroll
            for (int d = 0; d < 4; ++d) acc[a][d] = __builtin_amdgcn_mfma_f32_16x16x32_bf16(af[a], bfr[d], acc[a][d], 0, 0, 0);
        __builtin_amdgcn_sched_barrier(0);
    }
    float* out = F.CKV() + ((size_t)(((b * 4 + h) * 2 + dir) * NCH + n)) * 8192;
#pragma unroll
    for (int a = 0; a < 2; ++a)
#pragma unroll
        for (int d = 0; d < 4; ++d)
#pragma unroll
            for (int v = 0; v < 4; ++v) out[(eb + a * 16 + 4 * fq + v) * 64 + d * 16 + fr] = acc[a][d][v];
    __syncthreads();
}
template <int NH, int NC, int COL0>
__device__ __forceinline__ void p_tr16(Frame& F, bf16* dstb) {
    const int gw = F.vcu * NWAVES + F.wave, NGW = F.G * NWAVES;
    lbf16* sc = (lbf16*)(F.lds + F.wave * 16384);
    const bf16* qkv = F.QKV();
    for (int it = gw; it < NB * NH * (RB / 64); it += NGW) {
        const int t = it % (RB / 64), h = (it / (RB / 64)) % NH, b = it / ((RB / 64) * NH);
        const bf16* src = qkv + ((size_t)b * RB + t * 64 + F.lane) * N_IN0 + COL0 + h * NC;
#pragma unroll
        for (int c = 0; c < NC / 8; ++c) { const v4u v = *(const GAS v4u*)(src + c * 8);
#pragma unroll
            for (int q = 0; q < 4; ++q) { sc[(c * 8 + 2 * q) * 64 + F.lane] = (bf16)(v[q] & 0xffffu); sc[(c * 8 + 2 * q + 1) * 64 + F.lane] = (bf16)(v[q] >> 16); } }
        LDS_WAIT(); asm volatile("" ::: "memory");
        bf16* dst = dstb + ((size_t)((b * NH + h) * NC)) * RB + t * 64;
#pragma unroll
        for (int i = 0; i < NC / 8; ++i) { const int ch = i * 64 + F.lane, col = ch >> 3, q = ch & 7; *(GAS v4u*)(dst + (size_t)col * RB + q * 8) = *(const LAS v4u*)(sc + col * 64 + q * 8); }
        LDS_WAIT(); asm volatile("" ::: "memory");
    }
}
__device__ __forceinline__ void ret_kv_item2(Frame& F, int item) {
    const int n = item % NCH, h = (item / NCH) & 3, b = item / (NCH * 4);
    int lane = F.lane; asm volatile("" : "+v"(lane));
    const int w = F.wave, tid = w * 64 + lane, fr = lane & 15, fq = lane >> 4;
    lbf16* Vt = (lbf16*)F.lds; lbf16* Kft = (lbf16*)(F.lds + 34816); lbf16* Kbt = (lbf16*)(F.lds + 34816 + 17408);
    const bf16* vt = F.RVT() + ((size_t)((b * 4 + h) * 128)) * RB + n * 128; const bf16* kt = F.RKT() + ((size_t)((b * 4 + h) * 64)) * RB + n * 128;
    const float lgf = ret_lg2(F, 0, h), lgb = ret_lg2(F, 1, h);
#pragma unroll
    for (int p = 0; p < 4; ++p) { const int ch = tid + 512 * p, e = ch >> 4, c = ch & 15; *(LAS v4u*)(Vt + e * 136 + c * 8) = *(const GAS v4u*)(vt + (size_t)e * RB + c * 8); }
#pragma unroll
    for (int p = 0; p < 2; ++p) { const int ch = tid + 512 * p, d = ch >> 4, c = ch & 15; const v4u v = *(const GAS v4u*)(kt + (size_t)d * RB + c * 8);
        v4u of, ob;
#pragma unroll
        for (int q = 0; q < 4; ++q) { const int j = c * 8 + 2 * q; const float k0 = bf2f(v[q] & 0xffffu), k1 = bf2f(v[q] >> 16);
            of[q] = pk2(k0 * fast_exp2(lgf * (float)(127 - j)), k1 * fast_exp2(lgf * (float)(126 - j)));
            ob[q] = pk2(k0 * fast_exp2(lgb * (float)j), k1 * fast_exp2(lgb * (float)(j + 1))); }
        *(LAS v4u*)(Kft + d * 136 + c * 8) = of; *(LAS v4u*)(Kbt + d * 136 + c * 8) = ob; }
    __syncthreads();
    const int dir = w & 1, eb = (w >> 1) * 32;
    lbf16* Kt = dir ? Kbt : Kft;
    f32x4 acc[2][4];
#pragma unroll
    for (int a = 0; a < 2; ++a)
#pragma unroll
        for (int d = 0; d < 4; ++d) acc[a][d] = (f32x4){0.f, 0.f, 0.f, 0.f};
#pragma unroll
    for (int ks = 0; ks < 4; ++ks) {
        bf16x8 af[2], bfr[4];
#pragma unroll
        for (int a = 0; a < 2; ++a) af[a] = *(const LAS bf16x8*)(Vt + (eb + a * 16 + fr) * 136 + ks * 32 + fq * 8);
#pragma unroll
        for (int d = 0; d < 4; ++d) bfr[d] = *(const LAS bf16x8*)(Kt + (d * 16 + fr) * 136 + ks * 32 + fq * 8);
#pragma unroll
        for (int a = 0; a < 2; ++a)
#pragma unroll
            for (int d = 0; d < 4; ++d) acc[a][d] = __builtin_amdgcn_mfma_f32_16x16x32_bf16(af[a], bfr[d], acc[a][d], 0, 0, 0);
        __builtin_amdgcn_sched_barrier(0);
    }
    float* out = F.CKV() + ((size_t)(((b * 4 + h) * 2 + dir) * NCH + n)) * 8192;
#pragma unroll
    for (int a = 0; a < 2; ++a)
#pragma unroll
        for (int d = 0; d < 4; ++d)
#pragma unroll
            for (int v = 0; v < 4; ++v) out[(eb + a * 16 + 4 * fq + v) * 64 + d * 16 + fr] = acc[a][d][v];
    __syncthreads();
}
__device__ __forceinline__ void ret_out_item2(Frame& F, int item) {
    const int n = item % NCH, h = (item / NCH) & 3, b = item / (NCH * 4);
    int lane = F.lane; asm volatile("" : "+v"(lane));
    const int w = F.wave, tid = w * 64 + lane, fr = lane & 15, fq = lane >> 4;
    lbf16* Qs = (lbf16*)F.lds; lbf16* Ks = (lbf16*)(F.lds + 18432); lbf16* Vt = (lbf16*)(F.lds + 36864);
    lbf16* Pf = (lbf16*)(F.lds + 71680); lbf16* Pb = (lbf16*)(F.lds + 90112); lbf16* Ps = (lbf16*)F.lds;
    const size_t row0 = (size_t)b * RB + n * 128;
    const bf16* base = F.QKV() + row0 * 3072;
    const float lgf = ret_lg2(F, 0, h), lgb = ret_lg2(F, 1, h);
    bf16* cat = F.CAT(); const float* rnw = F.ret_norm_w();
    const bf16* pf = F.PREV() + ((size_t)(((b * 4 + h) * 2 + 0) * NCH + n)) * 8192; const bf16* pb = F.PREV() + ((size_t)(((b * 4 + h) * 2 + 1) * NCH + n)) * 8192;
    const bf16* vt = F.RVT() + ((size_t)((b * 4 + h) * 128)) * RB + n * 128;
#pragma unroll
    for (int pass = 0; pass < 2; ++pass) { const int ch = tid + 512 * pass, row = ch >> 3, c = ch & 7;
        *(LAS v4u*)(Qs + row * 72 + c * 8) = *(const GAS v4u*)(base + (size_t)row * 3072 + C_RQ + h * 64 + c * 8);
        *(LAS v4u*)(Ks + row * 72 + c * 8) = *(const GAS v4u*)(base + (size_t)row * 3072 + C_RK + h * 64 + c * 8);
        *(LAS v4u*)(Pf + row * 72 + c * 8) = *(const GAS v4u*)(pf + row * 64 + c * 8);
        *(LAS v4u*)(Pb + row * 72 + c * 8) = *(const GAS v4u*)(pb + row * 64 + c * 8); }
#pragma unroll
    for (int p = 0; p < 4; ++p) { const int ch = tid + 512 * p, e = ch >> 4, c = ch & 15; *(LAS v4u*)(Vt + e * 136 + c * 8) = *(const GAS v4u*)(vt + (size_t)e * RB + c * 8); }
    __syncthreads();
    const int i0 = 16 * w, i = i0 + fr;
    v2u gr[8]; { const GAS v2u* gp_ = (const GAS v2u*)(base + (size_t)i * 3072 + C_RG + h * 128 + 4 * fq);
#pragma unroll
        for (int t = 0; t < 8; ++t) gr[t] = gp_[4 * t]; }
    f32x4 as[8], af_[8], ab_[8];
#pragma unroll
    for (int t = 0; t < 8; ++t) { as[t] = (f32x4){0.f, 0.f, 0.f, 0.f}; af_[t] = as[t]; ab_[t] = as[t]; }
#pragma unroll
    for (int ks = 0; ks < 2; ++ks) {
        const bf16x8 q = *(const LAS bf16x8*)(Qs + (i0 + fr) * 72 + ks * 32 + fq * 8);
#pragma unroll
        for (int t = 0; t < 8; ++t) {
            as[t]  = __builtin_amdgcn_mfma_f32_16x16x32_bf16(*(const LAS bf16x8*)(Ks + (t * 16 + fr) * 72 + ks * 32 + fq * 8), q, as[t], 0, 0, 0);
            af_[t] = __builtin_amdgcn_mfma_f32_16x16x32_bf16(*(const LAS bf16x8*)(Pf + (t * 16 + fr) * 72 + ks * 32 + fq * 8), q, af_[t], 0, 0, 0);
            ab_[t] = __builtin_amdgcn_mfma_f32_16x16x32_bf16(*(const LAS bf16x8*)(Pb + (t * 16 + fr) * 72 + ks * 32 + fq * 8), q, ab_[t], 0, 0, 0);
            if (t & 1) __builtin_amdgcn_sched_barrier(0);
        }
    }
    __syncthreads();
#pragma unroll
    for (int t = 0; t < 8; ++t) { float pv_[4];
#pragma unroll
        for (int v = 0; v < 4; ++v) { const int j = t * 16 + 4 * fq + v, dl = i - j;
            const float dec = dl > 0 ? fast_exp2(lgf * (float)dl) : (dl < 0 ? fast_exp2(lgb * (float)(-dl)) : 2.0f);
            pv_[v] = as[t][v] * dec; }
        *(LAS v2u*)(Ps + i * 136 + t * 16 + 4 * fq) = (v2u){pk2(pv_[0], pv_[1]), pk2(pv_[2], pv_[3])}; }
    __syncthreads();
    f32x4 ao[8];
#pragma unroll
    for (int t = 0; t < 8; ++t) ao[t] = (f32x4){0.f, 0.f, 0.f, 0.f};
#pragma unroll
    for (int ks = 0; ks < 4; ++ks) {
        const bf16x8 p = *(const LAS bf16x8*)(Ps + (i0 + fr) * 136 + ks * 32 + fq * 8);
#pragma unroll
        for (int t = 0; t < 8; ++t) ao[t] = __builtin_amdgcn_mfma_f32_16x16x32_bf16(*(const LAS bf16x8*)(Vt + (t * 16 + fr) * 136 + ks * 32 + fq * 8), p, ao[t], 0, 0, 0);
        __builtin_amdgcn_sched_barrier(0);
    }
    {
        const float df = fast_exp2(lgf * (float)(i + 1)), db = fast_exp2(lgb * (float)(128 - i));
        float ss = 0.f;
#pragma unroll
        for (int t = 0; t < 8; ++t) { ao[t] = ao[t] + df * af_[t] + db * ab_[t]; ss += (ao[t][0] * ao[t][0] + ao[t][1] * ao[t][1]) + (ao[t][2] * ao[t][2] + ao[t][3] * ao[t][3]); }
        ss += __shfl_xor(ss, 16); ss += __shfl_xor(ss, 32);
        const float rs = 1.0f / sqrtf(ss * (1.0f / 128.0f) + EPS);
        bf16* orow = cat + (row0 + i) * D + 512 + h * 128 + 4 * fq;
#pragma unroll
        for (int t = 0; t < 8; ++t) { const f32x4 g = (f32x4){bf2f(gr[t].x & 0xffffu), bf2f(gr[t].x >> 16), bf2f(gr[t].y & 0xffffu), bf2f(gr[t].y >> 16)}; const f32x4 wv = *(const GAS f32x4*)(rnw + t * 16 + 4 * fq);
            f32x4 sg; sg[0] = g[0] * sigmoidf_(g[0]); sg[1] = g[1] * sigmoidf_(g[1]); sg[2] = g[2] * sigmoidf_(g[2]); sg[3] = g[3] * sigmoidf_(g[3]);
            st4bf(orow + t * 16, ao[t] * rs * wv * sg); }
    }
    __syncthreads();
}
template <int NH, int NC, int PITCH, int COL0>
__device__ __forceinline__ void p_vt8(Frame& F, unsigned char* vt) {
    const int gw = F.vcu * NWAVES + F.wave, NGW = F.G * NWAVES;
    LAS unsigned char* sc8 = (LAS unsigned char*)(F.lds + F.wave * 8192);
    const bf16* qkv = F.QKV();
    for (int it = gw; it < NB * NH * (RB / 64); it += NGW) {
        const int t = it % (RB / 64), h = (it / (RB / 64)) % NH, b = it / ((RB / 64) * NH);
        const bf16* src = qkv + ((size_t)b * RB + t * 64 + F.lane) * PITCH + COL0 + h * NC;
        const int slot = attn_dv::vt8_slot(F.lane);
#pragma unroll
        for (int c = 0; c < NC / 8; ++c) { const v4u v = *(const GAS v4u*)(src + c * 8);
#pragma unroll
            for (int q = 0; q < 4; ++q) { const int w = cvt4_fp8(bf2f(v[q] & 0xffffu), bf2f(v[q] >> 16), 0.f, 0.f);
                sc8[(c * 8 + 2 * q) * 64 + slot] = (unsigned char)(w & 0xff); sc8[(c * 8 + 2 * q + 1) * 64 + slot] = (unsigned char)((w >> 8) & 0xff); } }
        LDS_WAIT(); asm volatile("" ::: "memory");
        unsigned char* dst = vt + ((size_t)((b * NH + h) * NC)) * RB + t * 64;
#pragma unroll
        for (int i = 0; i < NC / 16; ++i) { const int ch = i * 64 + F.lane, col = ch >> 2, q = ch & 3; *(GAS v4u*)(dst + (size_t)col * RB + q * 16) = *(const LAS v4u*)(sc8 + col * 64 + q * 16); }
        LDS_WAIT(); asm volatile("" ::: "memory");
    }
}
__device__ __forceinline__ void p_ret_scan(Frame& F) {
    const float* ckv = F.CKV(); bf16* prev = F.PREV(); const float* rdl = F.ret_decay();
    for (int i = blockIdx.x * 512 + F.tid; i < NB * 4 * 2 * 4096; i += F.G * 512) {
        const int el = i & 4095, seq = i >> 12, dir = seq & 1, h = (seq >> 1) & 3;
        const float gC = fast_exp2(-log1pf(__expf(-rdl[dir * 4 + h])) * LOG2E * 128.0f);
        const float* src = ckv + (size_t)seq * NCH * 8192 + el * 2; bf16* dst = prev + (size_t)seq * NCH * 8192 + el * 2;
        float s0 = 0.f, s1 = 0.f;
#pragma unroll 33
        for (int s = 0; s < NCH; ++s) {
            const int n = dir ? (s < 2 ? 1 - s : NCH + 1 - s) : s;
            const f32x2 v = *(const GAS f32x2*)(src + (size_t)n * 8192);
            *(GAS unsigned*)(dst + (size_t)n * 8192) = pk2(s0, s1);
            s0 = gC * s0 + v.x; s1 = gC * s1 + v.y;
        }
    }
}
__device__ __forceinline__ void ret_out_item(Frame& F, int item) {
    const int n = item % NCH, h = (item / NCH) & 3, b = item / (NCH * 4);
    int lane = F.lane; asm volatile("" : "+v"(lane));
    const int w = F.wave, tid = w * 64 + lane, fr = lane & 15, fq = lane >> 4;
    lbf16* Qs = (lbf16*)F.lds; lbf16* Ks = (lbf16*)(F.lds + 18432); lbf16* Vt = (lbf16*)(F.lds + 36864);
    lbf16* Pf = (lbf16*)(F.lds + 71680); lbf16* Pb = (lbf16*)(F.lds + 90112); lbf16* Ps = (lbf16*)F.lds;
    const size_t row0 = (size_t)b * RB + n * 128;
    const bf16* base = F.QKV() + row0 * 3072;
    const float lgf = ret_lg2(F, 0, h), lgb = ret_lg2(F, 1, h);
    bf16* cat = F.CAT(); const float* rnw = F.ret_norm_w();
    const bf16* pf = F.PREV() + ((size_t)(((b * 4 + h) * 2 + 0) * NCH + n)) * 8192; const bf16* pb = F.PREV() + ((size_t)(((b * 4 + h) * 2 + 1) * NCH + n)) * 8192;
#pragma unroll
    for (int pass = 0; pass < 2; ++pass) { const int ch = tid + 512 * pass, row = ch >> 3, c = ch & 7;
        *(LAS v4u*)(Qs + row * 72 + c * 8) = *(const GAS v4u*)(base + (size_t)row * 3072 + C_RQ + h * 64 + c * 8);
        *(LAS v4u*)(Ks + row * 72 + c * 8) = *(const GAS v4u*)(base + (size_t)row * 3072 + C_RK + h * 64 + c * 8);
        *(LAS v4u*)(Pf + row * 72 + c * 8) = *(const GAS v4u*)(pf + row * 64 + c * 8);
        *(LAS v4u*)(Pb + row * 72 + c * 8) = *(const GAS v4u*)(pb + row * 64 + c * 8); }
    ret_stage_vt(base + C_RV + h * 128, Vt, tid);
    __syncthreads();
    const int i0 = 16 * w;
    f32x4 as[8], af_[8], ab_[8];
#pragma unroll
    for (int t = 0; t < 8; ++t) { as[t] = (f32x4){0.f, 0.f, 0.f, 0.f}; af_[t] = as[t]; ab_[t] = as[t]; }
#pragma unroll
    for (int ks = 0; ks < 2; ++ks) {
        const bf16x8 a = *(const LAS bf16x8*)(Qs + (i0 + fr) * 72 + ks * 32 + fq * 8);
#pragma unroll
        for (int t = 0; t < 8; ++t) {
            as[t]  = __builtin_amdgcn_mfma_f32_16x16x32_bf16(a, *(const LAS bf16x8*)(Ks + (t * 16 + fr) * 72 + ks * 32 + fq * 8), as[t], 0, 0, 0);
            af_[t] = __builtin_amdgcn_mfma_f32_16x16x32_bf16(a, *(const LAS bf16x8*)(Pf + (t * 16 + fr) * 72 + ks * 32 + fq * 8), af_[t], 0, 0, 0);
            ab_[t] = __builtin_amdgcn_mfma_f32_16x16x32_bf16(a, *(const LAS bf16x8*)(Pb + (t * 16 + fr) * 72 + ks * 32 + fq * 8), ab_[t], 0, 0, 0);
            if (t & 1) __builtin_amdgcn_sched_barrier(0);
        }
    }
    __syncthreads();
#pragma unroll
    for (int t = 0; t < 8; ++t)
#pragma unroll
        for (int v = 0; v < 4; ++v) { const int i = i0 + 4 * fq + v, j = t * 16 + fr, dl = i - j;
            const float dec = dl > 0 ? fast_exp2(lgf * (float)dl) : (dl < 0 ? fast_exp2(lgb * (float)(-dl)) : 2.0f);
            Ps[i * 136 + j] = (bf16)f2bf(as[t][v] * dec); }
    __syncthreads();
    f32x4 ao[8];
#pragma unroll
    for (int t = 0; t < 8; ++t) ao[t] = (f32x4){0.f, 0.f, 0.f, 0.f};
#pragma unroll
    for (int ks = 0; ks < 4; ++ks) {
        const bf16x8 a = *(const LAS bf16x8*)(Ps + (i0 + fr) * 136 + ks * 32 + fq * 8);
#pragma unroll
        for (int t = 0; t < 8; ++t) ao[t] = __builtin_amdgcn_mfma_f32_16x16x32_bf16(a, *(const LAS bf16x8*)(Vt + (t * 16 + fr) * 136 + ks * 32 + fq * 8), ao[t], 0, 0, 0);
        __builtin_amdgcn_sched_barrier(0);
    }
#pragma unroll
    for (int v = 0; v < 4; ++v) {
        const int i = i0 + 4 * fq + v;
        const float df = fast_exp2(lgf * (float)(i + 1)), db = fast_exp2(lgb * (float)(128 - i));
        float o[8], ss = 0.f;
#pragma unroll
        for (int t = 0; t < 8; ++t) { o[t] = ao[t][v] + df * af_[t][v] + db * ab_[t][v]; ss += o[t] * o[t]; }
        ss += __shfl_xor(ss, 1); ss += __shfl_xor(ss, 2); ss += __shfl_xor(ss, 4); ss += __shfl_xor(ss, 8);
        const float rs = 1.0f / sqrtf(ss * (1.0f / 128.0f) + EPS);
        const size_t r = row0 + i;
#pragma unroll
        for (int t = 0; t < 8; ++t) { const int e = t * 16 + fr;
            const float g = bf2f(base[(size_t)i * 3072 + C_RG + h * 128 + e]);
            cat[r * D + 512 + h * 128 + e] = (bf16)f2bf(o[t] * rs * rnw[e] * (g * sigmoidf_(g))); }
    }
    __syncthreads();
}
__device__ __forceinline__ void p_dfinish(Frame& F) {
    const int gw = F.vcu * NWAVES + F.wave, NGW = F.G * NWAVES;
    const float* dl_ = F.diff_lam(); bf16* cat = F.CAT();
    const float s1 = wave_sum(dl_[F.lane] * dl_[64 + F.lane]), s2 = wave_sum(dl_[128 + F.lane] * dl_[192 + F.lane]);
    const float lam = __expf(s1) - __expf(s2) + 0.2f;
    const bf16* O0 = F.OD(); const bf16* O1 = O0 + (size_t)M * 512; const float* dnw = F.diff_norm_w();
    float nw[8];
#pragma unroll
    for (int q = 0; q < 8; ++q) nw[q] = dnw[(F.lane & 15) * 8 + q] * 0.8f;
    for (int r = gw; r < M; r += NGW) {
        const v4u a = *(const GAS v4u*)(O0 + (size_t)r * 512 + F.lane * 8), b = *(const GAS v4u*)(O1 + (size_t)r * 512 + F.lane * 8);
        float d[8], ss = 0.f;
#pragma unroll
        for (int q = 0; q < 4; ++q) { d[2 * q] = bf2f(a[q] & 0xffffu) - lam * bf2f(b[q] & 0xffffu); d[2 * q + 1] = bf2f(a[q] >> 16) - lam * bf2f(b[q] >> 16); ss += d[2 * q] * d[2 * q] + d[2 * q + 1] * d[2 * q + 1]; }
        ss += __shfl_xor(ss, 1); ss += __shfl_xor(ss, 2); ss += __shfl_xor(ss, 4); ss += __shfl_xor(ss, 8);
        const float rs = 1.0f / sqrtf(ss * (1.0f / 128.0f) + EPS);
        v4u o;
#pragma unroll
        for (int q = 0; q < 4; ++q) o[q] = pk2(d[2 * q] * rs * nw[2 * q], d[2 * q + 1] * rs * nw[2 * q + 1]);
        *(GAS v4u*)(cat + (size_t)r * D + F.lane * 8) = o;
    }
}

template <class Epi, bool F8 = false> struct DenseProb {
    static constexpr bool PERM = Epi::PERM;
    const bf16* A; const bf16* Bt; int K, nM, nN, G, c; bool skipctx; Epi E;
    __device__ __forceinline__ bool next(int i, pg8::Unit& u) const {
        const int nwg = nM * nN; const long L = (long)i * G + c; if (L >= nwg) return false;
        int wgid = (int)L; { const int q = nwg / pg8::NXCD, r = nwg % pg8::NXCD, xcd = wgid % pg8::NXCD, off = wgid / pg8::NXCD; wgid = (xcd < r ? xcd * (q + 1) : r * (q + 1) + (xcd - r) * q) + off; }
        const int nig = pg8::WGM * nN, gid = wgid / nig, fm = gid * pg8::WGM, gsz = (nM - fm) < pg8::WGM ? (nM - fm) : pg8::WGM;
        int pm = fm + ((wgid % nig) % gsz); u.pn = (wgid % nig) / gsz; u.e = 0;
        if (skipctx) pm = (pm >> 5) * TPB + 1 + (pm & 31);
        u.pm = pm; return true;
    }
    __device__ __forceinline__ const char* a_base() const { return (const char*)A; }
    __device__ __forceinline__ void a_offs(const pg8::Unit& u, const int (&R)[2], const int (&C)[2], unsigned (&o)[2][2]) const {
#pragma unroll
        for (int h = 0; h < 2; ++h)
#pragma unroll
            for (int i = 0; i < 2; ++i) o[h][i] = (unsigned)((u.pm * 256 + h * 128 + R[i]) * K + C[i]) * 2u;
    }
    __device__ __forceinline__ const char* b_base(const pg8::Unit& u) const { return (const char*)Bt + (size_t)u.pn * 256 * K * 2; }
    static constexpr int NBIAS = 0; static constexpr bool FP8 = F8;
    __device__ __forceinline__ unsigned a_fix(unsigned x, int) const { return x; }
    __device__ __forceinline__ const float* bias_src(const pg8::Unit&, int) const { return nullptr; }
    __device__ __forceinline__ void epi(const f32x4 (&acc)[2][2][4][2], const pg8::Unit& u, int wr, int wc, int fr, int fq, const LAS float*) const { E(acc, u, wr, wc, fr, fq); }
};
struct EpiStoreBf16 {
    static constexpr bool PERM = true;
    bf16* O; int ldc; int rope_cols; float ascale; unsigned char* qk8; unsigned char* k8;
    __device__ __forceinline__ void operator()(const f32x4 (&acc)[2][2][4][2], const pg8::Unit& u, int wr, int wc, int fr, int fq) const {
        const int row0 = u.pm * 256 + wr * 64 + fr, col0 = u.pn * 256 + wc * 32 + 8 * fq;
        const int bq = u.pm / TPB, tt = u.pm - bq * TPB;
        const bool rope_tile = (tt != 0) && (u.pn * 256 < rope_cols);
        const float sgn = fq < 2 ? -1.0f : 1.0f;
#pragma unroll
        for (int ai = 0; ai < 2; ++ai)
#pragma unroll
            for (int m = 0; m < 4; ++m) { bf16* rowp = O + (size_t)(row0 + ai * 128 + m * 16) * ldc + col0;
                float y[2][8];
#pragma unroll
                for (int bj = 0; bj < 2; ++bj)
#pragma unroll
                    for (int i = 0; i < 8; ++i) y[bj][i] = acc[ai][bj][m][i >> 2][i & 3] * ascale;
                if (rope_tile) { const int t = (tt - 1) * 256 + ai * 128 + wr * 64 + m * 16 + fr; const float pos = (wc & 1) ? (float)(t & 63) : (float)(t >> 6);
#pragma unroll
                    for (int i = 0; i < 8; ++i) { float sn, cs; __sincosf(pos * exp2f(-(float)(8 * (fq & 1) + i) * (13.287712379549449f / 16.0f)), &sn, &cs);
#pragma unroll
                        for (int bj = 0; bj < 2; ++bj) if (u.pn * 256 + bj * 128 < rope_cols) { const float p = __shfl_xor(y[bj][i], 32); y[bj][i] = y[bj][i] * cs + sgn * p * sn; } } }
#pragma unroll
                for (int bj = 0; bj < 2; ++bj) {
                    if (k8 && u.pn == 4 && bj == 0) { *(GAS v2u*)(k8 + (size_t)(row0 + ai * 128 + m * 16) * 128 + wc * 32 + 8 * fq) = (v2u){(unsigned)cvt4_fp8(y[bj][0], y[bj][1], y[bj][2], y[bj][3]), (unsigned)cvt4_fp8(y[bj][4], y[bj][5], y[bj][6], y[bj][7])}; continue; }
                    if (qk8 && u.pn < 4) { *(GAS v2u*)(qk8 + (size_t)(row0 + ai * 128 + m * 16) * 1024 + col0 + bj * 128) = (v2u){(unsigned)cvt4_fp8(y[bj][0], y[bj][1], y[bj][2], y[bj][3]), (unsigned)cvt4_fp8(y[bj][4], y[bj][5], y[bj][6], y[bj][7])}; continue; }
                    v4u w; w.x = cvt_pk_bf16(y[bj][0], y[bj][1]); w.y = cvt_pk_bf16(y[bj][2], y[bj][3]); w.z = cvt_pk_bf16(y[bj][4], y[bj][5]); w.w = cvt_pk_bf16(y[bj][6], y[bj][7]);
                    *(GAS v4u*)(rowp + bj * 128) = w; } }
    }
};
struct EpiResid {
    static constexpr bool PERM = false;
    bf16* H; const float* MODL; int goff; const float* xin; const float* cin;
    __device__ __forceinline__ void operator()(const f32x4 (&acc)[2][2][4][2], const pg8::Unit& u, int wr, int wc, int fr, int fq) const {
        const int row0 = u.pm * 256 + wr * 64 + fr, col0 = u.pn * 256 + wc * 32 + 4 * fq;
        const int b = u.pm / TPB, tt = u.pm - b * TPB, v = tt == 0 ? 4 : b;
        const float* src = xin ? (tt == 0 ? cin + (size_t)b * CTXL * D : xin + ((size_t)b * SEQ + (tt - 1) * 256) * D) + (size_t)(wr * 64 + fr) * D + col0 : nullptr;
        const float* g = MODL + (size_t)v * 6144 + goff + col0;
        f32x4 gv[2][2];
#pragma unroll
        for (int bj = 0; bj < 2; ++bj)
#pragma unroll
            for (int n = 0; n < 2; ++n) gv[bj][n] = *(const GAS f32x4*)(g + bj * 128 + n * 16);
#pragma unroll
        for (int ai = 0; ai < 2; ++ai)
#pragma unroll
            for (int m = 0; m < 4; ++m) { bf16* rowp = H + (size_t)(row0 + ai * 128 + m * 16) * D + col0; const float* srow = src + (size_t)(ai * 128 + m * 16) * D;
#pragma unroll
                for (int bj = 0; bj < 2; ++bj)
#pragma unroll
                    for (int n = 0; n < 2; ++n) { bf16* p = rowp + bj * 128 + n * 16; const f32x4 res = xin ? *(const GAS f32x4*)(srow + bj * 128 + n * 16) : ld4bf(p); st4bf(p, res + gv[bj][n] * acc[ai][bj][m][n]); } }
    }
};
__device__ __forceinline__ void moe_tables(Frame& F, int layer) {
    __syncthreads();
    if (F.tid < 64) {
        const int e = F.lane & 31;
        const unsigned c = __hip_atomic_load(F.ctl() + CW_CNT + (layer * 32 + e) * 64, RLX_AGENT);
        const unsigned tl = (c + 255u) >> 8; unsigned inc = tl;
#pragma unroll
        for (int o = 1; o < 32; o <<= 1) { const unsigned up = __shfl_up(inc, o); if (e >= o) inc += up; }
        if (F.lane < 32) { F.MISC[MW_CNT + e] = c; F.MISC[MW_TST + e] = inc - tl; if (e == 31) F.MISC[MW_TST + NEXP] = inc; } }
    __syncthreads();
    { LAS unsigned char* te = (LAS unsigned char*)(F.lds + TILE_E_OFF);
      for (int t = F.tid; t < 576; t += NWAVES * 64) { int e = 0;
#pragma unroll
          for (int st = 16; st >= 1; st >>= 1) { if (t >= (int)F.MISC[MW_TST + e + st]) e += st; }
          te[t] = (unsigned char)e; } }
    __syncthreads();
}
struct Moe1Prob {
    static constexpr bool PERM = true;
    const bf16* Fin; const bf16* W1l; const float* b1l; const int* LIST; bf16* ACT; volatile LAS unsigned* MISC; int K, G, c;
    __device__ __forceinline__ bool next(int i, pg8::Unit& u) const {
        const int L = i * G + c, tt = (int)MISC[MW_TST + NEXP]; if (L >= tt * 8) return false;
        const int tr = L >> 3;
        u.pm = tr; u.pn = L & 7; u.e = (int)((const volatile LAS unsigned char*)((const volatile LAS unsigned char*)MISC - MISC_OFF + TILE_E_OFF))[tr]; return true;
    }
    __device__ __forceinline__ const char* a_base() const { return (const char*)Fin; }
    __device__ __forceinline__ void a_offs(const pg8::Unit& u, const int (&R)[2], const int (&C)[2], unsigned (&o)[2][2]) const {
        const int p0 = (u.pm - (int)MISC[MW_TST + u.e]) * 256, cnt = (int)MISC[MW_CNT + u.e];
#pragma unroll
        for (int h = 0; h < 2; ++h)
#pragma unroll
            for (int i = 0; i < 2; ++i) { const int p = p0 + h * 128 + R[i]; o[h][i] = (unsigned)LIST[(size_t)u.e * LIST_CAP + (p < cnt ? p : 0)]; }
    }
    static constexpr int NBIAS = 256; static constexpr bool FP8 = true;
    __device__ __forceinline__ unsigned a_fix(unsigned tok, int Ci) const { return (tok * (unsigned)K + (unsigned)Ci) * 2u; }
    __device__ __forceinline__ const float* bias_src(const pg8::Unit& u, int lane) const { return b1l + (size_t)u.e * 2048 + u.pn * 128 + (lane < 32 ? lane * 4 : 1024 + (lane - 32) * 4); }
    __device__ __forceinline__ const char* b_base(const pg8::Unit& u) const { return (const char*)W1l + ((size_t)u.e * 2048 + (size_t)u.pn * 256) * K * 2; }
    __device__ __forceinline__ void epi(const f32x4 (&acc)[2][2][4][2], const pg8::Unit& u, int wr, int wc, int fr, int fq, const LAS float* bias) const {
        const int row0 = u.pm * 256 + wr * 64 + fr, colt = wc * 32 + 8 * fq;
        f32x4 bgv[2], blv[2];
#pragma unroll
        for (int n = 0; n < 2; ++n) { bgv[n] = *(const LAS f32x4*)(bias + colt + 4 * n); blv[n] = *(const LAS f32x4*)(bias + 128 + colt + 4 * n); }
#pragma unroll
        for (int ai = 0; ai < 2; ++ai)
#pragma unroll
            for (int m = 0; m < 4; ++m) {
                unsigned w[2];
#pragma unroll
                for (int n = 0; n < 2; ++n) { const f32x4 gl = acc[ai][0][m][n] * W8_INV + bgv[n], li = acc[ai][1][m][n] * W8_INV + blv[n];
                    f32x4 g, l, e;
#pragma unroll
                    for (int j = 0; j < 4; ++j) { g[j] = fminf(gl[j], 7.0f); l[j] = __builtin_amdgcn_fmed3f(li[j], -7.0f, 7.0f); }
                    const f32x4 z = g * (-1.702f * 1.4426950408889634f);
#pragma unroll
                    for (int j = 0; j < 4; ++j) e[j] = __builtin_amdgcn_exp2f(z[j]);
                    const f32x4 den = e + 1.0f; f32x4 r;
#pragma unroll
                    for (int j = 0; j < 4; ++j) r[j] = __builtin_amdgcn_rcpf(den[j]);
                    const f32x4 a = (g * r) * (l + 1.0f);
                    w[n] = (unsigned)attn_dv::cvt4_nc(a[0], a[1], a[2], a[3]); }
                *(GAS v2u*)((unsigned char*)ACT + (size_t)(row0 + ai * 128 + m * 16) * DFF + u.pn * 128 + colt) = (v2u){w[0], w[1]}; }
    }
};
struct Moe2Prob {
    static constexpr bool PERM = true;
    const bf16* ACT; const bf16* W2l; const float* b2l; bf16* Y; volatile LAS unsigned* MISC; int K, G, c;
    __device__ __forceinline__ bool next(int i, pg8::Unit& u) const {
        const int L = i * G + c, tt = (int)MISC[MW_TST + NEXP]; if (L >= tt * 4) return false;
        const int tr = L >> 2;
        u.pm = tr; u.pn = L & 3; u.e = (int)((const volatile LAS unsigned char*)((const volatile LAS unsigned char*)MISC - MISC_OFF + TILE_E_OFF))[tr]; return true;
    }
    __device__ __forceinline__ const char* a_base() const { return (const char*)ACT; }
    __device__ __forceinline__ void a_offs(const pg8::Unit& u, const int (&R)[2], const int (&C)[2], unsigned (&o)[2][2]) const {
#pragma unroll
        for (int h = 0; h < 2; ++h)
#pragma unroll
            for (int i = 0; i < 2; ++i) o[h][i] = (unsigned)((u.pm * 256 + h * 128 + R[i]) * K + C[i]) * 2u;
    }
    __device__ __forceinline__ const char* b_base(const pg8::Unit& u) const { return (const char*)W2l + ((size_t)u.e * D + (size_t)u.pn * 256) * K * 2; }
    static constexpr int NBIAS = 256; static constexpr bool FP8 = true;
    __device__ __forceinline__ unsigned a_fix(unsigned x, int) const { return x; }
    __device__ __forceinline__ const float* bias_src(const pg8::Unit& u, int lane) const { return b2l + (size_t)u.e * D + u.pn * 256 + lane * 4; }
    __device__ __forceinline__ void epi(const f32x4 (&acc)[2][2][4][2], const pg8::Unit& u, int wr, int wc, int fr, int fq, const LAS float* bias) const {
        const int row0 = u.pm * 256 + wr * 64 + fr, col0 = u.pn * 256 + wc * 32 + 8 * fq;
        f32x4 bv[2][2];
#pragma unroll
        for (int bj = 0; bj < 2; ++bj)
#pragma unroll
            for (int n = 0; n < 2; ++n) bv[bj][n] = *(const LAS f32x4*)(bias + wc * 32 + 8 * fq + bj * 128 + 4 * n);
#pragma unroll
        for (int ai = 0; ai < 2; ++ai)
#pragma unroll
            for (int m = 0; m < 4; ++m) { bf16* rowp = Y + (size_t)(row0 + ai * 128 + m * 16) * D + col0;
#pragma unroll
                for (int bj = 0; bj < 2; ++bj) { const f32x4 v0 = acc[ai][bj][m][0] * W8_INV + bv[bj][0], v1 = acc[ai][bj][m][1] * W8_INV + bv[bj][1];
                    if (Y_FP8) { *(GAS v2u*)((unsigned char*)Y + (size_t)(row0 + ai * 128 + m * 16) * D + col0 + bj * 128) = (v2u){(unsigned)cvt4_fp8(v0[0], v0[1], v0[2], v0[3]), (unsigned)cvt4_fp8(v1[0], v1[1], v1[2], v1[3])}; continue; }
                    v4u w; w.x = cvt_pk_bf16(v0[0], v0[1]); w.y = cvt_pk_bf16(v0[2], v0[3]); w.z = cvt_pk_bf16(v1[0], v1[1]); w.w = cvt_pk_bf16(v1[2], v1[3]);
                    *(GAS v4u*)(rowp + bj * 128) = w; } }
    }
};

constexpr int PROV_OFF = MISC_OFF + 1024, PROV_CAP = 2048;
constexpr int LDS_TOTAL = PROV_OFF + PROV_CAP * 4;
__device__ __forceinline__ int tok_row(int layer, int i) { if (layer == 0) return i; const int b = i / SEQ; return b * RB + CTXL + (i - b * SEQ); }
__device__ __forceinline__ void tok_finish(Frame& F, int i, int i0, int r, const f32x2 (&pq)[16], float rbias, volatile LAS unsigned* prov, float* GATEp) {
    float p[32];
#pragma unroll
    for (int e = 0; e < 16; ++e) { p[2 * e] = pq[e].x; p[2 * e + 1] = pq[e].y; }
        float q16[16], q8[8], q4[4], q2[2], q1;
#pragma unroll
        for (int t = 0; t < 16; ++t) { const auto rr = __builtin_amdgcn_permlane32_swap(__float_as_uint(p[t]), __float_as_uint(p[16 + t]), false, false); q16[t] = __uint_as_float(rr[0]) + __uint_as_float(rr[1]); }
#pragma unroll
        for (int t = 0; t < 8; ++t) { const auto rr = __builtin_amdgcn_permlane16_swap(__float_as_uint(q16[t]), __float_as_uint(q16[8 + t]), false, false); q8[t] = __uint_as_float(rr[0]) + __uint_as_float(rr[1]); }
        { const bool up = (F.lane & 8) != 0;
#pragma unroll
          for (int t = 0; t < 4; ++t) { const float mine = up ? q8[4 + t] : q8[t], send = up ? q8[t] : q8[4 + t]; q4[t] = mine + dpp_xor<8>(send); } }
        { const bool up = (F.lane & 4) != 0;
#pragma unroll
          for (int t = 0; t < 2; ++t) { const float mine = up ? q4[2 + t] : q4[t], send = up ? q4[t] : q4[2 + t]; q2[t] = mine + dpp_xor<4>(send); } }
        { const bool up = (F.lane & 2) != 0; const float mine = up ? q2[1] : q2[0], send = up ? q2[0] : q2[1]; q1 = mine + dpp_xor<2>(send); }
        q1 += dpp_xor<1>(q1);
        const int myE = F.lane >> 1;
        float val = q1 + rbias;
        float tv[4]; int ti[4];
        { int rank = 0; const int vali = __float_as_int(val);
#pragma unroll
          for (int e = 0; e < 32; ++e) { const float ve = __int_as_float(__builtin_amdgcn_readlane(vali, 2 * e)); rank += ((ve > val) || (ve == val && e < myE)) ? 1 : 0; }
#pragma unroll
          for (int k = 0; k < 4; ++k) { const unsigned long long mk = __ballot(rank == k); const int ln = (int)__builtin_ctzll(mk); ti[k] = ln >> 1; tv[k] = __int_as_float(__builtin_amdgcn_readlane(vali, ln)); } }
        const float w1 = __expf(tv[1] - tv[0]), w2 = __expf(tv[2] - tv[0]), w3 = __expf(tv[3] - tv[0]); const float inv = 1.0f / (1.0f + w1 + w2 + w3);
        if (F.lane < 4) {
            const int ek = F.lane == 0 ? ti[0] : F.lane == 1 ? ti[1] : F.lane == 2 ? ti[2] : ti[3];
            const float gk = (F.lane == 0 ? 1.0f : F.lane == 1 ? w1 : F.lane == 2 ? w2 : w3) * inv;
            const unsigned ls = __hip_atomic_fetch_add((LAS unsigned*)(F.lds + MISC_OFF) + MW_LCNT + ek, 1u, __ATOMIC_RELAXED, __HIP_MEMORY_SCOPE_WORKGROUP);
            prov[(i - i0) * 4 + F.lane] = ((unsigned)ek << 16) | ls;
            GATEp[(size_t)r * 4 + F.lane] = gk;
        }
    }
__device__ __forceinline__ void p_token(Frame& F, int layer) {
    const int nrows = layer == 0 ? M : NB * SEQ, RPB = (nrows + F.G - 1) / F.G;
    const int i0 = blockIdx.x * RPB, i1 = (i0 + RPB < nrows) ? i0 + RPB : nrows;
    LAS float* WL = (LAS float*)F.lds;
    volatile LAS unsigned* prov = (volatile LAS unsigned*)(F.lds + PROV_OFF);
    __syncthreads();
    if (F.tid < 32) F.MISC[MW_LCNT + F.tid] = 0u;
    const float* rw = F.router_w() + (size_t)layer * D * NEXP;
#pragma unroll
    for (int p = 0; p < 2; ++p) { const int k = F.tid + 512 * p, rowL = ((k & 3) + 4 * (k >> 8)) * 64 + ((k >> 2) & 63);
#pragma unroll
        for (int q = 0; q < 8; ++q) *(LAS f32x4*)(WL + rowL * 36 + 4 * q) = *(const GAS f32x4*)(rw + (size_t)k * NEXP + 4 * q); }
    __syncthreads();
    const float* n2 = F.norm2_w() + layer * D;
    const float rbias = F.router_b()[layer * NEXP + (F.lane >> 1)];
    const float* MODl = F.MOD() + (size_t)layer * 5 * 6144; const bf16* Hp = F.H(); bf16* Ap = F.A(); float* GATEp = F.GATE();
    if (RPB * 4 <= PROV_CAP)
    for (int i = i0 + F.wave; i < i1; i += 2 * NWAVES) {
        const int iB = i + NWAVES; const bool hasB = iB < i1;
        const int rA = tok_row(layer, i), rB = tok_row(layer, hasB ? iB : i);
        const float* modA = MODl + (size_t)row_v(rA) * 6144; const float* modB = MODl + (size_t)row_v(rB) * 6144;
        f32x4 hA[4], hB[4]; const bf16* hpA = Hp + (size_t)rA * D + F.lane * 4; const bf16* hpB = Hp + (size_t)rB * D + F.lane * 4;
        float sA = 0.f, sB = 0.f;
#pragma unroll
        for (int j = 0; j < 4; ++j) { hA[j] = ld4bf(hpA + 256 * j); hB[j] = ld4bf(hpB + 256 * j); }
#pragma unroll
        for (int j = 0; j < 4; ++j) { sA += (hA[j].x * hA[j].x + hA[j].y * hA[j].y) + (hA[j].z * hA[j].z + hA[j].w * hA[j].w); sB += (hB[j].x * hB[j].x + hB[j].y * hB[j].y) + (hB[j].z * hB[j].z + hB[j].w * hB[j].w); }
        const float rsA = 1.0f / sqrtf(wave_sum(sA) * (1.0f / D) + EPS), rsB = 1.0f / sqrtf(wave_sum(sB) * (1.0f / D) + EPS);
        GAS unsigned* o8A = (GAS unsigned*)((unsigned char*)Ap + (size_t)rA * D) + F.lane;
        GAS unsigned* o8B = (GAS unsigned*)((unsigned char*)Ap + (size_t)rB * D) + F.lane;
        f32x2 pA[16], pB[16];
#pragma unroll
        for (int e = 0; e < 16; ++e) { pA[e] = (f32x2){0.f, 0.f}; pB[e] = (f32x2){0.f, 0.f}; }
#pragma unroll
        for (int j = 0; j < 4; ++j) {
            asm volatile("" ::: "memory");
            const f32x4 w = ((const GAS f32x4*)n2)[F.lane + 64 * j];
            const f32x4 aA = ((const GAS f32x4*)(modA + 4096))[F.lane + 64 * j], bA = ((const GAS f32x4*)(modA + 3072))[F.lane + 64 * j];
            const f32x4 aB = ((const GAS f32x4*)(modB + 4096))[F.lane + 64 * j], bB = ((const GAS f32x4*)(modB + 3072))[F.lane + 64 * j];
            const f32x4 yA = hA[j] * rsA * w * (1.0f + aA) + bA, yB = hB[j] * rsB * w * (1.0f + aB) + bB;
            o8A[64 * j] = (unsigned)cvt4_fp8(yA.x, yA.y, yA.z, yA.w);
            if (hasB) o8B[64 * j] = (unsigned)cvt4_fp8(yB.x, yB.y, yB.z, yB.w);
#pragma unroll
            for (int c = 0; c < 4; ++c) { const f32x2 fA = (f32x2){yA[c], yA[c]}, fB = (f32x2){yB[c], yB[c]}; const LAS float* wr_ = WL + ((c + 4 * j) * 64 + F.lane) * 36;
#pragma unroll
                for (int q = 0; q < 8; ++q) { const f32x4 w4 = *(const LAS f32x4*)(wr_ + 4 * q); const f32x2 wl = (f32x2){w4.x, w4.y}, wh = (f32x2){w4.z, w4.w};
                    pA[2 * q] += fA * wl; pA[2 * q + 1] += fA * wh; pB[2 * q] += fB * wl; pB[2 * q + 1] += fB * wh; }
                asm volatile("" : "+v"(pA[0]), "+v"(pA[1]), "+v"(pA[2]), "+v"(pA[3]), "+v"(pA[4]), "+v"(pA[5]), "+v"(pA[6]), "+v"(pA[7]), "+v"(pA[8]), "+v"(pA[9]), "+v"(pA[10]), "+v"(pA[11]), "+v"(pA[12]), "+v"(pA[13]), "+v"(pA[14]), "+v"(pA[15]) :: "memory");
                asm volatile("" : "+v"(pB[0]), "+v"(pB[1]), "+v"(pB[2]), "+v"(pB[3]), "+v"(pB[4]), "+v"(pB[5]), "+v"(pB[6]), "+v"(pB[7]), "+v"(pB[8]), "+v"(pB[9]), "+v"(pB[10]), "+v"(pB[11]), "+v"(pB[12]), "+v"(pB[13]), "+v"(pB[14]), "+v"(pB[15]) :: "memory");
                __builtin_amdgcn_sched_barrier(0); }
        }
#pragma unroll 1
        for (int rr = 0; rr < (hasB ? 2 : 1); ++rr) {
            f32x2 pq[16];
#pragma unroll
            for (int e = 0; e < 16; ++e) pq[e] = rr ? pB[e] : pA[e];
            tok_finish(F, rr ? iB : i, i0, rr ? rB : rA, pq, rbias, prov, GATEp);
        }
    }
    __syncthreads();
    int* POSp = F.POS(); int* LISTp = F.LIST();
    if (F.tid < 32) F.MISC[MW_BASE + F.tid] = __hip_atomic_fetch_add(F.ctl() + CW_CNT + (layer * 32 + F.tid) * 64, F.MISC[MW_LCNT + F.tid], RLX_AGENT);
    __syncthreads();
    if (RPB * 4 <= PROV_CAP)
    for (int idx = F.tid; idx < (i1 - i0) * 4; idx += 512) {
        const unsigned pv = prov[idx]; const int e = (int)(pv >> 16), slot = (int)(pv & 0xffffu) + (int)F.MISC[MW_BASE + e];
        const int r = tok_row(layer, i0 + (idx >> 2));
        POSp[(size_t)r * 4 + (idx & 3)] = (e << 16) | slot;
        LISTp[(size_t)e * LIST_CAP + slot] = r;
    }
    __syncthreads();
}
__device__ __forceinline__ void p_combine(Frame& F, int layer) {
    moe_tables(F, layer);
    const int gw = F.vcu * NWAVES + F.wave, NGW = F.G * NWAVES, nrows = layer == 0 ? M : NB * SEQ;
    const float* MODp = F.MOD(); bf16* Hp = F.H(); const int* POSp = F.POS(); const float* GATEp = F.GATE(); const bf16* Yp = F.Y(); bf16* Ap = F.A(); float* outp = F.out();
    const float* n1w = F.norm1_w() + D; const float* fnw = F.final_norm_w();
    const int lane = F.lane;
#define CB_PG(i_, P_, G_) do { const int r_ = tok_row(layer, (i_)); _Pragma("unroll") for (int k = 0; k < 4; ++k) { P_[k] = POSp[(size_t)r_ * 4 + k]; G_[k] = GATEp[(size_t)r_ * 4 + k]; } } while (0)
#define CB_ISSUE(i_, P_, Y_, H_) do { const int r_ = tok_row(layer, (i_)); const GAS v2u* hq_ = (const GAS v2u*)(Hp + (size_t)r_ * D) + lane; \
        _Pragma("unroll") for (int j = 0; j < 4; ++j) H_[j] = hq_[64 * j]; \
        _Pragma("unroll") for (int k = 0; k < 4; ++k) { const int e_ = P_[k] >> 16, slot_ = P_[k] & 0xffff; const size_t prow_ = (size_t)F.MISC[MW_TST + e_] * 256 + slot_; \
            const GAS int* y8_ = (const GAS int*)((const unsigned char*)Yp + prow_ * D) + lane; \
            _Pragma("unroll") for (int j = 0; j < 4; ++j) Y_[k * 4 + j] = y8_[64 * j]; } } while (0)
#define CB_FINISH(i_, G_, Y_, H_) do { const int r_ = tok_row(layer, (i_)), v_ = row_v(r_); const float* mod_ = MODp + ((size_t)layer * 5 + v_) * 6144; \
        f32x4 h[4], acc[4]; \
        _Pragma("unroll") for (int j = 0; j < 4; ++j) { h[j] = (f32x4){bf2f(H_[j].x & 0xffffu), bf2f(H_[j].x >> 16), bf2f(H_[j].y & 0xffffu), bf2f(H_[j].y >> 16)}; acc[j] = (f32x4){0.f, 0.f, 0.f, 0.f}; } \
        _Pragma("unroll") for (int k = 0; k < 4; ++k) { const float g_ = G_[k]; \
            _Pragma("unroll") for (int j = 0; j < 4; ++j) { const int w_ = Y_[k * 4 + j]; acc[j].x += g_ * __builtin_amdgcn_cvt_f32_fp8(w_, 0); acc[j].y += g_ * __builtin_amdgcn_cvt_f32_fp8(w_, 1); \
                acc[j].z += g_ * __builtin_amdgcn_cvt_f32_fp8(w_, 2); acc[j].w += g_ * __builtin_amdgcn_cvt_f32_fp8(w_, 3); } } \
        _Pragma("unroll") for (int j = 0; j < 4; ++j) { const f32x4 g2 = ((const GAS f32x4*)(mod_ + 5120))[lane + 64 * j]; h[j] = h[j] + g2 * acc[j]; } \
        if (layer == 0) { bf16* hp_ = Hp + (size_t)r_ * D + lane * 4; \
            _Pragma("unroll") for (int j = 0; j < 4; ++j) st4bf(hp_ + 256 * j, h[j]); \
            const float* mod1 = MODp + ((size_t)5 + v_) * 6144; \
            norm_mod_row(h, n1w, mod1 + 1024, mod1, (bf16*)((unsigned char*)Ap + (size_t)r_ * D * (QKV1_FP8 ? 1 : 2)), lane, QKV1_FP8 != 0); \
        } else { float s_ = 0.f; \
            _Pragma("unroll") for (int j = 0; j < 4; ++j) s_ += (h[j].x * h[j].x + h[j].y * h[j].y) + (h[j].z * h[j].z + h[j].w * h[j].w); \
            const float rs_ = 1.0f / sqrtf(wave_sum(s_) * (1.0f / D) + EPS); \
            GAS f32x4* op_ = (GAS f32x4*)(outp + (size_t)(i_) * D) + lane; \
            _Pragma("unroll") for (int j = 0; j < 4; ++j) op_[64 * j] = h[j] * rs_ * ((const GAS f32x4*)fnw)[lane + 64 * j]; } } while (0)
    static_assert(Y_FP8, "the pipelined combine reads fp8 expert rows");
    int pA[4], pB[4]; float gA[4], gB[4], gC[4]; int yA[16], yB[16]; v2u hA[4], hB[4];
    int i = gw;
    if (i < nrows) { CB_PG(i, pA, gA); CB_ISSUE(i, pA, yA, hA); }
    if (i + NGW < nrows) CB_PG(i + NGW, pB, gB);
    for (; i < nrows; i += 2 * NGW) {
        const bool hasB = i + NGW < nrows, hasA2 = i + 2 * NGW < nrows, hasB2 = i + 3 * NGW < nrows;
        if (hasB) CB_ISSUE(i + NGW, pB, yB, hB);
        _Pragma("unroll") for (int k = 0; k < 4; ++k) gC[k] = gA[k];
        if (hasA2) CB_PG(i + 2 * NGW, pA, gA);
        CB_FINISH(i, gC, yA, hA);
        if (!hasB) break;
        if (hasA2) CB_ISSUE(i + 2 * NGW, pA, yA, hA);
        _Pragma("unroll") for (int k = 0; k < 4; ++k) gC[k] = gB[k];
        if (hasB2) CB_PG(i + 3 * NGW, pB, gB);
        CB_FINISH(i + NGW, gC, yB, hB);
    }
#undef CB_PG
#undef CB_ISSUE
#undef CB_FINISH
}

constexpr int N_PHASES = 21;
__global__ void __launch_bounds__(NWAVES * 64, 2) fwd(Args args) {
    extern __shared__ __attribute__((aligned(16))) unsigned char lds[];
    Frame F;
    F.lds = (LAS unsigned char*)lds;
    F.MISC = (volatile LAS unsigned*)(F.lds + MISC_OFF);
    F.tid = threadIdx.x; F.lane = F.tid & 63; F.wave = __builtin_amdgcn_readfirstlane(F.tid >> 6);
    F.G = gridDim.x; { const int bx = blockIdx.x; F.vcu = (F.G % 8 == 0) ? (bx % 8) * (F.G / 8) + bx / 8 : bx; }
    for (int u = F.tid; u < 256; u += NWAVES * 64) ((LAS unsigned*)(F.lds + MISC_OFF))[u] = 0u;
    __syncthreads();
    const int lo = args.ph_lo, hi = args.ph_hi;
    const bool one = (hi - lo) > 1;
    if (one) (void)xcd_barrier_post((unsigned*)(F.ctl() + CW_BAR), F.MISC + 8);
#define bar (XcdBarrier{(unsigned*)(F.ctl() + CW_BAR), xb_xcc_id(), F.MISC + 8, F.wave})
#ifndef PROBE_DUP
#define PROBE_DUP -1
#endif
#define IN(k) (phase_ids(F), (lo <= (k) && (k) < hi))
#define SEAM(k) do { if (IN(k) && IN((k) + 1)) xcd_barrier(bar); } while (0)

#define PH0_BODY p0_prologue(F);
    if (IN(0)) { PH0_BODY } if (PROBE_DUP == 0 && IN(0)) { PH0_BODY } SEAM(0);
    if (IN(1)) { p1_mod_reduce(F); } SEAM(1);
    if (IN(2)) { p_norm1(F, 0); } SEAM(2);
#define PH3_BODY    \
        DenseProb<EpiStoreBf16> P{F.A(), F.WIN(), D, MT, N_IN0 / 256, F.G, (int)blockIdx.x, false, EpiStoreBf16{F.QKV(), N_IN0, 1024, 1.0f, (ATTN_QK8 && ATTN_FP8PV && ATTN_FASTEXP) ? F.QK8() : nullptr, nullptr}}; \
        pg8::gemm_phase(F.lds, P, F.wave);
    if (IN(3)) { PH3_BODY } if (PROBE_DUP == 3 && IN(3)) { PH3_BODY } if (IN(3) && IN(5)) xcd_barrier(bar);
#if ATTN_FASTEXP && ATTN_QK8
#define ATTN_CALL attn_dv::attn8<4, 1024, 512, false>(F.QK8() + ((size_t)b * RB + qb * 256) * 1024 + (2 * h + cc) * 64, F.QK8() + (size_t)b * RB * 1024 + 512 + (2 * h + cc) * 64, F.VT8() + (size_t)((b * 4 + h) * 128) * RB, \
                F.OD() + (size_t)cc * M * 512 + ((size_t)b * RB + qb * 256) * 512 + h * 128, (qb == 0 ? CTXL : RB) / 64, 0, 0, 0.f, (char*)lds, F.wave);
#define ATTN_BODY8 attn_dense_body8x
#elif ATTN_FASTEXP
#define ATTN_BODY8 attn_dense_body8x
#else
#define ATTN_BODY8 attn_dense_body8
#endif
#if ATTN_FP8PV && ATTN_FASTEXP && ATTN_QK8
#elif ATTN_FP8PV
#define ATTN_CALL attn_dv::ATTN_BODY8<N_IN0, 512>(base + (size_t)qb * 256 * N_IN0 + C_DQ + (2 * h + cc) * 64, base + C_DK + (2 * h + cc) * 64, F.VT8() + (size_t)((b * 4 + h) * 128) * RB, \
                F.OD() + (size_t)cc * M * 512 + ((size_t)b * RB + qb * 256) * 512 + h * 128, qb == 0 ? CTXL : RB, (char*)lds, F.wave);
#else
#define ATTN_CALL attn_dv::attn_dense_body<N_IN0, 512>(base + (size_t)qb * 256 * N_IN0 + C_DQ + (2 * h + cc) * 64, base + C_DK + (2 * h + cc) * 64, base + C_DV + h * 128, \
                F.OD() + (size_t)cc * M * 512 + ((size_t)b * RB + qb * 256) * 512 + h * 128, qb == 0 ? CTXL : RB, (char*)lds, F.wave);
#endif
    if (ATTN_FP8PV && IN(4)) { p_vt8<4, 128, N_IN0, C_DV>(F, F.VT8()); __syncthreads();
        if (RET_V2) { p_tr16<4, 128, C_RV>(F, F.RVT()); p_tr16<4, 64, C_RK>(F, F.RKT()); } else for (int it = blockIdx.x; it < NB * 4 * NCH; it += F.G) ret_kv_item(F, it); }
    if (ATTN_FP8PV && IN(4) && IN(5)) xcd_barrier(bar);
#define PH5_BODY    \
        for (int u = F.vcu; u < 5 * 256; u += F.G) {      \
            const int combo = (u & 255) >> 3, sub = (u & 7) + 8 * (u >> 8); \
            if (sub > 32) continue; \
            const int b = combo >> 3, h = (combo >> 1) & 3, cc = combo & 1; \
            const int qb = sub < 32 ? sub + 1 : 0;                                   \
            const bf16* base = F.QKV() + (size_t)b * RB * N_IN0; \
            ATTN_CALL \
        } \
        __syncthreads(); \
        if (!ATTN_FP8PV) for (int it = blockIdx.x; it < NB * 4 * NCH; it += F.G) ret_kv_item(F, it); \
        if (ATTN_FP8PV && RET_V2) for (int it = blockIdx.x; it < NB * 4 * NCH; it += F.G) ret_kv_item2(F, it);
    if (IN(5)) { PH5_BODY } if (PROBE_DUP == 5 && IN(5)) { PH5_BODY } SEAM(5);
#define PH6_BODY p_ret_scan(F);
    if (IN(6)) { PH6_BODY } if (PROBE_DUP == 6 && IN(6)) { PH6_BODY } SEAM(6);
#define PH7_BODY for (int it = blockIdx.x; it < NB * 4 * NCH; it += F.G) { if (RET_V2) ret_out_item2(F, it); else ret_out_item(F, it); } p_dfinish(F);
    if (IN(7)) { PH7_BODY } if (PROBE_DUP == 7 && IN(7)) { PH7_BODY } SEAM(7);
    if (IN(8)) {
        DenseProb<EpiResid> P{F.CAT(), F.WOUT0(), D, MT, D / 256, F.G, (int)blockIdx.x, false, EpiResid{F.H(), F.MOD(), 2048, F.x(), F.ctx()}};
        pg8::gemm_phase(F.lds, P, F.wave);
    } SEAM(8);
    if (IN(9)) { p_token(F, 0); } SEAM(9);
#define PH10_BODY moe_tables(F, 0); Moe1Prob P{F.A(), F.W1T(), F.moe_b1(), F.LIST(), F.ACT(), F.MISC, D / 2, F.G, F.vcu}; pg8::gemm_phase(F.lds, P, F.wave);
    if (IN(10)) { PH10_BODY } if (PROBE_DUP == 10 && IN(10)) { PH10_BODY } SEAM(10);
#define PH11_BODY moe_tables(F, 0); Moe2Prob P{F.ACT(), F.W2T(), F.moe_b2(), F.Y(), F.MISC, DFF / 2, F.G, F.vcu}; pg8::gemm_phase(F.lds, P, F.wave);
    if (IN(11)) { PH11_BODY } if (PROBE_DUP == 11 && IN(11)) { PH11_BODY } SEAM(11);
    if (IN(12)) { p_combine(F, 0); } SEAM(12);
#define PH13_BODY   \
        DenseProb<EpiStoreBf16, QKV1_FP8 != 0> P{F.A(), F.WQKV1(), QKV1_FP8 ? D / 2 : D, MT, N_QKV1 / 256, F.G, (int)blockIdx.x, false, EpiStoreBf16{F.QKV(), N_QKV1, 1152, QKV1_FP8 ? W8_INV : 1.0f, SWA_FP8 ? F.QK8() : nullptr, SWA_FP8 ? F.K81() : nullptr}}; \
        pg8::gemm_phase(F.lds, P, F.wave);
    if (IN(13)) { PH13_BODY } if (PROBE_DUP == 13 && IN(13)) { PH13_BODY } if (IN(13) && IN(15)) xcd_barrier(bar);
    if (SWA_FP8 && IN(14)) { p_vt8<2, 64, N_QKV1, C_V1>(F, F.VT81()); }
    if (SWA_FP8 && IN(14) && IN(15)) xcd_barrier(bar);
#define PH15_BODY   \
        for (int u = F.vcu; u < 8 * 256; u += F.G) { \
            const int combo = (u & 255) >> 2, sub = (u & 3) + 4 * (u >> 8); \
            const int b = combo >> 4, hq = combo & 15, kv = hq >> 3, qb = sub + 1; \
            int bs = 4 * qb - 2; if (bs < 4) bs = 4; int be = 4 * qb + 6; if (be > RB / 64) be = RB / 64; \
            const bf16* base = F.QKV() + (size_t)b * RB * N_QKV1; \
            if (SWA_FP8) attn_dv::attn8<2, 128, D, true>(F.QK8() + ((size_t)b * RB + qb * 256) * 1024 + hq * 64, F.K81() + (size_t)b * RB * 128 + kv * 64, F.VT81() + (size_t)((b * 2 + kv) * 64) * RB, \
                F.OD() + ((size_t)b * RB + qb * 256) * D + hq * 64, 4 + (be - bs), bs - 4, qb * 256, F.sinks()[hq] * LOG2E, (char*)lds, F.wave); \
            else attn_body::attn_unit<N_QKV1, D, true, 8>(base + (size_t)qb * 256 * N_QKV1 + C_Q1 + hq * 64, base + C_K1 + kv * 64, base + C_V1 + kv * 64, \
                F.OD() + ((size_t)b * RB + qb * 256) * D + hq * 64, 4 + (be - bs), bs - 4, qb * 256, F.sinks()[hq] * LOG2E, (char*)lds, F.wave); \
        } \
        __syncthreads();
    if (IN(15)) { PH15_BODY } if (PROBE_DUP == 15 && IN(15)) { PH15_BODY } SEAM(15);
    if (IN(16)) {
        DenseProb<EpiResid> P{F.OD(), F.WOUT1(), D, NB * 32, D / 256, F.G, (int)blockIdx.x, true, EpiResid{F.H(), F.MOD() + 5 * 6144, 2048, nullptr, nullptr}};
        pg8::gemm_phase(F.lds, P, F.wave);
    } SEAM(16);
    if (IN(17)) { p_token(F, 1); } SEAM(17);
#define PH18_BODY moe_tables(F, 1); Moe1Prob P{F.A(), F.W1T() + (size_t)NEXP * 2048 * D / 2, F.moe_b1() + NEXP * 2048, F.LIST(), F.ACT(), F.MISC, D / 2, F.G, F.vcu}; pg8::gemm_phase(F.lds, P, F.wave);
    if (IN(18)) { PH18_BODY } if (PROBE_DUP == 18 && IN(18)) { PH18_BODY } SEAM(18);
#define PH19_BODY moe_tables(F, 1); Moe2Prob P{F.ACT(), F.W2T() + (size_t)NEXP * D * DFF / 2, F.moe_b2() + NEXP * D, F.Y(), F.MISC, DFF / 2, F.G, F.vcu}; pg8::gemm_phase(F.lds, P, F.wave);
    if (IN(19)) { PH19_BODY } if (PROBE_DUP == 19 && IN(19)) { PH19_BODY } SEAM(19);
#define PH20_BODY p_combine(F, 1);
    if (IN(20)) { PH20_BODY } if (PROBE_DUP == 20 && IN(20)) { PH20_BODY }
#undef IN
#undef SEAM
}

extern "C" void kernel_launch(void* const* d_in, const int* in_sizes, int n_in, void* d_out, int out_size, void* d_ws, size_t ws_size, hipStream_t stream) {
    static int grid = 0;
    if (grid == 0) {
        if (n_in != 24 || in_sizes[0] != NB * SEQ * D || out_size != NB * SEQ * D || ws_size < WS_END) {
            fprintf(stderr, "kernel_launch: unexpected shapes (n_in %d, in0 %d, out %d, ws %zu, need %zu); nothing launched\n", n_in, n_in > 0 ? in_sizes[0] : -1, out_size, ws_size, (size_t)WS_END); grid = -1; return; }
        int dev = 0, cus = 0, per_cu = 0;
        if (hipGetDevice(&dev) != hipSuccess || hipDeviceGetAttribute(&cus, hipDeviceAttributeMultiprocessorCount, dev) != hipSuccess) { grid = -1; return; }
        if (hipFuncSetAttribute((const void*)fwd, hipFuncAttributeMaxDynamicSharedMemorySize, LDS_TOTAL) != hipSuccess) { fprintf(stderr, "kernel_launch: hipFuncSetAttribute failed\n"); grid = -1; return; }
        if (hipOccupancyMaxActiveBlocksPerMultiprocessor(&per_cu, (const void*)fwd, NWAVES * 64, LDS_TOTAL) != hipSuccess || per_cu < 1)
            fprintf(stderr, "kernel_launch: note: occupancy query reports %d workgroups per CU\n", per_cu);
        (void)hipGetLastError();
        grid = cus;
    }
    if (grid < 0) return;
    if (hipMemsetAsync((char*)d_ws + WS_CTL, 0, CTL_ZERO_BYTES, stream) != hipSuccess) return;
    Args a{};
    for (int i = 0; i < 24; ++i) a.in[i] = (const float*)d_in[i];
    a.out = (float*)d_out; a.ws = (unsigned char*)d_ws;
#if MK_ONE_LAUNCH
    a.ph_lo = 0; a.ph_hi = N_PHASES;
    hipLaunchKernelGGL(fwd, dim3(grid), dim3(NWAVES * 64), LDS_TOTAL, stream, a);
#else
    for (int p = 0; p < N_PHASES; ++p) { a.ph_lo = p; a.ph_hi = p + 1; hipLaunchKernelGGL(fwd, dim3(grid), dim3(NWAVES * 64), LDS_TOTAL, stream, a); }
#endif
}
```

```cpp
#include <hip/hip_runtime.h>
#include <hip/hip_bf16.h>
#include <cstdio>
#include <cstdint>

#ifndef ATTN_FP8PV
#define ATTN_FP8PV 1
#endif
#ifndef QKV1_FP8
#define QKV1_FP8 1
#endif
#ifndef RET_V2
#define RET_V2 1
#endif
#ifndef SWA_FP8
#define SWA_FP8 1
#endif
#ifndef ATTN_QK8
#define ATTN_QK8 1
#endif
#ifndef Y_FP8
#define Y_FP8 1
#endif
#ifndef ATTN_FASTEXP
#define ATTN_FASTEXP 1
#endif
#ifndef MK_ONE_LAUNCH
#define MK_ONE_LAUNCH 1
#endif

#define GAS __attribute__((address_space(1)))
#define LAS __attribute__((address_space(3)))
typedef unsigned short bf16;
typedef unsigned v4u __attribute__((ext_vector_type(4)));
typedef unsigned v2u __attribute__((ext_vector_type(2)));
typedef float f32x4 __attribute__((ext_vector_type(4)));
typedef float f32x2 __attribute__((ext_vector_type(2)));
typedef float f32x16 __attribute__((ext_vector_type(16)));
typedef short bf16x8 __attribute__((ext_vector_type(8)));
typedef short s16x4 __attribute__((ext_vector_type(4)));
typedef int v8i __attribute__((ext_vector_type(8)));
typedef int v4i __attribute__((ext_vector_type(4)));
typedef GAS unsigned gu32;
#define RLX_AGENT __ATOMIC_RELAXED, __HIP_MEMORY_SCOPE_AGENT
#define LDS_WAIT() asm volatile("s_waitcnt lgkmcnt(0)" ::: "memory")
#define VM_WAIT() asm volatile("s_waitcnt vmcnt(0)" ::: "memory")

constexpr int NB = 4, SEQ = 8192, CTXL = 256, D = 1024;
constexpr int RB = SEQ + CTXL;
constexpr int M = NB * RB;
constexpr int TPB = RB / 256;
constexpr int MT = M / 256;
constexpr int NEXP = 32, DFF = 1024;
constexpr int N_IN0 = 3072, N_QKV1 = 1280;
constexpr int NCH = RB / 128;
constexpr float EPS = 1e-6f;
constexpr float LOG2E = 1.4426950408889634f;
constexpr float C2 = 0.125f * LOG2E;
constexpr int C_DQ = 0, C_DK = 512, C_DV = 1024, C_RQ = 1536, C_RK = 1792, C_RV = 2048, C_RG = 2560;
constexpr int C_Q1 = 0, C_K1 = 1024, C_V1 = 1152;
constexpr int MOE_CAP_ROWS = 143360;
constexpr int LIST_CAP = M;

constexpr size_t MiB = 1u << 20;
constexpr size_t WS_CTL = 0, CTL_ZERO_BYTES = 1 * MiB;
constexpr size_t WS_MODP = 1 * MiB;
constexpr size_t WS_MOD = 5 * MiB;
constexpr size_t WS_LIST = 6 * MiB;
constexpr size_t WS_POS = 11 * MiB;
constexpr size_t WS_GATE = 12 * MiB;
constexpr size_t WS_WIN = 13 * MiB;
constexpr size_t WS_WOUT0 = 19 * MiB;
constexpr size_t WS_WQKV1 = 21 * MiB;
constexpr size_t WS_WOUT1 = 24 * MiB;
constexpr size_t WS_H = 26 * MiB;
constexpr size_t WS_A = 158 * MiB;
constexpr size_t WS_QKV = 224 * MiB;
constexpr size_t WS_OD = 422 * MiB;
constexpr size_t WS_CAT = 488 * MiB;
constexpr size_t WS_CKV = 554 * MiB;
constexpr size_t WS_PREV = 620 * MiB;
constexpr size_t WS_ACT = 653 * MiB;
constexpr size_t WS_QK8 = 820 * MiB;
constexpr size_t WS_RVT = 880 * MiB;
constexpr size_t WS_RKT = 914 * MiB;
constexpr size_t WS_K81 = 860 * MiB;
constexpr size_t WS_VT81 = 870 * MiB;
constexpr size_t WS_VT8 = 800 * MiB;
constexpr size_t WS_Y = 933 * MiB;
constexpr size_t WS_W1T = 1213 * MiB;
constexpr size_t WS_W2T = 1469 * MiB;
constexpr size_t WS_END = 1597 * MiB;
static_assert(WS_H + (size_t)M * D * 4 <= WS_A && WS_A + (size_t)M * D * 2 <= WS_QKV && WS_QKV + (size_t)M * 3072 * 2 <= WS_OD, "ws map");
static_assert(WS_ACT + (size_t)MOE_CAP_ROWS * 1024 * 2 <= WS_Y && WS_Y + (size_t)MOE_CAP_ROWS * 1024 * 2 <= WS_W1T, "ws map 2");
constexpr int CW_TMO = 0;
constexpr int CW_MODC = 6144;
constexpr int CW_CNT = 1024;
constexpr int CW_BAR = 8192;

constexpr int RING_BYTES = 131072;
constexpr int ROUTER_LDS = 1024 * 36 * 4;
constexpr int MISC_OFF = ROUTER_LDS;
constexpr int LDS_BYTES = MISC_OFF + 1024;
constexpr int MW_TST = 16, MW_CNT = 64, MW_LCNT = 96, MW_BASE = 128;
constexpr int TILE_E_OFF = 131072 + 4096;

__device__ __forceinline__ int lane_id() { const int l = (int)__builtin_amdgcn_mbcnt_hi(~0u, __builtin_amdgcn_mbcnt_lo(~0u, 0u)); __builtin_assume(l >= 0 && l < 64); return l; }
__device__ __forceinline__ unsigned f2bf(float f) { unsigned u = __builtin_bit_cast(unsigned, f); return (u + 0x7fffu + ((u >> 16) & 1u)) >> 16; }
__device__ __forceinline__ float bf2f(unsigned b) { return __builtin_bit_cast(float, b << 16); }
__device__ __forceinline__ unsigned pk2(float lo, float hi) { return f2bf(lo) | (f2bf(hi) << 16); }
__device__ __forceinline__ unsigned cvt_pk_bf16(float lo, float hi) { unsigned r; asm volatile("v_cvt_pk_bf16_f32 %0, %1, %2" : "=v"(r) : "v"(lo), "v"(hi)); return r; }
__device__ __forceinline__ f32x4 ld4bf(const bf16* p) { const v2u u = *(const GAS v2u*)p; return (f32x4){bf2f(u.x & 0xffffu), bf2f(u.x >> 16), bf2f(u.y & 0xffffu), bf2f(u.y >> 16)}; }
__device__ __forceinline__ void st4bf(bf16* p, f32x4 v) { v2u u; u.x = pk2(v.x, v.y); u.y = pk2(v.z, v.w); *(GAS v2u*)p = u; }
__device__ __forceinline__ float wave_sum(float v) {
#pragma unroll
    for (int o = 1; o < 64; o <<= 1) v += __shfl_xor(v, o);
    return v;
}
__device__ __forceinline__ int cvt4_fp8(float a, float b, float c, float d) {
    int w = 0;
    w = __builtin_amdgcn_cvt_pk_fp8_f32(__builtin_amdgcn_fmed3f(a, -448.f, 448.f), __builtin_amdgcn_fmed3f(b, -448.f, 448.f), w, false);
    w = __builtin_amdgcn_cvt_pk_fp8_f32(__builtin_amdgcn_fmed3f(c, -448.f, 448.f), __builtin_amdgcn_fmed3f(d, -448.f, 448.f), w, true);
    return w;
}
constexpr float W8_SCALE = 256.0f, W8_INV = 1.0f / 256.0f;
__device__ __forceinline__ float fast_exp2(float x) { return __builtin_amdgcn_exp2f(x); }
__device__ __forceinline__ float sigmoidf_(float x) { return __builtin_amdgcn_rcpf(1.0f + __builtin_amdgcn_exp2f(-1.4426950408889634f * x)); }

namespace pg8 {
constexpr int BM = 256, BK = 64, HALF = 128, HTB = HALF * BK * 2, STAGE_BYTES = 8 * HTB, NXCD = 8, WGM = 8, BIAS_LDS_OFF = STAGE_BYTES;
__host__ __device__ __forceinline__ int lds_byte(int r, int c) { const int st = (r >> 4) * 2 + (c >> 5), rr = r & 15, cc = c & 31, ob = rr * 64 + cc * 2; return st * 1024 + (ob ^ (((ob >> 9) & 1) << 5)); }
__host__ __device__ __forceinline__ void stage_rc(int b, int& R, int& C) { const int st = b / 1024, sb = b % 1024, swz = sb ^ (((sb >> 9) & 1) << 5); R = (st >> 1) * 16 + swz / 64; C = (st & 1) * 32 + (swz % 64) / 2; }
__host__ __device__ __forceinline__ int perm32(int rho) { const int n = rho >> 4, i = rho & 15; return 8 * (i >> 2) + 4 * n + (i & 3); }
struct Unit { int pm, pn, e; };

template <class P>
__device__ __forceinline__ void gemm_phase(LAS unsigned char* lds, const P& S, const int wid) {
    __builtin_assume(wid >= 0 && wid < 8);
    const int lane = lane_id(), tid = wid * 64 + lane, wr = wid >> 2, wc = wid & 3, fr = lane & 15, fq = lane >> 4;
    const int K = S.K, nt = K / BK;
    int R[2], C[2]; unsigned voffB[2];
#pragma unroll
    for (int i = 0; i < 2; ++i) { stage_rc(tid * 16 + i * 8192, R[i], C[i]); const int Rb = P::PERM ? ((R[i] & ~31) + perm32(R[i] & 31)) : R[i]; voffB[i] = (unsigned)(Rb * K + C[i]) * 2u; }
    const size_t kstep = (size_t)(BK * 2);
    const size_t hstep = (size_t)HALF * K * 2;
    const unsigned ldsw = (unsigned)wid * 1024u;
    const int aoff = lds_byte(wr * 64 + fr, fq * 8), boff = lds_byte(wc * 32 + fr, fq * 8);
#define PG8_SA(b, h) (((b) * 2 + (h)) * HTB)
#define PG8_SB(b, h) ((4 + (b) * 2 + (h)) * HTB)
#define PG8_STAGE(bufoff, gbase, voff) do { _Pragma("unroll") for (int _i = 0; _i < 2; ++_i) \
        __builtin_amdgcn_global_load_lds((const unsigned*)((const char*)(gbase) + (voff)[_i]), (LAS unsigned*)(lds + (bufoff) + ldsw + _i * 8192), 16, 0, 0); } while (0)
#define PG8_LD8(p) ({ const v4i lo_ = *(const LAS v4i*)(p), hi_ = *(const LAS v4i*)((p) + 1024); (v8i){lo_[0], lo_[1], lo_[2], lo_[3], hi_[0], hi_[1], hi_[2], hi_[3]}; })
#define PG8_LDA(dst, b, h) do { if constexpr (P::FP8) { _Pragma("unroll") for (int m = 0; m < 4; ++m) dst##8[m] = PG8_LD8(lds + PG8_SA(b, h) + aoff + m * 2048); } \
        else { _Pragma("unroll") for (int m = 0; m < 4; ++m) _Pragma("unroll") for (int k = 0; k < 2; ++k) dst[m][k] = *(const LAS bf16x8*)(lds + PG8_SA(b, h) + aoff + m * 2048 + k * 1024); } } while (0)
#define PG8_LDB(dst, b, h) do { if constexpr (P::FP8) { _Pragma("unroll") for (int n = 0; n < 2; ++n) dst##8[n] = PG8_LD8(lds + PG8_SB(b, h) + boff + n * 2048); } \
        else { _Pragma("unroll") for (int n = 0; n < 2; ++n) _Pragma("unroll") for (int k = 0; k < 2; ++k) dst[n][k] = *(const LAS bf16x8*)(lds + PG8_SB(b, h) + boff + n * 2048 + k * 1024); } } while (0)
#define PG8_MMA(ai, bj, At, Bt) do { __builtin_amdgcn_s_setprio(1); \
        if constexpr (P::FP8) { _Pragma("unroll") for (int m = 0; m < 4; ++m) _Pragma("unroll") for (int n = 0; n < 2; ++n) \
            asm volatile("v_mfma_f32_16x16x128_f8f6f4 %0, %1, %2, %0" : "+v"(acc[ai][bj][m][n]) : "v"(Bt##8[n]), "v"(At##8[m]), "v"(scale1)); } \
        else { _Pragma("unroll") for (int m = 0; m < 4; ++m) _Pragma("unroll") for (int n = 0; n < 2; ++n) _Pragma("unroll") for (int k = 0; k < 2; ++k) \
            acc[ai][bj][m][n] = __builtin_amdgcn_mfma_f32_16x16x32_bf16(Bt[n][k], At[m][k], acc[ai][bj][m][n], 0, 0, 0); } \
        __builtin_amdgcn_s_setprio(0); } while (0)
#define PG8_WAIT_V(n) asm volatile("s_waitcnt vmcnt(" #n ")" ::: "memory")
#define PG8_WAIT_L(n) asm volatile("s_waitcnt lgkmcnt(" #n ")" ::: "memory")
#define PG8_BAR __builtin_amdgcn_s_barrier()
#define PG8_SCHED __builtin_amdgcn_sched_barrier(0)
    Unit cur, nxt; int ui = 0;
    if (!S.next(0, cur)) return;
    f32x4 acc[2][2][4][2];
#pragma unroll
    for (int a = 0; a < 2; ++a)
#pragma unroll
        for (int b = 0; b < 2; ++b)
#pragma unroll
            for (int m = 0; m < 4; ++m)
#pragma unroll
                for (int n = 0; n < 2; ++n) acc[a][b][m][n] = (f32x4){0.f, 0.f, 0.f, 0.f};
    const int scale1 = 0x7F7F7F7F;
    bf16x8 At[4][2], B0[2][2], B1[2][2]; v8i At8[4], B08[2], B18[2];
    unsigned aoc[2][2], aon[2][2];
    S.a_offs(cur, R, C, aoc);
#pragma unroll
    for (int h = 0; h < 2; ++h)
#pragma unroll
        for (int i = 0; i < 2; ++i) aoc[h][i] = S.a_fix(aoc[h][i], C[i]);
    const char* Ab = S.a_base();
    const char* cB = S.b_base(cur);
    if constexpr (P::NBIAS > 0) { if (wid == 0) __builtin_amdgcn_global_load_lds((const unsigned*)S.bias_src(cur, lane), (LAS unsigned*)(lds + BIAS_LDS_OFF), 16, 0, 0); }
    PG8_STAGE(PG8_SB(0, 0), cB, voffB); PG8_STAGE(PG8_SB(0, 1), cB + hstep, voffB); PG8_STAGE(PG8_SA(0, 0), Ab, aoc[0]); PG8_STAGE(PG8_SA(0, 1), Ab, aoc[1]);
    if (wr == 1) PG8_BAR;
    PG8_WAIT_V(2); PG8_BAR;
    PG8_STAGE(PG8_SB(1, 0), cB + kstep, voffB); PG8_STAGE(PG8_SA(1, 0), Ab + kstep, aoc[0]); PG8_STAGE(PG8_SB(1, 1), cB + hstep + kstep, voffB);
    PG8_WAIT_V(6); PG8_BAR;
    for (;;) {
        const bool has_next = S.next(ui + 1, nxt);
        if (has_next) S.a_offs(nxt, R, C, aon);
        else { aon[0][0] = aoc[0][0]; aon[0][1] = aoc[0][1]; aon[1][0] = aoc[1][0]; aon[1][1] = aoc[1][1]; }
        if constexpr (P::NBIAS > 0) { if (has_next && wid == 0) __builtin_amdgcn_global_load_lds((const unsigned*)S.bias_src(nxt, lane), (LAS unsigned*)(lds + BIAS_LDS_OFF + ((ui + 1) % 3) * 1024), 16, 0, 0); }
        const char* nB = has_next ? S.b_base(nxt) : cB;
#pragma unroll 1
        for (int t = 0; t < nt; t += 2) {
            const bool last = (t == nt - 2);
            const char* a1 = Ab + (size_t)(t + 1) * kstep;
            const char* a2 = last ? Ab : Ab + (size_t)(t + 2) * kstep; const char* b2 = last ? nB : cB + (size_t)(t + 2) * kstep;
            const char* a3 = a2 + kstep; const char* b3 = b2 + kstep;
            unsigned o2[2][2];
            o2[0][0] = aoc[0][0]; o2[0][1] = aoc[0][1]; o2[1][0] = aoc[1][0]; o2[1][1] = aoc[1][1];
            if (last && has_next) {
#pragma unroll
                for (int h = 0; h < 2; ++h)
#pragma unroll
                    for (int i = 0; i < 2; ++i) { unsigned x = aon[h][i]; asm volatile("" : "+v"(x)); aon[h][i] = S.a_fix(x, C[i]); o2[h][i] = aon[h][i]; }
            }
            PG8_LDB(B0, 0, 0); PG8_LDB(B1, 0, 1); PG8_SCHED; PG8_LDA(At, 0, 0); PG8_STAGE(PG8_SA(1, 1), a1, aoc[1]);
            PG8_WAIT_V(8); PG8_WAIT_L(0); PG8_BAR; PG8_MMA(0, 0, At, B0); PG8_MMA(0, 1, At, B1); PG8_BAR; PG8_SCHED;
            PG8_LDA(At, 0, 1); PG8_STAGE(PG8_SB(0, 0), b2, voffB); PG8_STAGE(PG8_SB(0, 1), b2 + hstep, voffB); PG8_STAGE(PG8_SA(0, 0), a2, o2[0]);
            PG8_WAIT_V(8); PG8_WAIT_L(0); PG8_BAR; PG8_MMA(1, 0, At, B0); PG8_MMA(1, 1, At, B1); PG8_BAR; PG8_SCHED;
            PG8_LDB(B0, 1, 0); PG8_LDB(B1, 1, 1); PG8_SCHED; PG8_LDA(At, 1, 0); PG8_STAGE(PG8_SA(0, 1), a2, o2[1]);
            PG8_WAIT_V(8); PG8_WAIT_L(0); PG8_BAR; PG8_MMA(0, 0, At, B0); PG8_MMA(0, 1, At, B1); PG8_BAR; PG8_SCHED;
            PG8_LDA(At, 1, 1); PG8_STAGE(PG8_SB(1, 0), b3, voffB); PG8_STAGE(PG8_SB(1, 1), b3 + hstep, voffB); PG8_STAGE(PG8_SA(1, 0), a3, o2[0]);
            PG8_WAIT_V(8); PG8_WAIT_L(0); PG8_BAR; PG8_MMA(1, 0, At, B0); PG8_MMA(1, 1, At, B1); PG8_BAR; PG8_SCHED;
        }
        if (wr == 0) PG8_BAR;
        if constexpr (P::FP8) asm volatile("s_nop 15\n\ts_nop 15" ::: "memory");
        S.epi(acc, cur, wr, wc, fr, fq, (const LAS float*)(lds + BIAS_LDS_OFF + (ui % 3) * 1024));
        if (!has_next) break;
#pragma unroll
        for (int a = 0; a < 2; ++a)
#pragma unroll
            for (int b = 0; b < 2; ++b)
#pragma unroll
                for (int m = 0; m < 4; ++m)
#pragma unroll
                    for (int n = 0; n < 2; ++n) acc[a][b][m][n] = (f32x4){0.f, 0.f, 0.f, 0.f};
        cur = nxt; cB = nB; ++ui;
        aoc[0][0] = aon[0][0]; aoc[0][1] = aon[0][1]; aoc[1][0] = aon[1][0]; aoc[1][1] = aon[1][1];
        if (wr == 1) PG8_BAR;
    }
    PG8_WAIT_V(0);
    PG8_BAR;
#undef PG8_SA
#undef PG8_SB
#undef PG8_STAGE
#undef PG8_LDA
#undef PG8_LDB
#undef PG8_MMA
#undef PG8_WAIT_V
#undef PG8_WAIT_L
#undef PG8_BAR
#undef PG8_SCHED
}
}

namespace attn_body {
constexpr int NW = 8, QBLK = 32, QB = QBLK * NW, KVBLK = 64;
__device__ __forceinline__ int crow(int r, int hi) { return (r & 3) + 8 * (r >> 2) + 4 * hi; }
#define SBAR() __builtin_amdgcn_sched_barrier(0)
__device__ __forceinline__ void wmask(f32x16& p0, f32x16& p1, int dbase, int hi) {
    const float NEG = -INFINITY; const int kb = dbase + 4 * hi;
#pragma unroll
    for (int r = 0; r < 16; ++r) { const int d0 = kb + (r & 3) + 8 * (r >> 2); if (d0 > 128 || d0 < -128) p0[r] = NEG; const int d1 = d0 + 32; if (d1 > 128 || d1 < -128) p1[r] = NEG; }
}
constexpr int NSLOT = 3, SLOTB = 8192;
constexpr int LDS_K = 0, LDS_V = NSLOT * SLOTB, LDS_WS = 2 * NSLOT * SLOTB, LDS_OST = LDS_WS + NW * 64 * 4, LDS_BYTES = LDS_OST + NW * 4096;
__device__ __forceinline__ void glds16(const void* gsrc, unsigned lds_dst) { unsigned keep;
    asm volatile("s_mov_b32 %0, m0\n\ts_mov_b32 m0, %2\n\ts_nop 0\n\tglobal_load_lds_dwordx4 %1, off\n\ts_mov_b32 m0, %0" : "=&s"(keep) : "v"(gsrc), "s"(lds_dst) : "memory"); }
__device__ __forceinline__ float max3f(float a, float b, float c) { float r; asm("v_max3_f32 %0, %1, %2, %3" : "=v"(r) : "v"(a), "v"(b), "v"(c)); return r; }
__device__ __forceinline__ float max2f(float a, float b) { float r; asm("v_max_f32_e32 %0, %1, %2" : "=v"(r) : "v"(a), "v"(b)); return r; }
__device__ __forceinline__ float fadd_s(float a, float b) { float r; asm("v_add_f32_e32 %0, %1, %2" : "=v"(r) : "v"(a), "v"(b)); return r; }
__device__ __forceinline__ float fsub_s(float a, float b) { float r; asm("v_sub_f32_e32 %0, %1, %2" : "=v"(r) : "v"(a), "v"(b)); return r; }
typedef float f32x2_t __attribute__((ext_vector_type(2))); typedef __bf16 bf16x2_t __attribute__((ext_vector_type(2)));
__device__ __forceinline__ unsigned cvtpk_s(float lo, float hi) { f32x2_t v = {lo, hi}; bf16x2_t b = __builtin_convertvector(v, bf16x2_t); return __builtin_bit_cast(unsigned, b); }
#define WAIT_BAR(N) asm volatile("s_waitcnt vmcnt(" #N ") lgkmcnt(0)\n\ts_barrier" ::: "memory")

__device__ __forceinline__ void qkt(f32x16& p0, f32x16& p1, const char* Kslot, const bf16x8* qr, const f32x16& negm, int r32, int hi) {
    const char* kb = Kslot + hi * 1024 + r32 * 16;
#pragma unroll
    for (int d0 = 0; d0 < 4; ++d0) {
        const bf16x8 b0 = *reinterpret_cast<const bf16x8*>(kb + d0 * 2048);
        const bf16x8 b1 = *reinterpret_cast<const bf16x8*>(kb + d0 * 2048 + 512);
        if (d0 == 0) { p0 = __builtin_amdgcn_mfma_f32_32x32x16_bf16(b0, qr[0], negm, 0, 0, 0); p1 = __builtin_amdgcn_mfma_f32_32x32x16_bf16(b1, qr[0], negm, 0, 0, 0); }
        else { p0 = __builtin_amdgcn_mfma_f32_32x32x16_bf16(b0, qr[d0], p0, 0, 0, 0); p1 = __builtin_amdgcn_mfma_f32_32x32x16_bf16(b1, qr[d0], p1, 0, 0, 0); } }
}
typedef __attribute__((address_space(3))) const char* lds_cptr;
typedef short v4i16_t __attribute__((ext_vector_type(4)));
__device__ __forceinline__ void kload8(bf16x8* kf, lds_cptr kp) {
    kf[0] = *(const LAS bf16x8*)(kp);        kf[1] = *(const LAS bf16x8*)(kp + 512);
    kf[2] = *(const LAS bf16x8*)(kp + 2048); kf[3] = *(const LAS bf16x8*)(kp + 2560);
    kf[4] = *(const LAS bf16x8*)(kp + 4096); kf[5] = *(const LAS bf16x8*)(kp + 4608);
    kf[6] = *(const LAS bf16x8*)(kp + 6144); kf[7] = *(const LAS bf16x8*)(kp + 6656);
}
__device__ __forceinline__ void kload2(bf16x8* kf, lds_cptr kp, int j) { kf[2 * j] = *(const LAS bf16x8*)(kp + j * 2048); kf[2 * j + 1] = *(const LAS bf16x8*)(kp + j * 2048 + 512); }
__device__ __forceinline__ s16x4 vtr(lds_cptr p) { return __builtin_bit_cast(s16x4, __builtin_amdgcn_ds_read_tr16_b64_v4i16((LAS v4i16_t*)p)); }
__device__ __forceinline__ float rowmax(const f32x16& p0, const f32x16& p1) {
    float a = max3f(p0[0], p0[1], p1[0]), b = max3f(p0[2], p0[3], p1[1]); a = max3f(a, p1[2], p1[3]);
#pragma unroll
    for (int r = 4; r < 16; r += 4) { a = max3f(a, p0[r], p0[r + 1]); b = max3f(b, p0[r + 2], p0[r + 3]); a = max3f(a, p1[r], p1[r + 1]); b = max3f(b, p1[r + 2], p1[r + 3]); }
    const float m = max2f(a, b);
    auto rr = __builtin_amdgcn_permlane32_swap(__float_as_uint(m), __float_as_uint(m), false, false);
    return max2f(__uint_as_float(rr[0]), __uint_as_float(rr[1]));
}
__device__ __forceinline__ void pv(f32x16* o, int vb, bf16x8 pa0, bf16x8 pa1, bf16x8 pa2, bf16x8 pa3) {
#pragma unroll
    for (int d0 = 0; d0 < 2; ++d0) { s16x4 lo[4], hi[4];
#pragma unroll
        for (int ks = 0; ks < 4; ++ks) {
            asm volatile("ds_read_b64_tr_b16 %0,%1 offset:%c2" : "=&v"(lo[ks]) : "v"(vb), "i"(d0 * 4096 + ks * 1024) : "memory");
            asm volatile("ds_read_b64_tr_b16 %0,%1 offset:%c2" : "=&v"(hi[ks]) : "v"(vb), "i"(d0 * 4096 + ks * 1024 + 512) : "memory"); }
        asm volatile("s_waitcnt lgkmcnt(0)" ::: "memory"); SBAR();
#define PK(k) (bf16x8){lo[k][0], lo[k][1], lo[k][2], lo[k][3], hi[k][0], hi[k][1], hi[k][2], hi[k][3]}
        o[d0] = __builtin_amdgcn_mfma_f32_32x32x16_bf16(pa0, PK(0), o[d0], 0, 0, 0);
        o[d0] = __builtin_amdgcn_mfma_f32_32x32x16_bf16(pa1, PK(1), o[d0], 0, 0, 0);
        o[d0] = __builtin_amdgcn_mfma_f32_32x32x16_bf16(pa2, PK(2), o[d0], 0, 0, 0);
        o[d0] = __builtin_amdgcn_mfma_f32_32x32x16_bf16(pa3, PK(3), o[d0], 0, 0, 0);
#undef PK
    }
}

template <int PITCH, int OPITCH, bool SWA, int THRL>
__device__ __forceinline__ void attn_unit(const bf16* Q0, const bf16* __restrict__ Kh, const bf16* __restrict__ Vh, bf16* O0, int NT, int boff, int qrow0, float sinkl2, char* shm, const int wid) {
    const int lane = lane_id(), tid = wid * 64 + lane, r32 = lane & 31, hi = lane >> 5;
    const bf16* Qw = Q0 + (long)(wid * QBLK) * PITCH;
    const unsigned lds0 = (unsigned)(uintptr_t)shm;
    float* wsf = (float*)(shm + LDS_WS) + wid * 64;
    const bf16* ksrc = Kh + (long)lane * PITCH + wid * 8;
    const bf16* vsrc = Vh + (long)(16 * (wid & 3) + (lane >> 2)) * PITCH + (wid >> 2) * 32 + (lane & 3) * 8;
    const unsigned kdst = lds0 + LDS_K + wid * 1024, vdst = lds0 + LDS_V + wid * 1024;
#define TILE(t) (((t) < 4) ? (t) : ((t) + boff))
#define DMA_K(t, slot) glds16(ksrc + (long)TILE(t) * KVBLK * PITCH, (unsigned)__builtin_amdgcn_readfirstlane(kdst + (slot)))
#define DMA_V(t, slot) glds16(vsrc + (long)TILE(t) * KVBLK * PITCH, (unsigned)__builtin_amdgcn_readfirstlane(vdst + (slot)))
    const int vb0 = (int)(lds0 + LDS_V) + ((lane >> 4) & 1) * 32 + (lane & 3) * 8 + (4 * hi + ((lane & 15) >> 2)) * 64;
    const char* Kbase = shm + LDS_K; bf16x8 kf[8];
    const lds_cptr shm3 = (lds_cptr)shm; const lds_cptr kp0 = shm3 + LDS_K + hi * 1024 + r32 * 16; const lds_cptr vp0 = shm3 + LDS_V + ((lane >> 4) & 1) * 32 + (lane & 3) * 8 + (4 * hi + ((lane & 15) >> 2)) * 64;
    DMA_K(0, 0); DMA_V(0, 0); DMA_K(1, SLOTB);
    bf16x8 qr[4];
#pragma unroll
    for (int d0 = 0; d0 < 4; ++d0) qr[d0] = *reinterpret_cast<const bf16x8*>(&Qw[(long)r32 * PITCH + d0 * 16 + hi * 8]);
    float mhat = 0.f, l_reg = 0.f; f32x16 o[2]; o[0] = f32x16{}; o[1] = f32x16{}; f32x16 negm = f32x16{}; asm volatile("" : "+v"(negm));
    const int qrel = qrow0 + wid * QBLK + r32;
#define AMASK(P0, P1, t) do { if (SWA) { if ((t) >= 4) wmask(P0, P1, 64 * TILE(t) - qrel, hi); } } while (0)
    bool resc = false;
#define START(P0, P1) do { const float rm = rowmax(P0, P1); resc = false; \
    { const float dl = rm; mhat = fadd_s(mhat, dl); \
      _Pragma("unroll") for (int r = 0; r < 16; ++r) { P0[r] = fsub_s(P0[r], dl); P1[r] = fsub_s(P1[r], dl); } \
      _Pragma("unroll") for (int r = 0; r < 16; ++r) negm[r] = -mhat; asm volatile("" : "+v"(negm)); } \
    _Pragma("unroll") for (int r = 0; r < 16; ++r) P0[r] = __builtin_amdgcn_exp2f(P0[r]); } while (0)
#define RESC() do { if (resc) { asm volatile("s_waitcnt lgkmcnt(0)" ::: "memory"); \
      _Pragma("unroll") for (int d_ = 0; d_ < 2; ++d_) _Pragma("unroll") for (int r = 0; r < 16; ++r) o[d_][r] *= wsf[crow(r, hi)]; } } while (0)
    f32x16 pA0, pA1, pB0, pB1;
    int sl_prev = 0, sl_cur = 0, sl_next = SLOTB;
#define ROT() do { sl_prev = sl_cur; sl_cur = sl_next; sl_next = (sl_next == (NSLOT - 1) * SLOTB) ? 0 : sl_next + SLOTB; } while (0)
    DMA_K(2, 2 * SLOTB);
    WAIT_BAR(3);
    qkt(pA0, pA1, Kbase, qr, negm, r32, hi); asm volatile("s_nop 15\n\ts_nop 7" : "+v"(pA0), "+v"(pA1)); AMASK(pA0, pA1, 0);
    START(pA0, pA1);
    _Pragma("unroll") for (int r = 0; r < 16; ++r) pA1[r] = __builtin_amdgcn_exp2f(pA1[r]);
    WAIT_BAR(0);
    DMA_K(3, 0); DMA_V(1, SLOTB);
    ROT();
    kload8(kf, kp0 + sl_cur);
    WAIT_BAR(2);
    s16x4 vlo[8], vhi[8]; v4u pw0, pw1, pw2, pw3;
#define PKW(P, B) cvtpk_s(P[B], P[B + 1])
#define PAF(k) __builtin_bit_cast(bf16x8, pw##k)
#define VFR(i) (bf16x8){vlo[i][0], vlo[i][1], vlo[i][2], vlo[i][3], vhi[i][0], vhi[i][1], vhi[i][2], vhi[i][3]}
#define PIN(x) asm volatile("" : "+v"(x))
#define MX3(a, b, c) __builtin_fmaxf(__builtin_fmaxf((a), (b)), (c))
#define GAPA(MF, A0, A1, A2, A3, W0, W1, PW) do { MF; sacc += A0; sacc += A1; sacc += A2; sacc += A3; PIN(sacc); W0; W1; PIN(PW); SBAR(); } while (0)
#define EX(v) __builtin_amdgcn_exp2f(v)
#define GAPB(MF, X, B) do { MF; X[B] = EX(X[B]); X[B + 1] = EX(X[B + 1]); X[B + 2] = EX(X[B + 2]); X[B + 3] = EX(X[B + 3]); PIN(X); SBAR(); } while (0)
#define VRD(i) do { vlo[i] = vtr(vp_ + (((i) >> 2) * 4096 + ((i) & 3) * 1024)); vhi[i] = vtr(vp_ + (((i) >> 2) * 4096 + ((i) & 3) * 1024 + 512)); } while (0)
#define KRD(G, j) do { if (G) { kload2(kf, kp0 + sl_next, j); SBAR(); } } while (0)
#define STEP(C0, C1, P0, P1, t, GK, GV, GL) do { SBAR(); \
    const lds_cptr vp_ = vp0 + sl_prev; \
    VRD(0); SBAR(); float sacc = (P0[0] + P0[1]); \
    GAPA(C0 = __builtin_amdgcn_mfma_f32_32x32x16_bf16(kf[0], qr[0], negm, 0, 0, 0), P0[2], P0[3], P0[4], P0[5],     pw0[0] = PKW(P0, 0), pw0[1] = PKW(P0, 2), pw0); \
    VRD(4); SBAR(); GAPA(C1 = __builtin_amdgcn_mfma_f32_32x32x16_bf16(kf[1], qr[0], negm, 0, 0, 0), P0[6], P0[7], P0[8], P0[9],     pw0[2] = PKW(P0, 4), pw0[3] = PKW(P0, 6), pw0); \
    VRD(1); SBAR(); GAPA(C0 = __builtin_amdgcn_mfma_f32_32x32x16_bf16(kf[2], qr[1], C0, 0, 0, 0),   P0[10], P0[11], P0[12], P0[13], pw1[0] = PKW(P0, 8), pw1[1] = PKW(P0, 10), pw1); \
    VRD(5); SBAR(); GAPA(C1 = __builtin_amdgcn_mfma_f32_32x32x16_bf16(kf[3], qr[1], C1, 0, 0, 0),   P0[14], P0[15], P1[0], P1[1],   pw1[2] = PKW(P0, 12), pw1[3] = PKW(P0, 14), pw1); \
    VRD(2); SBAR(); GAPA(C0 = __builtin_amdgcn_mfma_f32_32x32x16_bf16(kf[4], qr[2], C0, 0, 0, 0),   P1[2], P1[3], P1[4], P1[5],     pw2[0] = PKW(P1, 0), pw2[1] = PKW(P1, 2), pw2); \
    VRD(6); SBAR(); GAPA(C1 = __builtin_amdgcn_mfma_f32_32x32x16_bf16(kf[5], qr[2], C1, 0, 0, 0),   P1[6], P1[7], P1[8], P1[9],     pw2[2] = PKW(P1, 4), pw2[3] = PKW(P1, 6), pw2); \
    VRD(3); SBAR(); GAPA(C0 = __builtin_amdgcn_mfma_f32_32x32x16_bf16(kf[6], qr[3], C0, 0, 0, 0),   P1[10], P1[11], P1[12], P1[13], pw3[0] = PKW(P1, 8), pw3[1] = PKW(P1, 10), pw3); \
    VRD(7); SBAR(); GAPA(C1 = __builtin_amdgcn_mfma_f32_32x32x16_bf16(kf[7], qr[3], C1, 0, 0, 0),   P1[14], P1[15], 0.f, 0.f,       pw3[2] = PKW(P1, 12), pw3[3] = PKW(P1, 14), pw3); \
    l_reg += sacc; \
    if (GK) { DMA_K((t) + 3, sl_cur); } if (GV) { DMA_V((t) + 1, sl_next); } \
    AMASK(C0, C1, t); \
    { float a = MX3(C0[0], C0[1], C1[0]), b = MX3(C0[2], C0[3], C1[1]); a = MX3(a, C1[2], C1[3]); \
      _Pragma("unroll") for (int r = 4; r < 16; r += 4) { a = MX3(a, C0[r], C0[r + 1]); b = MX3(b, C0[r + 2], C0[r + 3]); a = MX3(a, C1[r], C1[r + 1]); b = MX3(b, C1[r + 2], C1[r + 3]); } \
      float rm = __builtin_fmaxf(a, b); { auto rr = __builtin_amdgcn_permlane32_swap(__float_as_uint(rm), __float_as_uint(rm), false, false); rm = __builtin_fmaxf(__uint_as_float(rr[0]), __uint_as_float(rr[1])); } \
      resc = false; \
      if (__builtin_expect(__any(rm > (float)THRL), 0)) { const float dl = __builtin_fmaxf(rm, 0.f); mhat += dl; \
        _Pragma("unroll") for (int r = 0; r < 16; ++r) { C0[r] -= dl; C1[r] -= dl; } \
        _Pragma("unroll") for (int r = 0; r < 16; ++r) negm[r] = -mhat; asm volatile("" : "+v"(negm)); \
        const float f = __builtin_amdgcn_exp2f(-dl); l_reg *= f; if (hi == 0) wsf[r32] = f; resc = true; } } \
    SBAR(); \
    GAPB(o[0] = __builtin_amdgcn_mfma_f32_32x32x16_bf16(PAF(0), VFR(0), o[0], 0, 0, 0), C0, 0); \
    GAPB(o[1] = __builtin_amdgcn_mfma_f32_32x32x16_bf16(PAF(0), VFR(4), o[1], 0, 0, 0), C0, 4); \
    KRD(GL, 0); GAPB(o[0] = __builtin_amdgcn_mfma_f32_32x32x16_bf16(PAF(1), VFR(1), o[0], 0, 0, 0), C0, 8); \
    KRD(GL, 1); GAPB(o[1] = __builtin_amdgcn_mfma_f32_32x32x16_bf16(PAF(1), VFR(5), o[1], 0, 0, 0), C0, 12); \
    KRD(GL, 2); GAPB(o[0] = __builtin_amdgcn_mfma_f32_32x32x16_bf16(PAF(2), VFR(2), o[0], 0, 0, 0), C1, 0); \
    KRD(GL, 3); GAPB(o[1] = __builtin_amdgcn_mfma_f32_32x32x16_bf16(PAF(2), VFR(6), o[1], 0, 0, 0), C1, 4); \
    GAPB(o[0] = __builtin_amdgcn_mfma_f32_32x32x16_bf16(PAF(3), VFR(3), o[0], 0, 0, 0), C1, 8); \
    GAPB(o[1] = __builtin_amdgcn_mfma_f32_32x32x16_bf16(PAF(3), VFR(7), o[1], 0, 0, 0), C1, 12); \
    } while (0)
    int t = 1;
    for (; t + 5 < NT; t += 2) {
        STEP(pB0, pB1, pA0, pA1, t, true, true, true);     WAIT_BAR(2); RESC(); ROT();
        STEP(pA0, pA1, pB0, pB1, t + 1, true, true, true); WAIT_BAR(2); RESC(); ROT();
    }
#define ENDW(tt) do { if ((tt) + 3 < NT) { WAIT_BAR(2); } else if ((tt) + 2 < NT) { WAIT_BAR(1); } else { WAIT_BAR(0); } } while (0)
    for (; t + 1 < NT; t += 2) {
        STEP(pB0, pB1, pA0, pA1, t, (t + 3 < NT), (t + 1 < NT), (t + 1 < NT));       ENDW(t);     RESC(); ROT();
        STEP(pA0, pA1, pB0, pB1, t + 1, (t + 4 < NT), (t + 2 < NT), (t + 2 < NT));   ENDW(t + 1); RESC(); ROT();
    }
    STEP(pB0, pB1, pA0, pA1, NT - 1, false, false, false); RESC();
    { float sacc = pB0[0] + pB0[1]; _Pragma("unroll") for (int r = 2; r < 16; ++r) sacc += pB0[r]; _Pragma("unroll") for (int r = 0; r < 16; ++r) sacc += pB1[r]; l_reg += sacc;
      pw0 = (v4u){PKW(pB0, 0), PKW(pB0, 2), PKW(pB0, 4), PKW(pB0, 6)}; pw1 = (v4u){PKW(pB0, 8), PKW(pB0, 10), PKW(pB0, 12), PKW(pB0, 14)}; pw2 = (v4u){PKW(pB1, 0), PKW(pB1, 2), PKW(pB1, 4), PKW(pB1, 6)}; pw3 = (v4u){PKW(pB1, 8), PKW(pB1, 10), PKW(pB1, 12), PKW(pB1, 14)};
      SBAR(); pv(o, vb0 + sl_cur, PAF(0), PAF(1), PAF(2), PAF(3)); }
#undef PKW
#undef PAF
#undef VFR
#undef PIN
#undef MX3
#undef GAPA
#undef GAPB
#undef EX
#undef VRD
#undef KRD
#undef STEP
#undef ENDW
    { auto rr = __builtin_amdgcn_permlane32_swap(__float_as_uint(l_reg), __float_as_uint(l_reg), false, false); l_reg = __uint_as_float(rr[0]) + __uint_as_float(rr[1]); }
    if (SWA) l_reg += __builtin_amdgcn_exp2f(sinkl2 - mhat);
    if (hi == 0) wsf[32 + r32] = l_reg; asm volatile("s_waitcnt lgkmcnt(0)" ::: "memory");
    float rli[16];
#pragma unroll
    for (int r = 0; r < 16; ++r) rli[r] = __builtin_amdgcn_rcpf(wsf[32 + crow(r, hi)]);
    bf16* Ow = O0 + (long)(wid * QBLK) * OPITCH;
    { bf16* stg = (bf16*)(shm + LDS_OST) + wid * 2048;
#pragma unroll
      for (int r = 0; r < 16; ++r) { const int orow = crow(r, hi);
#pragma unroll
        for (int d0 = 0; d0 < 2; ++d0) stg[orow * 64 + d0 * 32 + r32] = (bf16)f2bf(o[d0][r] * rli[r]); }
      asm volatile("s_waitcnt lgkmcnt(0)" ::: "memory");
#pragma unroll
      for (int i = 0; i < 4; ++i) { const int row = i * 8 + (lane >> 3), ch = lane & 7; const v4u v = *(const v4u*)(stg + row * 64 + ch * 8); *(v4u*)(Ow + (long)row * OPITCH + ch * 8) = v; } }
    asm volatile("s_waitcnt lgkmcnt(0)\n\ts_barrier" ::: "memory");
#undef DMA_K
#undef DMA_V
#undef TILE
#undef AMASK
#undef START
#undef RESC
#undef ROT
}
#undef SBAR
#undef WAIT_BAR
}

namespace attn_dv {
constexpr int NW = 8, QBLK = 32, KVBLK = 64;
constexpr int SHM_V = KVBLK * 128 * 2, SHM_K = KVBLK * 64 * 2, SHM_ATTN = 2 * SHM_V + 2 * SHM_K + NW * 64 * 4;
constexpr float THR = 8.f;
#define KSWZ64(row, colB) ((row) * 128 + ((colB) ^ ((((row) >> 1) & 7) << 4)))
#define SBAR() __builtin_amdgcn_sched_barrier(0)
__device__ __forceinline__ int crow(int r, int hi) { return (r & 3) + 8 * (r >> 2) + 4 * hi; }
__device__ __forceinline__ unsigned cvtpk(float lo, float hi) { unsigned r; asm volatile("v_cvt_pk_bf16_f32 %0, %1, %2" : "=v"(r) : "v"(lo), "v"(hi)); return r; }
__device__ __forceinline__ void partialSM(f32x16& p0, f32x16& p1, float& m_reg, float& mn, float& alpha) {
    float pmax = p0[0];
#pragma unroll
    for (int r = 1; r < 16; ++r) pmax = fmaxf(pmax, p0[r]);
#pragma unroll
    for (int r = 0; r < 16; ++r) pmax = fmaxf(pmax, p1[r]);
    { auto rr = __builtin_amdgcn_permlane32_swap(__float_as_uint(pmax), __float_as_uint(pmax), false, false); pmax = fmaxf(__uint_as_float(rr[0]), __uint_as_float(rr[1])); }
    if (__builtin_expect(__all(pmax - m_reg <= THR), 1)) { mn = m_reg; alpha = 1.f; }
    else { mn = fmaxf(m_reg, pmax); alpha = __builtin_amdgcn_exp2f(m_reg - mn); m_reg = mn; }
#pragma unroll
    for (int r = 0; r < 16; ++r) p0[r] = p0[r] - mn;
#pragma unroll
    for (int r = 0; r < 16; ++r) p1[r] = p1[r] - mn;
#pragma unroll
    for (int r = 0; r < 16; ++r) p0[r] = __builtin_amdgcn_exp2f(p0[r]);
}
__device__ __forceinline__ void finishSM(f32x16& p0, f32x16& p1, float alpha, float& l_reg, bf16x8& pa0, bf16x8& pa1, bf16x8& pa2, bf16x8& pa3) {
#pragma unroll
    for (int r = 0; r < 16; ++r) p1[r] = __builtin_amdgcn_exp2f(p1[r]);
    float ps = 0;
#pragma unroll
    for (int r = 0; r < 16; ++r) ps += p0[r];
#pragma unroll
    for (int r = 0; r < 16; ++r) ps += p1[r];
    { auto rr = __builtin_amdgcn_permlane32_swap(__float_as_uint(ps), __float_as_uint(ps), false, false); ps = __uint_as_float(rr[0]) + __uint_as_float(rr[1]); }
    l_reg = l_reg * alpha + ps;
#define PK4(P, BASE, OUT) do { unsigned a0 = cvtpk(P[BASE + 0], P[BASE + 1]), a1 = cvtpk(P[BASE + 2], P[BASE + 3]);   \
    unsigned b0 = cvtpk(P[BASE + 4], P[BASE + 5]), b1 = cvtpk(P[BASE + 6], P[BASE + 7]);                              \
    auto r0 = __builtin_amdgcn_permlane32_swap(a0, b0, false, false); auto r1 = __builtin_amdgcn_permlane32_swap(a1, b1, false, false); \
    v4u w = {r0[0], r1[0], r0[1], r1[1]}; OUT = __builtin_bit_cast(bf16x8, w); } while (0)
    PK4(p0, 0, pa0); PK4(p0, 8, pa1); PK4(p1, 0, pa2); PK4(p1, 8, pa3);
#undef PK4
}
__device__ __forceinline__ void qkt(f32x16& p0, f32x16& p1, const char* Ks, const bf16x8* qr, int r32, int hi) {
    p0 = f32x16{}; p1 = f32x16{};
#pragma unroll
    for (int d0 = 0; d0 < 4; ++d0) { const int cb = (d0 * 16 + hi * 8) * 2;
        const bf16x8 b0 = *reinterpret_cast<const bf16x8*>(Ks + KSWZ64(r32, cb));
        const bf16x8 b1 = *reinterpret_cast<const bf16x8*>(Ks + KSWZ64(32 + r32, cb));
        p0 = __builtin_amdgcn_mfma_f32_32x32x16_bf16(b0, qr[d0], p0, 0, 0, 0);
        p1 = __builtin_amdgcn_mfma_f32_32x32x16_bf16(b1, qr[d0], p1, 0, 0, 0); }
}
__device__ __forceinline__ int v_st(int k, int c) { const int kk = (k & ~0xC) | ((k & 4) << 1) | ((k & 8) >> 1); return ((kk >> 3) * 4 + (c >> 5)) * 512 + ((kk & 7) * 32 + (c & 31)) * 2; }
__device__ __forceinline__ int v_rd_base(int lane) { return ((lane & 3) << 3) | (((lane >> 2) & 3) << 6) | (((lane >> 4) & 1) << 5) | (((lane >> 5) & 1) << 8); }
constexpr int v_rd_off(int d0, int ks, int half) { return d0 * 512 + ks * 4096 + half * 2048; }
template <int OFF> __device__ __forceinline__ s16x4 tr_read(int vb) { s16x4 r; asm volatile("ds_read_b64_tr_b16 %0, %1 offset:%2" : "=&v"(r) : "v"(vb), "i"(OFF) : "memory"); return r; }
template <int D0> __device__ __forceinline__ void pv_one(f32x16& od, int vb, bf16x8 pa0, bf16x8 pa1, bf16x8 pa2, bf16x8 pa3) {
    const s16x4 l0 = tr_read<v_rd_off(D0, 0, 0)>(vb), h0 = tr_read<v_rd_off(D0, 0, 1)>(vb), l1 = tr_read<v_rd_off(D0, 1, 0)>(vb), h1 = tr_read<v_rd_off(D0, 1, 1)>(vb);
    const s16x4 l2 = tr_read<v_rd_off(D0, 2, 0)>(vb), h2 = tr_read<v_rd_off(D0, 2, 1)>(vb), l3 = tr_read<v_rd_off(D0, 3, 0)>(vb), h3 = tr_read<v_rd_off(D0, 3, 1)>(vb);
    asm volatile("s_waitcnt lgkmcnt(0)" ::: "memory"); SBAR();
#define PK(L, H) (bf16x8){L[0], L[1], L[2], L[3], H[0], H[1], H[2], H[3]}
    od = __builtin_amdgcn_mfma_f32_32x32x16_bf16(pa0, PK(l0, h0), od, 0, 0, 0);
    od = __builtin_amdgcn_mfma_f32_32x32x16_bf16(pa1, PK(l1, h1), od, 0, 0, 0);
    od = __builtin_amdgcn_mfma_f32_32x32x16_bf16(pa2, PK(l2, h2), od, 0, 0, 0);
    od = __builtin_amdgcn_mfma_f32_32x32x16_bf16(pa3, PK(l3, h3), od, 0, 0, 0);
#undef PK
}
__device__ __forceinline__ void pv_d0(f32x16* o, int vb, bf16x8 pa0, bf16x8 pa1, bf16x8 pa2, bf16x8 pa3) {
    pv_one<0>(o[0], vb, pa0, pa1, pa2, pa3); pv_one<1>(o[1], vb, pa0, pa1, pa2, pa3); pv_one<2>(o[2], vb, pa0, pa1, pa2, pa3); pv_one<3>(o[3], vb, pa0, pa1, pa2, pa3);
}
constexpr int SHM_ATTN3 = 3 * SHM_V + 3 * SHM_K + NW * 64 * 4;
template <int LDP, int LDO>
__device__ __forceinline__ void attn_dense_body(const bf16* __restrict__ Qb, const bf16* __restrict__ Kh, const bf16* __restrict__ Vh, bf16* __restrict__ Ob, int seq, char* lds, const int wid) {
    const int lane = lane_id(), tid = wid * 64 + lane, r32 = lane & 31, hi = lane >> 5;
    char* V_lds = lds; char* K_lds = lds + 3 * SHM_V;
    float* ws = (float*)(lds + 3 * SHM_V + 3 * SHM_K) + wid * 64; float* li_l = ws; float* al_l = ws + 32;
    float m_reg = -1e30f, l_reg = 0; f32x16 o[4] = {}; bf16x8 qr[4];
    const bf16* Qw = Qb + (long)(wid * QBLK + r32) * LDP + hi * 8;
#pragma unroll
    for (int d0 = 0; d0 < 4; ++d0) qr[d0] = *reinterpret_cast<const bf16x8*>(Qw + d0 * 16);
    const int sr = tid >> 4, sc = (tid & 15) * 8, vst0 = v_st(sr, sc), vst1 = v_st(32 + sr, sc);
    const int kr = tid >> 3, kc = (tid & 7) * 8, kst = KSWZ64(kr, kc * 2);
    const int vb0 = (int)(uintptr_t)V_lds + v_rd_base(lane);
    bf16x8 vs0, vs1, ks0;
#define SLOAD(k0) do { vs0 = *reinterpret_cast<const bf16x8*>(&Vh[(long)((k0) + sr) * LDP + sc]); vs1 = *reinterpret_cast<const bf16x8*>(&Vh[(long)((k0) + 32 + sr) * LDP + sc]); \
    ks0 = *reinterpret_cast<const bf16x8*>(&Kh[(long)((k0) + kr) * LDP + kc]); } while (0)
#define SWRITE(s) do { *(bf16x8*)(V_lds + (s) * SHM_V + vst0) = vs0; *(bf16x8*)(V_lds + (s) * SHM_V + vst1) = vs1; *(bf16x8*)(K_lds + (s) * SHM_K + kst) = ks0; } while (0)
#define RESC(a) do { if (__any((a) < 1.f)) { if (hi == 0) al_l[r32] = (a); asm volatile("s_waitcnt lgkmcnt(0)" ::: "memory"); \
    _Pragma("unroll") for (int d = 0; d < 4; ++d) _Pragma("unroll") for (int r = 0; r < 16; ++r) o[d][r] *= al_l[crow(r, hi)]; } } while (0)
#define LBAR() do { asm volatile("s_waitcnt lgkmcnt(0)" ::: "memory"); __builtin_amdgcn_s_barrier(); asm volatile("" ::: "memory"); } while (0)
    f32x16 pA0, pA1, pB0, pB1; float mnA, mnB, alA, alB; bf16x8 pa0, pa1, pa2, pa3; const int NT = seq / KVBLK;
    int s0 = 0, s1 = 1, s2 = 2;
#define ROT3() do { const int t_ = s0; s0 = s1; s1 = s2; s2 = t_; } while (0)
    SLOAD(0); SWRITE(0); SLOAD(KVBLK); LBAR();
    qkt(pA0, pA1, K_lds, qr, r32, hi); partialSM(pA0, pA1, m_reg, mnA, alA);
    SWRITE(1); if (2 < NT) SLOAD(2 * KVBLK); LBAR();
#define STEP3(X0, X1, mnX, alX, Y0, Y1, alY, j) do { \
        if ((j) + 1 < NT) SWRITE(s2); SBAR(); \
        if ((j) + 2 < NT) SLOAD(((j) + 2) * KVBLK); SBAR(); \
        qkt(X0, X1, K_lds + s1 * SHM_K, qr, r32, hi); \
        finishSM(Y0, Y1, alY, l_reg, pa0, pa1, pa2, pa3); SBAR(); \
        pv_d0(o, vb0 + s0 * SHM_V, pa0, pa1, pa2, pa3); partialSM(X0, X1, m_reg, mnX, alX); \
        RESC(alX); LBAR(); ROT3(); } while (0)
    int j = 1;
    for (; j + 1 < NT; j += 2) {
        STEP3(pB0, pB1, mnB, alB, pA0, pA1, alA, j);
        STEP3(pA0, pA1, mnA, alA, pB0, pB1, alB, j + 1);
    }
    STEP3(pB0, pB1, mnB, alB, pA0, pA1, alA, NT - 1);
    finishSM(pB0, pB1, alB, l_reg, pa0, pa1, pa2, pa3); SBAR();
    pv_d0(o, vb0 + s0 * SHM_V, pa0, pa1, pa2, pa3);
    if (hi == 0) li_l[r32] = l_reg; asm volatile("s_waitcnt lgkmcnt(0)" ::: "memory");
    float rli[16];
#pragma unroll
    for (int r = 0; r < 16; ++r) rli[r] = __builtin_amdgcn_rcpf(li_l[crow(r, hi)]);
    bf16* Ow = Ob + (long)(wid * QBLK) * LDO;
#pragma unroll
    for (int r = 0; r < 16; ++r) { const int orow = crow(r, hi);
#pragma unroll
        for (int d0 = 0; d0 < 4; ++d0) Ow[(long)orow * LDO + d0 * 32 + r32] = (bf16)f2bf(o[d0][r] * rli[r]); }
    LBAR();
#undef SLOAD
#undef SWRITE
#undef RESC
#undef LBAR
#undef ROT3
#undef STEP3
}

constexpr int SHM_V8 = 128 * 80, SHM_ATTN8 = 3 * SHM_V8 + 3 * SHM_K + NW * 64 * 4;
__device__ __forceinline__ int cvt4_nc(float a, float b, float c, float d) { int w = 0; w = __builtin_amdgcn_cvt_pk_fp8_f32(a, b, w, false); w = __builtin_amdgcn_cvt_pk_fp8_f32(c, d, w, true); return w; }
__device__ __forceinline__ int vt8_slot(int ko) { const int k5 = ko & 31, hi = (k5 >> 2) & 1, r = (k5 & 3) + 4 * (k5 >> 3); return hi * 32 + (ko >> 5) * 16 + r; }
__device__ __forceinline__ void finishSM8(f32x16& p0, f32x16& p1, float alpha, float& l_reg, v8i& pa) {
#pragma unroll
    for (int r = 0; r < 16; ++r) p1[r] = __builtin_amdgcn_exp2f(p1[r]);
    float ps = 0;
#pragma unroll
    for (int r = 0; r < 16; ++r) ps += p0[r];
#pragma unroll
    for (int r = 0; r < 16; ++r) ps += p1[r];
    { auto rr = __builtin_amdgcn_permlane32_swap(__float_as_uint(ps), __float_as_uint(ps), false, false); ps = __uint_as_float(rr[0]) + __uint_as_float(rr[1]); }
    l_reg = l_reg * alpha + ps;
    pa = (v8i){cvt4_nc(p0[0], p0[1], p0[2], p0[3]), cvt4_nc(p0[4], p0[5], p0[6], p0[7]), cvt4_nc(p0[8], p0[9], p0[10], p0[11]), cvt4_nc(p0[12], p0[13], p0[14], p0[15]),
               cvt4_nc(p1[0], p1[1], p1[2], p1[3]), cvt4_nc(p1[4], p1[5], p1[6], p1[7]), cvt4_nc(p1[8], p1[9], p1[10], p1[11]), cvt4_nc(p1[12], p1[13], p1[14], p1[15])};
}
__device__ __forceinline__ void pv8(f32x16* o, const char* Vs, v8i pa, int r32, int hi, int scale1) {
    v8i vb[4];
#pragma unroll
    for (int d0 = 0; d0 < 4; ++d0) { const char* p = Vs + (d0 * 32 + r32) * 80 + hi * 32; const v4i lo = *reinterpret_cast<const v4i*>(p), hh = *reinterpret_cast<const v4i*>(p + 16);
        vb[d0] = (v8i){lo[0], lo[1], lo[2], lo[3], hh[0], hh[1], hh[2], hh[3]}; }
    asm volatile("s_waitcnt lgkmcnt(0)\n\ts_nop 3" ::: "memory"); SBAR();
#pragma unroll
    for (int d0 = 0; d0 < 4; ++d0)
        asm volatile("v_mfma_f32_32x32x64_f8f6f4 %0, %1, %2, %0" : "+v"(o[d0]) : "v"(pa), "v"(vb[d0]), "v"(scale1));
    SBAR();
}
template <int LDP, int LDO>
__device__ __forceinline__ void attn_dense_body8(const bf16* __restrict__ Qb, const bf16* __restrict__ Kh, const unsigned char* __restrict__ Vt, bf16* __restrict__ Ob, int seq, char* lds, const int wid) {
    const int lane = lane_id(), tid = wid * 64 + lane, r32 = lane & 31, hi = lane >> 5;
    char* V_lds = lds; char* K_lds = lds + 3 * SHM_V8;
    float* ws = (float*)(lds + 3 * SHM_V8 + 3 * SHM_K) + wid * 64; float* li_l = ws; float* al_l = ws + 32;
    float m_reg = -1e30f, l_reg = 0; f32x16 o[4] = {}; bf16x8 qr[4];
    const int scale1 = 0x7F7F7F7F;
    const bf16* Qw = Qb + (long)(wid * QBLK + r32) * LDP + hi * 8;
#pragma unroll
    for (int d0 = 0; d0 < 4; ++d0) qr[d0] = *reinterpret_cast<const bf16x8*>(Qw + d0 * 16);
    const int vcol = tid >> 2, vq = tid & 3, vst = vcol * 80 + vq * 16;
    const unsigned char* vsrc = Vt + (long)vcol * RB + vq * 16;
    const int kr = tid >> 3, kc = (tid & 7) * 8, kst = KSWZ64(kr, kc * 2);
    v4i vs0; bf16x8 ks0;
#define SLOAD(k0) do { vs0 = *reinterpret_cast<const v4i*>(vsrc + (k0)); ks0 = *reinterpret_cast<const bf16x8*>(&Kh[(long)((k0) + kr) * LDP + kc]); } while (0)
#define SWRITE(s) do { *(v4i*)(V_lds + (s) * SHM_V8 + vst) = vs0; *(bf16x8*)(K_lds + (s) * SHM_K + kst) = ks0; } while (0)
#define RESC(a) do { if (__any((a) < 1.f)) { if (hi == 0) al_l[r32] = (a); asm volatile("s_waitcnt lgkmcnt(0)" ::: "memory"); \
    _Pragma("unroll") for (int d = 0; d < 4; ++d) _Pragma("unroll") for (int r = 0; r < 16; ++r) o[d][r] *= al_l[crow(r, hi)]; } } while (0)
#define LBAR() do { asm volatile("s_waitcnt lgkmcnt(0)" ::: "memory"); __builtin_amdgcn_s_barrier(); asm volatile("" ::: "memory"); } while (0)
    f32x16 pA0, pA1, pB0, pB1; float mnA, mnB, alA, alB; v8i pa; const int NT = seq / KVBLK;
    int s0 = 0, s1 = 1, s2 = 2;
#define ROT3() do { const int t_ = s0; s0 = s1; s1 = s2; s2 = t_; } while (0)
    SLOAD(0); SWRITE(0); SLOAD(KVBLK); LBAR();
    qkt(pA0, pA1, K_lds, qr, r32, hi); partialSM(pA0, pA1, m_reg, mnA, alA);
    SWRITE(1); if (2 < NT) SLOAD(2 * KVBLK); LBAR();
#define STEP3(X0, X1, mnX, alX, Y0, Y1, alY, j) do { \
        if ((j) + 1 < NT) SWRITE(s2); SBAR(); \
        if ((j) + 2 < NT) SLOAD(((j) + 2) * KVBLK); SBAR(); \
        qkt(X0, X1, K_lds + s1 * SHM_K, qr, r32, hi); \
        finishSM8(Y0, Y1, alY, l_reg, pa); SBAR(); \
        pv8(o, V_lds + s0 * SHM_V8, pa, r32, hi, scale1); partialSM(X0, X1, m_reg, mnX, alX); \
        RESC(alX); LBAR(); ROT3(); } while (0)
    int j = 1;
    for (; j + 1 < NT; j += 2) {
        STEP3(pB0, pB1, mnB, alB, pA0, pA1, alA, j);
        STEP3(pA0, pA1, mnA, alA, pB0, pB1, alB, j + 1);
    }
    STEP3(pB0, pB1, mnB, alB, pA0, pA1, alA, NT - 1);
    finishSM8(pB0, pB1, alB, l_reg, pa); SBAR();
    pv8(o, V_lds + s0 * SHM_V8, pa, r32, hi, scale1);
    if (hi == 0) li_l[r32] = l_reg; asm volatile("s_waitcnt lgkmcnt(0)\n\ts_nop 15\n\ts_nop 15\n\ts_nop 15\n\ts_nop 15\n\ts_nop 15" ::: "memory");
    float rli[16];
#pragma unroll
    for (int r = 0; r < 16; ++r) rli[r] = __builtin_amdgcn_rcpf(li_l[crow(r, hi)]);
    bf16* Ow = Ob + (long)(wid * QBLK) * LDO;
#pragma unroll
    for (int r = 0; r < 16; ++r) { const int orow = crow(r, hi);
#pragma unroll
        for (int d0 = 0; d0 < 4; ++d0) Ow[(long)orow * LDO + d0 * 32 + r32] = (bf16)f2bf(o[d0][r] * rli[r]); }
    LBAR();
#undef SLOAD
#undef SWRITE
#undef RESC
#undef LBAR
#undef ROT3
#undef STEP3
}

__device__ __forceinline__ void pack8x(const f32x16& p0, const f32x16& p1, v8i& pa) {
    unsigned w[8];
#pragma unroll
    for (int g = 0; g < 4; ++g) { unsigned a = 0, b = 0;
#pragma unroll
        for (int i = 0; i < 4; ++i) { a = __builtin_amdgcn_cvt_pk_u8_f32(p0[4 * g + i], i, a); b = __builtin_amdgcn_cvt_pk_u8_f32(p1[4 * g + i], i, b); }
        w[g] = a; w[4 + g] = b; }
    pa = (v8i){(int)w[0], (int)w[1], (int)w[2], (int)w[3], (int)w[4], (int)w[5], (int)w[6], (int)w[7]};
}
template <int LDP, int LDO>
__device__ __forceinline__ void attn_dense_body8x(const bf16* __restrict__ Qb, const bf16* __restrict__ Kh, const unsigned char* __restrict__ Vt, bf16* __restrict__ Ob, int seq, char* lds, const int wid) {
    const int lane = lane_id(), tid = wid * 64 + lane, r32 = lane & 31, hi = lane >> 5;
    char* V_lds = lds; char* K_lds = lds + 3 * SHM_V8;
    float* ws = (float*)(lds + 3 * SHM_V8 + 3 * SHM_K) + wid * 64; float* al_l = ws + 32;
    f32x16 o[5] = {}; bf16x8 qr[4];
    f32x16 cvec; { _Pragma("unroll") for (int r = 0; r < 16; ++r) cvec[r] = 56.5f; }
    const int scale1 = 0x7F7F7F7F;
    const bf16* Qw = Qb + (long)(wid * QBLK + r32) * LDP + hi * 8;
#pragma unroll
    for (int d0 = 0; d0 < 4; ++d0) qr[d0] = *reinterpret_cast<const bf16x8*>(Qw + d0 * 16);
    const int vcol = tid >> 2, vq = tid & 3, vst = vcol * 80 + vq * 16;
    const unsigned char* vsrc = Vt + (long)vcol * RB + vq * 16;
    const int kr = tid >> 3, kc = (tid & 7) * 8, kst = KSWZ64(kr, kc * 2);
    v4i vs0; bf16x8 ks0;
#define SLOAD(k0) do { vs0 = *reinterpret_cast<const v4i*>(vsrc + (k0)); ks0 = *reinterpret_cast<const bf16x8*>(&Kh[(long)((k0) + kr) * LDP + kc]); } while (0)
#define SWRITE(s) do { *(v4i*)(V_lds + (s) * SHM_V8 + vst) = vs0; *(bf16x8*)(K_lds + (s) * SHM_K + kst) = ks0; } while (0)
#define RESC(a) do { if (__any((a) < 1.f)) { if (hi == 0) al_l[r32] = (a); asm volatile("s_waitcnt lgkmcnt(0)" ::: "memory"); \
    _Pragma("unroll") for (int d = 0; d < 5; ++d) _Pragma("unroll") for (int r = 0; r < 16; ++r) o[d][r] *= al_l[crow(r, hi)]; } } while (0)
#define LBAR() do { asm volatile("s_waitcnt lgkmcnt(0)" ::: "memory"); __builtin_amdgcn_s_barrier(); asm volatile("" ::: "memory"); } while (0)
#define REFUPD(X0, X1, alX, FIRST) do { float pmax_ = X0[0]; \
        _Pragma("unroll") for (int r = 1; r < 16; ++r) pmax_ = fmaxf(pmax_, X0[r]); \
        _Pragma("unroll") for (int r = 0; r < 16; ++r) pmax_ = fmaxf(pmax_, X1[r]); \
        { auto rr = __builtin_amdgcn_permlane32_swap(__float_as_uint(pmax_), __float_as_uint(pmax_), false, false); pmax_ = fmaxf(__uint_as_float(rr[0]), __uint_as_float(rr[1])); } \
        alX = 1.f; \
        if ((FIRST) || !__all(pmax_ <= 56.5f + 8.0f * THR)) { const float d8_ = (FIRST) ? pmax_ - 56.5f : fmaxf(pmax_ - 56.5f, 0.f); \
            _Pragma("unroll") for (int r = 0; r < 16; ++r) { X0[r] -= d8_; X1[r] -= d8_; cvec[r] -= d8_; } \
            alX = __builtin_amdgcn_exp2f(-0.125f * d8_); } } while (0)
#define PV5(Vs) do { v8i vb_[4]; \
        _Pragma("unroll") for (int d0 = 0; d0 < 4; ++d0) { const char* p_ = (Vs) + (d0 * 32 + r32) * 80 + hi * 32; const v4i lo_ = *reinterpret_cast<const v4i*>(p_), hh_ = *reinterpret_cast<const v4i*>(p_ + 16); \
            vb_[d0] = (v8i){lo_[0], lo_[1], lo_[2], lo_[3], hh_[0], hh_[1], hh_[2], hh_[3]}; } \
        asm volatile("s_waitcnt lgkmcnt(0)\n\ts_nop 3" ::: "memory"); SBAR(); \
        _Pragma("unroll") for (int d0 = 0; d0 < 4; ++d0) asm volatile("v_mfma_f32_32x32x64_f8f6f4 %0, %1, %2, %0" : "+v"(o[d0]) : "v"(pa), "v"(vb_[d0]), "v"(scale1)); \
        { int k38_ = 0x38383838; asm volatile("" : "+v"(k38_)); const v8i ones_ = {k38_, k38_, k38_, k38_, k38_, k38_, k38_, k38_};        \
          asm volatile("s_nop 1\n\tv_mfma_f32_32x32x64_f8f6f4 %0, %1, %2, %0" : "+v"(o[4]) : "v"(pa), "v"(ones_), "v"(scale1)); } SBAR(); } while (0)
    f32x16 pA0, pA1, pB0, pB1; float alA, alB; v8i pa; const int NT = seq / KVBLK;
    int s0 = 0, s1 = 1, s2 = 2;
#define ROT3() do { const int t_ = s0; s0 = s1; s1 = s2; s2 = t_; } while (0)
#define QKT8(P0, P1, Ks) do { const char* kb_ = (Ks); \
        _Pragma("unroll") for (int d0 = 0; d0 < 4; ++d0) { const int cb = (d0 * 16 + hi * 8) * 2; \
            const bf16x8 b0 = *reinterpret_cast<const bf16x8*>(kb_ + KSWZ64(r32, cb)); const bf16x8 b1 = *reinterpret_cast<const bf16x8*>(kb_ + KSWZ64(32 + r32, cb)); \
            if (d0 == 0) { P0 = __builtin_amdgcn_mfma_f32_32x32x16_bf16(b0, qr[0], cvec, 0, 0, 0); P1 = __builtin_amdgcn_mfma_f32_32x32x16_bf16(b1, qr[0], cvec, 0, 0, 0); } \
            else { P0 = __builtin_amdgcn_mfma_f32_32x32x16_bf16(b0, qr[d0], P0, 0, 0, 0); P1 = __builtin_amdgcn_mfma_f32_32x32x16_bf16(b1, qr[d0], P1, 0, 0, 0); } } } while (0)
    SLOAD(0); SWRITE(0); SLOAD(KVBLK); LBAR();
    QKT8(pA0, pA1, K_lds); REFUPD(pA0, pA1, alA, true);
    SWRITE(1); if (2 < NT) SLOAD(2 * KVBLK); LBAR();
#define STEP3(X0, X1, alX, Y0, Y1, j) do { \
        if ((j) + 1 < NT) SWRITE(s2); SBAR(); \
        if ((j) + 2 < NT) SLOAD(((j) + 2) * KVBLK); SBAR(); \
        QKT8(X0, X1, K_lds + s1 * SHM_K); \
        pack8x(Y0, Y1, pa); SBAR(); \
        PV5(V_lds + s0 * SHM_V8); \
        REFUPD(X0, X1, alX, false); \
        RESC(alX); LBAR(); ROT3(); } while (0)
    int j = 1;
    for (; j + 1 < NT; j += 2) {
        STEP3(pB0, pB1, alB, pA0, pA1, j);
        STEP3(pA0, pA1, alA, pB0, pB1, j + 1);
    }
    STEP3(pB0, pB1, alB, pA0, pA1, NT - 1);
    pack8x(pB0, pB1, pa); SBAR();
    PV5(V_lds + s0 * SHM_V8);
    asm volatile("s_nop 15\n\ts_nop 15\n\ts_nop 15\n\ts_nop 15\n\ts_nop 15\n\ts_nop 15" ::: "memory");
    asm volatile("" : "+v"(o[0]), "+v"(o[1]), "+v"(o[2]), "+v"(o[3]), "+v"(o[4]));
    bf16* Ow = Ob + (long)(wid * QBLK) * LDO;
#pragma unroll
    for (int r = 0; r < 16; ++r) { const int orow = crow(r, hi); const float rl = __builtin_amdgcn_rcpf(o[4][r]);
#pragma unroll
        for (int d0 = 0; d0 < 4; ++d0) Ow[(long)orow * LDO + d0 * 32 + r32] = (bf16)f2bf(o[d0][r] * rl); }
    LBAR();
#undef SLOAD
#undef SWRITE
#undef RESC
#undef LBAR
#undef REFUPD
#undef PV5
#undef QKT8
#undef ROT3
#undef STEP3
}
template <int N> struct VStage { typedef v4i T; };
template <> struct VStage<2> { typedef v2u T; };
template <int NDB, int KP, int LDO, bool SWA>
__device__ __forceinline__ void attn8(const unsigned char* __restrict__ Qb, const unsigned char* __restrict__ Kh, const unsigned char* __restrict__ Vt, bf16* __restrict__ Ob, const int NT, const int boff, const int qrow0, const float sinkl2, char* lds, const int wid) {
    const int lane = lane_id(), tid = wid * 64 + lane, r32 = lane & 31, hi = lane >> 5;
    constexpr int SHM_K8 = 64 * 80;
    constexpr int SHM_VT = 32 * NDB * 80;
    char* V_lds = lds; char* K_lds = lds + 4 * SHM_VT;
    float* ws = (float*)(lds + 4 * SHM_VT + 4 * SHM_K8) + wid * 64; float* al_l = ws + 32;
    f32x16 o[NDB + 1] = {}; v8i qf;
    f32x16 cvec; { _Pragma("unroll") for (int r = 0; r < 16; ++r) cvec[r] = 56.5f; }
    const int scale1 = 0x7F7F7F7F;
    { const unsigned char* Qw = Qb + (long)(wid * QBLK + r32) * 1024 + hi * 32; const v4i lo_ = *reinterpret_cast<const v4i*>(Qw), hh_ = *reinterpret_cast<const v4i*>(Qw + 16);
      qf = (v8i){lo_[0], lo_[1], lo_[2], lo_[3], hh_[0], hh_[1], hh_[2], hh_[3]}; }
    constexpr int VW = NDB * 4, VPR = 64 / VW;
    typedef typename VStage<NDB>::T vst_t;
    const int vcol = tid / VPR, vq = tid % VPR, vst = vcol * 80 + vq * VW;
    const unsigned char* vsrc = Vt + (long)vcol * RB + vq * VW;
    const int kr = tid >> 3, kst = kr * 80 + (tid & 7) * 8;
    const unsigned char* ksrc = Kh + (long)kr * KP + (tid & 7) * 8;
    vst_t vs0, vs1; v2u ks0, ks1;
#define TILE(t) (((t) < 4) ? (t) : ((t) + boff))
#define SLOADX(t, VS, KS) do { const int t_ = (t) < NT ? (t) : NT - 1; const int k0_ = TILE(t_) * KVBLK; VS = *reinterpret_cast<const vst_t*>(vsrc + k0_); KS = *reinterpret_cast<const v2u*>(ksrc + (long)k0_ * KP); } while (0)
#define SWRITEX(s, VS, KS) do { *(vst_t*)(V_lds + (s) * SHM_VT + vst) = VS; *(v2u*)(K_lds + (s) * SHM_K8 + kst) = KS; } while (0)
#define SLOAD(t) SLOADX(t, vs0, ks0)
#define SWRITE(s) SWRITEX(s, vs0, ks0)
#define RESC(a) do { if (__any((a) < 1.f)) { if (hi == 0) al_l[r32] = (a); asm volatile("s_waitcnt lgkmcnt(0)" ::: "memory"); \
    _Pragma("unroll") for (int d = 0; d < NDB + 1; ++d) _Pragma("unroll") for (int r = 0; r < 16; ++r) o[d][r] *= al_l[crow(r, hi)]; } } while (0)
#define LBAR() do { asm volatile("s_waitcnt lgkmcnt(0)" ::: "memory"); __builtin_amdgcn_s_barrier(); asm volatile("" ::: "memory"); } while (0)
#define REFUPD(X0, X1, alX, FIRST) do { float pmax_ = X0[0]; \
        _Pragma("unroll") for (int r = 1; r < 16; ++r) pmax_ = fmaxf(pmax_, X0[r]); \
        _Pragma("unroll") for (int r = 0; r < 16; ++r) pmax_ = fmaxf(pmax_, X1[r]); \
        { auto rr = __builtin_amdgcn_permlane32_swap(__float_as_uint(pmax_), __float_as_uint(pmax_), false, false); pmax_ = fmaxf(__uint_as_float(rr[0]), __uint_as_float(rr[1])); } \
        alX = 1.f; \
        if ((FIRST) || !__all(pmax_ <= 56.5f + 8.0f * THR)) { const float d8_ = (FIRST) ? pmax_ - 56.5f : fmaxf(pmax_ - 56.5f, 0.f); \
            _Pragma("unroll") for (int r = 0; r < 16; ++r) { X0[r] -= d8_; X1[r] -= d8_; cvec[r] -= d8_; } \
            alX = __builtin_amdgcn_exp2f(-0.125f * d8_); } } while (0)
    v8i vb[NDB], kf0, kf1;
#define VREAD(d0, Vs) do { const char* p_ = (Vs) + ((d0) * 32 + r32) * 80 + hi * 32; const v4i lo_ = *reinterpret_cast<const v4i*>(p_), hh_ = *reinterpret_cast<const v4i*>(p_ + 16); \
        vb[d0] = (v8i){lo_[0], lo_[1], lo_[2], lo_[3], hh_[0], hh_[1], hh_[2], hh_[3]}; } while (0)
#define KREAD(Ks) do { const char* kb_ = (Ks) + r32 * 80 + hi * 32; \
        const v4i a0_ = *reinterpret_cast<const v4i*>(kb_), a1_ = *reinterpret_cast<const v4i*>(kb_ + 16), b0_ = *reinterpret_cast<const v4i*>(kb_ + 32 * 80), b1_ = *reinterpret_cast<const v4i*>(kb_ + 32 * 80 + 16); \
        kf0 = (v8i){a0_[0], a0_[1], a0_[2], a0_[3], a1_[0], a1_[1], a1_[2], a1_[3]}; kf1 = (v8i){b0_[0], b0_[1], b0_[2], b0_[3], b1_[0], b1_[1], b1_[2], b1_[3]}; } while (0)
#define QKM(P0, P1) do { asm volatile("s_nop 1\n\tv_mfma_f32_32x32x64_f8f6f4 %0, %2, %4, %5\n\tv_mfma_f32_32x32x64_f8f6f4 %1, %3, %4, %5" \
                     : "=&v"(P0), "=&v"(P1) : "v"(kf0), "v"(kf1), "v"(qf), "v"(cvec), "v"(scale1)); SBAR(); } while (0)
#define PVM() do { asm volatile("s_nop 3" ::: "memory"); \
        _Pragma("unroll") for (int d0 = 0; d0 < NDB; ++d0) asm volatile("v_mfma_f32_32x32x64_f8f6f4 %0, %1, %2, %0" : "+v"(o[d0]) : "v"(pa), "v"(vb[d0]), "v"(scale1)); \
        { int k38_ = 0x38383838; asm volatile("" : "+v"(k38_)); const v8i ones_ = {k38_, k38_, k38_, k38_, k38_, k38_, k38_, k38_};        \
          asm volatile("s_nop 1\n\tv_mfma_f32_32x32x64_f8f6f4 %0, %1, %2, %0" : "+v"(o[NDB]) : "v"(pa), "v"(ones_), "v"(scale1)); } SBAR(); } while (0)
    f32x16 X0, X1; float al; v8i pa; unsigned pn[8];
    const int q0w = qrow0 + wid * QBLK, qrel = q0w + r32;
#define AMASK(X0, X1, t) do { if (SWA) { if ((t) >= 4) { const int kv0_ = 64 * TILE(t); if (!((kv0_ + 63 - q0w <= 128) && (q0w + 31 - kv0_ <= 128))) attn_body::wmask(X0, X1, kv0_ - qrel, hi); } } } while (0)
#define PVONE(d0) asm volatile("v_mfma_f32_32x32x64_f8f6f4 %0, %1, %2, %0" : "+v"(o[d0]) : "v"(pa), "v"(vb[d0]), "v"(scale1))
#define PVSUM() do { int k38_ = 0x38383838; asm volatile("" : "+v"(k38_)); const v8i ones_ = {k38_, k38_, k38_, k38_, k38_, k38_, k38_, k38_};        \
          asm volatile("s_nop 1\n\tv_mfma_f32_32x32x64_f8f6f4 %0, %1, %2, %0" : "+v"(o[NDB]) : "v"(pa), "v"(ones_), "v"(scale1)); } while (0)
#define PACKH(X, base) do { _Pragma("unroll") for (int g = 0; g < 4; ++g) { unsigned a_ = 0; _Pragma("unroll") for (int i = 0; i < 4; ++i) a_ = __builtin_amdgcn_cvt_pk_u8_f32(X[4 * g + i], i, a_); pn[(base) + g] = a_; } } while (0)
    int s0 = 0, s1 = 1, s2 = 2, s3 = 3;
#define ROT4() do { const int t_ = s0; s0 = s1; s1 = s2; s2 = s3; s3 = t_; } while (0)
    { vst_t vsA, vsB; v2u ksA, ksB;
      SLOADX(0, vs0, ks0); SLOADX(1, vsA, ksA); SLOADX(2, vsB, ksB); SBAR();
      SWRITEX(0, vs0, ks0); SWRITEX(1, vsA, ksA); SWRITEX(2, vsB, ksB); SBAR();
      SLOADX(3, vs0, ks0); SLOADX(4, vs1, ks1); LBAR(); }
    KREAD(K_lds); SBAR();
    QKM(X0, X1);
    KREAD(K_lds + SHM_K8); SBAR();
    asm volatile("s_nop 15\n\ts_nop 15\n\ts_nop 15\n\ts_nop 15\n\ts_nop 15\n\ts_nop 15\n\ts_nop 15\n\ts_nop 15\n\ts_nop 15" : "+v"(X0), "+v"(X1)); REFUPD(X0, X1, al, true);
    pack8x(X0, X1, pa); SBAR();
#define STEP5(j, VS, KS) do { \
        SBAR(); \
        _Pragma("unroll") for (int d0 = 0; d0 < NDB / 2; ++d0) VREAD(d0, V_lds + s0 * SHM_VT); \
        SBAR(); \
        SWRITEX(s3, VS, KS);                         \
        SBAR(); \
        SLOADX((j) + 4, VS, KS); \
        SBAR(); \
        QKM(X0, X1); \
        _Pragma("unroll") for (int d0 = NDB / 2; d0 < NDB; ++d0) VREAD(d0, V_lds + s0 * SHM_VT); \
        SBAR(); \
        asm volatile("s_nop 3" ::: "memory"); \
        _Pragma("unroll") for (int d0 = 0; d0 < NDB / 2; ++d0) PVONE(d0); \
        SBAR(); \
        if ((j) + 1 < NT) KREAD(K_lds + s2 * SHM_K8); \
        SBAR(); \
        AMASK(X0, X1, (j)); \
        float pmax_ = X0[0]; \
        _Pragma("unroll") for (int r = 1; r < 16; ++r) pmax_ = fmaxf(pmax_, X0[r]); \
        SBAR(); \
        PVONE(NDB / 2); \
        SBAR(); \
        _Pragma("unroll") for (int r = 0; r < 16; ++r) pmax_ = fmaxf(pmax_, X1[r]); \
        { auto rr = __builtin_amdgcn_permlane32_swap(__float_as_uint(pmax_), __float_as_uint(pmax_), false, false); pmax_ = fmaxf(__uint_as_float(rr[0]), __uint_as_float(rr[1])); } \
        al = 1.f; \
        if (!__all(pmax_ <= 56.5f + 8.0f * THR)) { const float d8_ = fmaxf(pmax_ - 56.5f, 0.f); \
            _Pragma("unroll") for (int r = 0; r < 16; ++r) { X0[r] -= d8_; X1[r] -= d8_; cvec[r] -= d8_; } \
            al = __builtin_amdgcn_exp2f(-0.125f * d8_); } \
        SBAR(); \
        if (NDB == 4) { PVONE(NDB - 1); SBAR(); } \
        PACKH(X0, 0); \
        asm volatile("" : "+v"(pn[0]), "+v"(pn[1]), "+v"(pn[2]), "+v"(pn[3])); \
        SBAR(); \
        PVSUM(); \
        SBAR(); \
        PACKH(X1, 4); \
        asm volatile("" : "+v"(pn[4]), "+v"(pn[5]), "+v"(pn[6]), "+v"(pn[7])); \
        SBAR(); \
        if (__any(al < 1.f)) { if (hi == 0) al_l[r32] = al; \
            asm volatile("s_nop 15\n\ts_nop 15\n\ts_nop 15\n\ts_nop 15\n\ts_nop 15\n\ts_nop 15\n\ts_nop 15\n\ts_nop 15\n\ts_waitcnt lgkmcnt(0)" ::: "memory"); \
            _Pragma("unroll") for (int d = 0; d < NDB + 1; ++d) asm volatile("" : "+v"(o[d])); \
            _Pragma("unroll") for (int d = 0; d < NDB + 1; ++d) _Pragma("unroll") for (int r = 0; r < 16; ++r) o[d][r] *= al_l[crow(r, hi)]; } \
        pa = (v8i){(int)pn[0], (int)pn[1], (int)pn[2], (int)pn[3], (int)pn[4], (int)pn[5], (int)pn[6], (int)pn[7]}; \
        LBAR(); ROT4(); \
    } while (0)
    { int j = 1;
      for (; j + 1 < NT; j += 2) { STEP5(j, vs0, ks0); STEP5(j + 1, vs1, ks1); }
      STEP5(NT - 1, vs0, ks0); }
    _Pragma("unroll") for (int d0 = 0; d0 < NDB; ++d0) VREAD(d0, V_lds + s0 * SHM_VT);
    SBAR();
    PVM();
    asm volatile("s_nop 15\n\ts_nop 15\n\ts_nop 15\n\ts_nop 15\n\ts_nop 15\n\ts_nop 15" ::: "memory");
    _Pragma("unroll") for (int d = 0; d < NDB + 1; ++d) asm volatile("" : "+v"(o[d]));
    if (SWA) { if (hi == 0) ws[r32] = sinkl2 - (56.5f - cvec[0]) * 0.125f; asm volatile("s_waitcnt lgkmcnt(0)" ::: "memory");
        _Pragma("unroll") for (int r = 0; r < 16; ++r) o[NDB][r] += __builtin_amdgcn_exp2f(ws[crow(r, hi)]); }
    bf16* Ow = Ob + (long)(wid * QBLK) * LDO;
#pragma unroll
    for (int r = 0; r < 16; ++r) { const int orow = crow(r, hi); const float rl = __builtin_amdgcn_rcpf(o[NDB][r]);
#pragma unroll
        for (int d0 = 0; d0 < NDB; ++d0) Ow[(long)orow * LDO + d0 * 32 + r32] = (bf16)f2bf(o[d0][r] * rl); }
    LBAR();
#undef SLOAD
#undef SLOADX
#undef TILE
#undef AMASK
#undef SWRITE
#undef SWRITEX
#undef RESC
#undef LBAR
#undef REFUPD
#undef PVM
#undef QKM
#undef VREAD
#undef KREAD
#undef ROT4
#undef PVONE
#undef STEP5
#undef PVSUM
#undef PACKH
}
#undef SBAR
#undef KSWZ64
}

#define XB_TMO      128
#define XB_XCNT(j)  (256  + 64 * (j))
#define XB_XSUB(j)  (1280 + 64 * (j))
#define XB_XGEN(j)  (2304 + 64 * (j))
#define XB_TOP      3328
#define XB_TOPGEN   3392
#define XCD_BAR_WORDS 3456
#define XB_SPIN_CAP (1u << 18)
__device__ __forceinline__ unsigned xb_ld(unsigned* p)              { return __hip_atomic_load(p, __ATOMIC_RELAXED, __HIP_MEMORY_SCOPE_AGENT); }
__device__ __forceinline__ unsigned xb_add(unsigned* p, unsigned v) { return __hip_atomic_fetch_add(p, v, __ATOMIC_RELAXED, __HIP_MEMORY_SCOPE_AGENT); }
__device__ __forceinline__ unsigned xb_xcc_id() { return (unsigned)__builtin_amdgcn_s_getreg((3 << 11) | 20) & 0xFu; }
#define XB_SPIN(cond, bar) do { unsigned _sp = 0; while (cond) { __builtin_amdgcn_s_sleep(1); \
    if ((++_sp & 255u) == 0u) { if (xb_ld(&(bar)[XB_TMO])) break; if (_sp > XB_SPIN_CAP) { atomicAdd(&(bar)[XB_TMO], 1u); break; } } } } while (0)
struct XcdBarrier { unsigned* bar; unsigned x; volatile LAS unsigned* st; int wave; };
__device__ __forceinline__ XcdBarrier xcd_barrier_post(unsigned* bar, volatile LAS unsigned* st) {
    XcdBarrier b; b.bar = bar; b.x = xb_xcc_id(); b.st = st; b.wave = 0;
    if (threadIdx.x == 0) (void)xb_add(&bar[XB_XCNT(b.x)], 1u);
    return b;
}
__device__ __forceinline__ void xcd_barrier_complete(unsigned* bar, unsigned x, unsigned& nloc, unsigned& nx) {
    const unsigned G = gridDim.x * gridDim.y * gridDim.z;
    unsigned sum, cnt, mine, sp = 0u;
    for (;;) {
        sum = 0u; cnt = 0u; mine = 0u;
#pragma unroll
        for (unsigned j = 0; j < 16; ++j) { const unsigned c = xb_ld(&bar[XB_XCNT(j)]); sum += c; cnt += (c > 0u) ? 1u : 0u; mine = (j == x) ? c : mine; }
        if (sum == G) break;
        __builtin_amdgcn_s_sleep(1);
        if ((++sp & 255u) == 0u) { if (xb_ld(&bar[XB_TMO])) break; if (sp > XB_SPIN_CAP) { atomicAdd(&bar[XB_TMO], 1u); break; } }
    }
    nloc = mine > 0u ? mine : 1u; nx = cnt > 0u ? cnt : 1u;
}
__device__ __forceinline__ void xcd_barrier(const XcdBarrier& b) {
    asm volatile("s_waitcnt vmcnt(0)" ::: "memory");
    __syncthreads();
    if (b.wave == 0 && lane_id() == 0) {
        unsigned* bar = b.bar;
        __builtin_amdgcn_s_waitcnt(0);
        unsigned nloc = b.st[0], nx = b.st[1];
        if (nloc == 0u) { xcd_barrier_complete(bar, b.x, nloc, nx); b.st[0] = nloc; b.st[1] = nx; }
        const unsigned gen = b.st[2] + 1u; b.st[2] = gen;
        const unsigned old = xb_add(&bar[XB_XSUB(b.x)], 1u);
        if (old + 1u == gen * nloc) {
            __builtin_amdgcn_fence(__ATOMIC_RELEASE, "agent");
            asm volatile("s_waitcnt vmcnt(0)" ::: "memory");
            (void)xb_add(&bar[XB_TOP], 1u);
        }
        XB_SPIN(xb_ld(&bar[XB_TOP]) < gen * nx, bar);
        __builtin_amdgcn_fence(__ATOMIC_ACQUIRE, "agent");
        asm volatile("s_waitcnt vmcnt(0)" ::: "memory");
    }
    __syncthreads();
}

constexpr int NWAVES = 8;
struct Args { const float* in[24]; float* out; unsigned char* ws; int ph_lo, ph_hi; };
typedef __attribute__((address_space(4))) const Args* kargs_t;
__device__ __forceinline__ kargs_t kargs() { kargs_t p = (kargs_t)__builtin_amdgcn_kernarg_segment_ptr(); asm volatile("" : "+s"(p)); return p; }
struct Frame {
    LAS unsigned char* lds;
    volatile LAS unsigned* MISC;
    int tid, lane, wave;
    int vcu, G;
    __device__ __forceinline__ const float* in(int k) const { return kargs()->in[k]; }
    __device__ __forceinline__ unsigned char* ws() const { return kargs()->ws; }
    __device__ __forceinline__ gu32* ctl() const { return (gu32*)(ws() + WS_CTL); }
#define FIN(name, k) __device__ __forceinline__ const float* name() const { return in(k); }
    FIN(x, 0) FIN(c, 1) FIN(ctx, 2) FIN(c_ctx, 3) FIN(mod_w, 4) FIN(mod_b, 5) FIN(norm1_w, 6) FIN(norm2_w, 7) FIN(w_in, 8) FIN(w_out0, 9) FIN(diff_lam, 10) FIN(diff_norm_w, 11)
    FIN(ret_decay, 12) FIN(ret_norm_w, 13) FIN(w_qkv1, 14) FIN(w_out1, 15) FIN(sinks, 16) FIN(router_w, 17) FIN(router_b, 18) FIN(moe_w1, 19) FIN(moe_b1, 20) FIN(moe_w2, 21) FIN(moe_b2, 22) FIN(final_norm_w, 23)
#undef FIN
    __device__ __forceinline__ float* out() const { return kargs()->out; }
#define FWS(type, name, off) __device__ __forceinline__ type* name() const { return (type*)(ws() + off); }
    FWS(float, MODP, WS_MODP) FWS(float, MOD, WS_MOD) FWS(bf16, H, WS_H) FWS(float, GATE, WS_GATE) FWS(float, CKV, WS_CKV) FWS(int, LIST, WS_LIST) FWS(int, POS, WS_POS)
    FWS(bf16, WIN, WS_WIN) FWS(bf16, WOUT0, WS_WOUT0) FWS(bf16, WQKV1, WS_WQKV1) FWS(bf16, WOUT1, WS_WOUT1) FWS(bf16, A, WS_A) FWS(bf16, QKV, WS_QKV) FWS(bf16, OD, WS_OD) FWS(bf16, CAT, WS_CAT)
    FWS(bf16, RVT, WS_RVT) FWS(bf16, RKT, WS_RKT) FWS(unsigned char, K81, WS_K81) FWS(unsigned char, VT81, WS_VT81) FWS(unsigned char, QK8, WS_QK8) FWS(unsigned char, VT8, WS_VT8) FWS(bf16, PREV, WS_PREV) FWS(bf16, ACT, WS_ACT) FWS(bf16, Y, WS_Y) FWS(bf16, W1T, WS_W1T) FWS(bf16, W2T, WS_W2T)
#undef FWS
};
__device__ __forceinline__ void phase_ids(Frame& F) { int l = lane_id(); asm volatile("" : "+v"(l)); F.lane = l; F.tid = F.wave * 64 + l; }
__device__ __forceinline__ int row_v(int r) { const int b = r / RB; return (r - b * RB) < CTXL ? 4 : b; }

__device__ __forceinline__ void p0_transpose_item(const float* W, int N, int K, bf16* wt_row0, float scale, LAS float* scr, int k0, int n0, int lane) {
    float v[32];
#pragma unroll
    for (int i = 0; i < 32; ++i) { const int kk = 2 * i + (lane >> 5); v[i] = W[(size_t)(k0 + kk) * N + n0 + (lane & 31)]; }
#pragma unroll
    for (int i = 0; i < 32; ++i) { const int kk = 2 * i + (lane >> 5); scr[kk * 33 + (lane & 31)] = v[i] * scale; }
    LDS_WAIT(); asm volatile("" ::: "memory");
    const int c = lane & 7;
#pragma unroll
    for (int j = 0; j < 4; ++j) { const int n = (lane >> 3) + 8 * j; const LAS float* s = scr + (8 * c) * 33 + n;
        v4u o; o.x = pk2(s[0 * 33], s[1 * 33]); o.y = pk2(s[2 * 33], s[3 * 33]); o.z = pk2(s[4 * 33], s[5 * 33]); o.w = pk2(s[6 * 33], s[7 * 33]);
        *(GAS v4u*)(wt_row0 + (size_t)n * K + k0 + 8 * c) = o; }
    LDS_WAIT(); asm volatile("" ::: "memory");
}
__device__ __forceinline__ void p0_transpose_item8(const float* W, int N, int K, unsigned char* wt_row0, float scale, LAS float* scr, int k0, int n0, int lane) {
    float v[32];
#pragma unroll
    for (int i = 0; i < 32; ++i) { const int kk = 2 * i + (lane >> 5); v[i] = W[(size_t)(k0 + kk) * N + n0 + (lane & 31)]; }
#pragma unroll
    for (int i = 0; i < 32; ++i) { const int kk = 2 * i + (lane >> 5); scr[kk * 33 + (lane & 31)] = v[i] * scale; }
    LDS_WAIT(); asm volatile("" ::: "memory");
    const int c = lane & 7;
#pragma unroll
    for (int j = 0; j < 4; ++j) { const int n = (lane >> 3) + 8 * j; const LAS float* s = scr + (8 * c) * 33 + n;
        v2u o; o.x = (unsigned)cvt4_fp8(s[0 * 33], s[1 * 33], s[2 * 33], s[3 * 33]); o.y = (unsigned)cvt4_fp8(s[4 * 33], s[5 * 33], s[6 * 33], s[7 * 33]);
        *(GAS v2u*)(wt_row0 + (size_t)n * K + k0 + 8 * c) = o; }
    LDS_WAIT(); asm volatile("" ::: "memory");
}
__device__ __forceinline__ void p0_prologue(Frame& F) {
    {
        LAS float* sl = (LAS float*)F.lds;
        const float* cvec = F.c(); const float* cctx = F.c_ctx(); const float* modw = F.mod_w(); float* MODPp = F.MODP(); gu32* ctlp = F.ctl(); const float* modb = F.mod_b(); float* MODo = F.MOD();
        for (int it = blockIdx.x; it < 2 * 16 * 12; it += F.G) {
            const int nc = it % 12, kc = (it / 12) % 16, l = it / (12 * 16);
            __syncthreads();
            if (F.tid < 320) { const int v = F.tid / 64, k = kc * 64 + (F.tid & 63); const float cv = (v < 4) ? cvec[v * D + k] : cctx[k]; sl[F.tid] = cv * sigmoidf_(cv); }
            __syncthreads();
            const int n = nc * 512 + F.tid;
            const float* wp = modw + ((size_t)l * D + kc * 64) * 6144 + n;
            float a0 = 0.f, a1 = 0.f, a2 = 0.f, a3 = 0.f, a4 = 0.f;
#pragma unroll 16
            for (int k = 0; k < 64; ++k) { const float w = wp[(size_t)k * 6144]; a0 += sl[k] * w; a1 += sl[64 + k] * w; a2 += sl[128 + k] * w; a3 += sl[192 + k] * w; a4 += sl[256 + k] * w; }
            float* o = MODPp + ((size_t)(kc * 2 + l) * 5) * 6144 + n;
            o[0] = a0; o[6144] = a1; o[2 * 6144] = a2; o[3 * 6144] = a3; o[4 * 6144] = a4;
        }
        __syncthreads();
    }
    const int gw = F.vcu * NWAVES + F.wave, NGW = F.G * NWAVES;
    LAS float* scr = (LAS float*)(F.lds + F.wave * 16384);
    constexpr int I_IN = 16 * (N_IN0 / 32), I_O = 16 * 32, I_QKV = 16 * (N_QKV1 / 32);
    constexpr int I_SMALL = I_IN + I_O + I_QKV + I_O;
    constexpr int I_W1 = 16 * 64, I_W2 = 16 * 32, I_EXP = I_W1 + I_W2;
    constexpr int NITEMS = I_SMALL + 2 * NEXP * I_EXP;
    for (int it = gw; it < NITEMS; it += NGW) {
        int r = it;
        if (r < I_IN) { const int nb = r % (N_IN0 / 32), kb = r / (N_IN0 / 32), n0 = nb * 32; const float sc = (n0 < 512) ? C2 * (ATTN_FASTEXP ? 8.0f : 1.0f) : ((n0 >= C_RQ && n0 < C_RK) ? 0.125f : 1.0f);
            p0_transpose_item(F.w_in(), N_IN0, D, F.WIN() + (size_t)n0 * D, sc, scr, kb * 64, n0, F.lane); continue; } r -= I_IN;
        if (r < I_O) { const int nb = r % 32, kb = r / 32; p0_transpose_item(F.w_out0(), D, D, F.WOUT0() + (size_t)nb * 32 * D, 1.0f, scr, kb * 64, nb * 32, F.lane); continue; } r -= I_O;
        if (r < I_QKV) { const int nb = r % (N_QKV1 / 32), kb = r / (N_QKV1 / 32), n0 = nb * 32; const float sc = (n0 < 1024) ? C2 * (SWA_FP8 ? 8.0f : 1.0f) : 1.0f;
            if (QKV1_FP8) p0_transpose_item8(F.w_qkv1(), N_QKV1, D, (unsigned char*)F.WQKV1() + (size_t)n0 * D, sc * W8_SCALE, scr, kb * 64, n0, F.lane);
            else p0_transpose_item(F.w_qkv1(), N_QKV1, D, F.WQKV1() + (size_t)n0 * D, sc, scr, kb * 64, n0, F.lane); continue; } r -= I_QKV;
        if (r < I_O) { const int nb = r % 32, kb = r / 32; p0_transpose_item(F.w_out1(), D, D, F.WOUT1() + (size_t)nb * 32 * D, 1.0f, scr, kb * 64, nb * 32, F.lane); continue; } r -= I_O;
        const int le = r / I_EXP; r -= le * I_EXP;
        if (r < I_W1) { const int nb = r % 64, kb = r / 64, n0 = nb * 32;
            const int nn = n0 & 1023, drow = (nn >> 7) * 256 + (n0 >= 1024 ? 128 : 0) + (nn & 127);
            p0_transpose_item8(F.moe_w1() + (size_t)le * D * 2048, 2048, D, (unsigned char*)F.W1T() + ((size_t)le * 2048 + drow) * D, W8_SCALE, scr, kb * 64, n0, F.lane); continue; } r -= I_W1;
        { const int nb = r % 32, kb = r / 32; p0_transpose_item8(F.moe_w2() + (size_t)le * DFF * D, D, DFF, (unsigned char*)F.W2T() + ((size_t)le * D + nb * 32) * DFF, W8_SCALE, scr, kb * 64, nb * 32, F.lane); }
    }
}
__device__ __forceinline__ void p1_mod_reduce(Frame& F) {
    const float* mb = F.mod_b(); const float* mp = F.MODP(); float* mo = F.MOD();
    for (int i = blockIdx.x * 512 + F.tid; i < 2 * 5 * 6144; i += F.G * 512) {
        const int n = i % 6144, l = i / (5 * 6144);
        float s = mb[l * 6144 + n];
#pragma unroll
        for (int kc = 0; kc < 16; ++kc) s += mp[(size_t)kc * (2 * 5 * 6144) + i];
        mo[i] = s;
    }
}

__device__ __forceinline__ void norm_mod_row(const f32x4 (&h)[4], const float* nw, const float* sc, const float* sh, bf16* orow, int lane, bool fp8out = false) {
    float s = 0.f;
#pragma unroll
    for (int j = 0; j < 4; ++j) s += (h[j].x * h[j].x + h[j].y * h[j].y) + (h[j].z * h[j].z + h[j].w * h[j].w);
    const float rs = 1.0f / sqrtf(wave_sum(s) * (1.0f / D) + EPS);
    GAS v2u* o8 = (GAS v2u*)orow + lane;
#pragma unroll
    for (int j = 0; j < 4; ++j) {
        const f32x4 w = ((const GAS f32x4*)nw)[lane + 64 * j], a = ((const GAS f32x4*)sc)[lane + 64 * j], b = ((const GAS f32x4*)sh)[lane + 64 * j];
        const f32x4 y = h[j] * rs * w * (1.0f + a) + b;
        if (fp8out) ((GAS unsigned*)orow)[lane + 64 * j] = (unsigned)cvt4_fp8(y.x, y.y, y.z, y.w);
        else { v2u o; o.x = pk2(y.x, y.y); o.y = pk2(y.z, y.w); o8[64 * j] = o; }
    }
}
__device__ __forceinline__ void p_norm1(Frame& F, int layer) {
    const int gw = F.vcu * NWAVES + F.wave, NGW = F.G * NWAVES;
    const float* MODp = F.MOD(); const float* xin = F.x(); const float* cin = F.ctx(); bf16* Ap = F.A(); const float* n1w = F.norm1_w() + layer * D;
    for (int r = gw; r < M; r += NGW) {
        const int v = row_v(r); const float* mod = MODp + ((size_t)layer * 5 + v) * 6144;
        const int b = r / RB, p = r - b * RB;
        const float* src = (p < CTXL) ? cin + ((size_t)b * CTXL + p) * D : xin + ((size_t)b * SEQ + (p - CTXL)) * D;
        f32x4 h[4]; const GAS f32x4* hp = (const GAS f32x4*)src + F.lane;
#pragma unroll
        for (int j = 0; j < 4; ++j) h[j] = hp[64 * j];
        norm_mod_row(h, n1w, mod + 1024, mod, Ap + (size_t)r * D, F.lane);
    }
}
template <int PITCH, int NHEADS>
__device__ __forceinline__ void p_rope(Frame& F, bf16* buf) {
    const int gw = F.vcu * NWAVES + F.wave, NGW = F.G * NWAVES;
    for (int i = gw; i < NB * SEQ; i += NGW) {
        const int b = i / SEQ, t = i - b * SEQ; const size_t r = (size_t)b * RB + CTXL + t;
        const float prow = (float)(t >> 6), pcol = (float)(t & 63);
#pragma unroll
        for (int pass = 0; pass < (NHEADS * 4 + 63) / 64; ++pass) {
            const int slot = pass * 64 + F.lane;
            if (slot < NHEADS * 4) {
                const int head = slot >> 2, part = (slot >> 1) & 1, jh = slot & 1;
                bf16* p = buf + r * PITCH + head * 64 + part * 32 + jh * 8;
                const v4u av = *(const GAS v4u*)p, bv = *(const GAS v4u*)(p + 16);
                const float pos = part ? pcol : prow;
                unsigned ao[4], bo[4];
#pragma unroll
                for (int q = 0; q < 4; ++q) {
                    float a0 = bf2f(av[q] & 0xffffu), a1 = bf2f(av[q] >> 16), b0 = bf2f(bv[q] & 0xffffu), b1 = bf2f(bv[q] >> 16);
                    const int j0 = jh * 8 + 2 * q;
                    const float ang0 = pos * exp2f(-(float)j0 * (13.287712379549449f / 16.0f)), ang1 = pos * exp2f(-(float)(j0 + 1) * (13.287712379549449f / 16.0f));
                    float s0, c0, s1, c1; __sincosf(ang0, &s0, &c0); __sincosf(ang1, &s1, &c1);
                    ao[q] = pk2(a0 * c0 - b0 * s0, a1 * c1 - b1 * s1); bo[q] = pk2(a0 * s0 + b0 * c0, a1 * s1 + b1 * c1);
                }
                *(GAS v4u*)p = (v4u){ao[0], ao[1], ao[2], ao[3]}; *(GAS v4u*)(p + 16) = (v4u){bo[0], bo[1], bo[2], bo[3]};
            }
        }
    }
}

__device__ __forceinline__ float ret_lg2(const Frame& F, int dir, int h) { const float x = F.ret_decay()[dir * 4 + h]; return -log1pf(__expf(-x)) * LOG2E; }
typedef __attribute__((address_space(3))) bf16 lbf16;
__device__ __forceinline__ void ret_stage_vt(const bf16* vbase, lbf16* Vt, int tid) {
#pragma unroll
    for (int pass = 0; pass < 4; ++pass) { const int j = tid & 127, c = (tid >> 7) + 4 * pass;
        const v4u v = *(const GAS v4u*)(vbase + (size_t)j * 3072 + c * 8);
#pragma unroll
        for (int q = 0; q < 4; ++q) { Vt[(c * 8 + 2 * q) * 136 + j] = (bf16)(v[q] & 0xffffu); Vt[(c * 8 + 2 * q + 1) * 136 + j] = (bf16)(v[q] >> 16); } }
}
__device__ __forceinline__ void ret_kv_item(Frame& F, int item) {
    const int n = item % NCH, h = (item / NCH) & 3, b = item / (NCH * 4);
    int lane = F.lane; asm volatile("" : "+v"(lane));
    const int w = F.wave, tid = w * 64 + lane, fr = lane & 15, fq = lane >> 4;
    lbf16* Vt = (lbf16*)F.lds; lbf16* Kft = (lbf16*)(F.lds + 34816); lbf16* Kbt = (lbf16*)(F.lds + 34816 + 17408);
    const bf16* base = F.QKV() + (size_t)(b * RB + n * 128) * 3072;
    const float lgf = ret_lg2(F, 0, h), lgb = ret_lg2(F, 1, h);
    ret_stage_vt(base + C_RV + h * 128, Vt, tid);
#pragma unroll
    for (int pass = 0; pass < 2; ++pass) { const int j = tid & 127, c = (tid >> 7) + 4 * pass;
        const v4u v = *(const GAS v4u*)(base + (size_t)j * 3072 + C_RK + h * 64 + c * 8);
        const float wf = fast_exp2(lgf * (float)(127 - j)), wb = fast_exp2(lgb * (float)j);
#pragma unroll
        for (int q = 0; q < 4; ++q) { const float k0 = bf2f(v[q] & 0xffffu), k1 = bf2f(v[q] >> 16);
            Kft[(c * 8 + 2 * q) * 136 + j] = (bf16)f2bf(k0 * wf); Kft[(c * 8 + 2 * q + 1) * 136 + j] = (bf16)f2bf(k1 * wf);
            Kbt[(c * 8 + 2 * q) * 136 + j] = (bf16)f2bf(k0 * wb); Kbt[(c * 8 + 2 * q + 1) * 136 + j] = (bf16)f2bf(k1 * wb); } }
    __syncthreads();
    const int dir = w & 1, eb = (w >> 1) * 32;
    lbf16* Kt = dir ? Kbt : Kft;
    f32x4 acc[2][4];
#pragma unroll
    for (int a = 0; a < 2; ++a)
#pragma unroll
        for (int d = 0; d < 4; ++d) acc[a][d] = (f32x4){0.f, 0.f, 0.f, 0.f};
#pragma unroll
    for (int ks = 0; ks < 4; ++ks) {
        bf16x8 af[2], bfr[4];
#pragma unroll
        for (int a = 0; a < 2; ++a) af[a] = *(const LAS bf16x8*)(Vt + (eb + a * 16 + fr) * 136 + ks * 32 + fq * 8);
#pragma unroll
        for (int d = 0; d < 4; ++d) bfr[d] = *(const LAS bf16x8*)(Kt + (d * 16 + fr) * 136 + ks * 32 + fq * 8);
#pragma unroll
        for (int a = 0; a < 2; ++a)
#pragma unroll
            for (int d = 0; d < 4; ++d) acc[a][d] = __builtin_amdgcn_mfma_f32_16x16x32_bf16(af[a], bfr[d], acc[a][d], 0, 0, 0);
        __builtin_amdgcn_sched_barrier(0);
    }
    float* out = F.CKV() + ((size_t)(((b * 4 + h) * 2 + dir) * NCH + n)) * 8192;
#pragma unroll
    for (int a = 0; a < 2; ++a)
#pragma unroll
        for (int d = 0; d < 4; ++d)
#pragma unroll
            for (int v = 0; v < 4; ++v) out[(eb + a * 16 + 4 * fq + v) * 64 + d * 16 + fr] = acc[a][d][v];
    __syncthreads();
}
template <int NH, int NC, int COL0>
__device__ __forceinline__ void p_tr16(Frame& F, bf16* dstb) {
    const int gw = F.vcu * NWAVES + F.wave, NGW = F.G * NWAVES;
    lbf16* sc = (lbf16*)(F.lds + F.wave * 16384);
    const bf16* qkv = F.QKV();
    for (int it = gw; it < NB * NH * (RB / 64); it += NGW) {
        const int t = it % (RB / 64), h = (it / (RB / 64)) % NH, b = it / ((RB / 64) * NH);
        const bf16* src = qkv + ((size_t)b * RB + t * 64 + F.lane) * N_IN0 + COL0 + h * NC;
#pragma unroll
        for (int c = 0; c < NC / 8; ++c) { const v4u v = *(const GAS v4u*)(src + c * 8);
#pragma unroll
            for (int q = 0; q < 4; ++q) { sc[(c * 8 + 2 * q) * 64 + F.lane] = (bf16)(v[q] & 0xffffu); sc[(c * 8 + 2 * q + 1) * 64 + F.lane] = (bf16)(v[q] >> 16); } }
        LDS_WAIT(); asm volatile("" ::: "memory");
        bf16* dst = dstb + ((size_t)((b * NH + h) * NC)) * RB + t * 64;
#pragma unroll
        for (int i = 0; i < NC / 8; ++i) { const int ch = i * 64 + F.lane, col = ch >> 3, q = ch & 7; *(GAS v4u*)(dst + (size_t)col * RB + q * 8) = *(const LAS v4u*)(sc + col * 64 + q * 8); }
        LDS_WAIT(); asm volatile("" ::: "memory");
    }
}
__device__ __forceinline__ void ret_kv_item2(Frame& F, int item) {
    const int n = item % NCH, h = (item / NCH) & 3, b = item / (NCH * 4);
    int lane = F.lane; asm volatile("" : "+v"(lane));
    const int w = F.wave, tid = w * 64 + lane, fr = lane & 15, fq = lane >> 4;
    lbf16* Vt = (lbf16*)F.lds; lbf16* Kft = (lbf16*)(F.lds + 34816); lbf16* Kbt = (lbf16*)(F.lds + 34816 + 17408);
    const bf16* vt = F.RVT() + ((size_t)((b * 4 + h) * 128)) * RB + n * 128; const bf16* kt = F.RKT() + ((size_t)((b * 4 + h) * 64)) * RB + n * 128;
    const float lgf = ret_lg2(F, 0, h), lgb = ret_lg2(F, 1, h);
#pragma unroll
    for (int p = 0; p < 4; ++p) { const int ch = tid + 512 * p, e = ch >> 4, c = ch & 15; *(LAS v4u*)(Vt + e * 136 + c * 8) = *(const GAS v4u*)(vt + (size_t)e * RB + c * 8); }
#pragma unroll
    for (int p = 0; p < 2; ++p) { const int ch = tid + 512 * p, d = ch >> 4, c = ch & 15; const v4u v = *(const GAS v4u*)(kt + (size_t)d * RB + c * 8);
        v4u of, ob;
#pragma unroll
        for (int q = 0; q < 4; ++q) { const int j = c * 8 + 2 * q; const float k0 = bf2f(v[q] & 0xffffu), k1 = bf2f(v[q] >> 16);
            of[q] = pk2(k0 * fast_exp2(lgf * (float)(127 - j)), k1 * fast_exp2(lgf * (float)(126 - j)));
            ob[q] = pk2(k0 * fast_exp2(lgb * (float)j), k1 * fast_exp2(lgb * (float)(j + 1))); }
        *(LAS v4u*)(Kft + d * 136 + c * 8) = of; *(LAS v4u*)(Kbt + d * 136 + c * 8) = ob; }
    __syncthreads();
    const int dir = w & 1, eb = (w >> 1) * 32;
    lbf16* Kt = dir ? Kbt : Kft;
    f32x4 acc[2][4];
#pragma unroll
    for (int a = 0; a < 2; ++a)
#pragma unroll
        for (int d = 0; d < 4; ++d) acc[a][d] = (f32x4){0.f, 0.f, 0.f, 0.f};
#pragma unroll
    for (int ks = 0; ks < 4; ++ks) {
        bf16x8 af[2], bfr[4];
#pragma unroll
        for (int a = 0; a < 2; ++a) af[a] = *(const LAS bf16x8*)(Vt + (eb + a * 16 + fr) * 136 + ks * 32 + fq * 8);
#pragma unroll
        for (int d = 0; d < 4; ++d) bfr[d] = *(const LAS bf16x8*)(Kt + (d * 16 + fr) * 136 + ks * 32 + fq * 8);
#pragma unroll
        for (int a = 0; a < 2; ++a)
#pragma unroll
            for (int d = 0; d < 4; ++d) acc[a][d] = __builtin_amdgcn_mfma_f32_16x16x32_bf16(af[a], bfr[d], acc[a][d], 0, 0, 0);
        __builtin_amdgcn_sched_barrier(0);
    }
    float* out = F.CKV() + ((size_t)(((b * 4 + h) * 2 + dir) * NCH + n)) * 8192;
#pragma unroll
    for (int a = 0; a < 2; ++a)
#pragma unroll
        for (int d = 0; d < 4; ++d)
#pragma unroll
            for (int v = 0; v < 4; ++v) out[(eb + a * 16 + 4 * fq + v) * 64 + d * 16 + fr] = acc[a][d][v];
    __syncthreads();
}
__device__ __forceinline__ void ret_out_item2(Frame& F, int item) {
    const int n = item % NCH, h = (item / NCH) & 3, b = item / (NCH * 4);
    int lane = F.lane; asm volatile("" : "+v"(lane));
    const int w = F.wave, tid = w * 64 + lane, fr = lane & 15, fq = lane >> 4;
    lbf16* Qs = (lbf16*)F.lds; lbf16* Ks = (lbf16*)(F.lds + 18432); lbf16* Vt = (lbf16*)(F.lds + 36864);
    lbf16* Pf = (lbf16*)(F.lds + 71680); lbf16* Pb = (lbf16*)(F.lds + 90112); lbf16* Ps = (lbf16*)F.lds;
    const size_t row0 = (size_t)b * RB + n * 128;
    const bf16* base = F.QKV() + row0 * 3072;
    const float lgf = ret_lg2(F, 0, h), lgb = ret_lg2(F, 1, h);
    bf16* cat = F.CAT(); const float* rnw = F.ret_norm_w();
    const bf16* pf = F.PREV() + ((size_t)(((b * 4 + h) * 2 + 0) * NCH + n)) * 8192; const bf16* pb = F.PREV() + ((size_t)(((b * 4 + h) * 2 + 1) * NCH + n)) * 8192;
    const bf16* vt = F.RVT() + ((size_t)((b * 4 + h) * 128)) * RB + n * 128;
#pragma unroll
    for (int pass = 0; pass < 2; ++pass) { const int ch = tid + 512 * pass, row = ch >> 3, c = ch & 7;
        *(LAS v4u*)(Qs + row * 72 + c * 8) = *(const GAS v4u*)(base + (size_t)row * 3072 + C_RQ + h * 64 + c * 8);
        *(LAS v4u*)(Ks + row * 72 + c * 8) = *(const GAS v4u*)(base + (size_t)row * 3072 + C_RK + h * 64 + c * 8);
        *(LAS v4u*)(Pf + row * 72 + c * 8) = *(const GAS v4u*)(pf + row * 64 + c * 8);
        *(LAS v4u*)(Pb + row * 72 + c * 8) = *(const GAS v4u*)(pb + row * 64 + c * 8); }
#pragma unroll
    for (int p = 0; p < 4; ++p) { const int ch = tid + 512 * p, e = ch >> 4, c = ch & 15; *(LAS v4u*)(Vt + e * 136 + c * 8) = *(const GAS v4u*)(vt + (size_t)e * RB + c * 8); }
    __syncthreads();
    const int i0 = 16 * w, i = i0 + fr;
    v2u gr[8]; { const GAS v2u* gp_ = (const GAS v2u*)(base + (size_t)i * 3072 + C_RG + h * 128 + 4 * fq);
#pragma unroll
        for (int t = 0; t < 8; ++t) gr[t] = gp_[4 * t]; }
    f32x4 as[8], af_[8], ab_[8];
#pragma unroll
    for (int t = 0; t < 8; ++t) { as[t] = (f32x4){0.f, 0.f, 0.f, 0.f}; af_[t] = as[t]; ab_[t] = as[t]; }
#pragma unroll
    for (int ks = 0; ks < 2; ++ks) {
        const bf16x8 q = *(const LAS bf16x8*)(Qs + (i0 + fr) * 72 + ks * 32 + fq * 8);
#pragma unroll
        for (int t = 0; t < 8; ++t) {
            as[t]  = __builtin_amdgcn_mfma_f32_16x16x32_bf16(*(const LAS bf16x8*)(Ks + (t * 16 + fr) * 72 + ks * 32 + fq * 8), q, as[t], 0, 0, 0);
            af_[t] = __builtin_amdgcn_mfma_f32_16x16x32_bf16(*(const LAS bf16x8*)(Pf + (t * 16 + fr) * 72 + ks * 32 + fq * 8), q, af_[t], 0, 0, 0);
            ab_[t] = __builtin_amdgcn_mfma_f32_16x16x32_bf16(*(const LAS bf16x8*)(Pb + (t * 16 + fr) * 72 + ks * 32 + fq * 8), q, ab_[t], 0, 0, 0);
            if (t & 1) __builtin_amdgcn_sched_barrier(0);
        }
    }
    __syncthreads();
#pragma unroll
    for (int t = 0; t < 8; ++t) { float pv_[4];
#pragma unroll
        for (int v = 0; v < 4; ++v) { const int j = t * 16 + 4 * fq + v, dl = i - j;
            const float dec = dl > 0 ? fast_exp2(lgf * (float)dl) : (dl < 0 ? fast_exp2(lgb * (float)(-dl)) : 2.0f);
            pv_[v] = as[t][v] * dec; }
        *(LAS v2u*)(Ps + i * 136 + t * 16 + 4 * fq) = (v2u){pk2(pv_[0], pv_[1]), pk2(pv_[2], pv_[3])}; }
    __syncthreads();
    f32x4 ao[8];
#pragma unroll
    for (int t = 0; t < 8; ++t) ao[t] = (f32x4){0.f, 0.f, 0.f, 0.f};
#pragma unroll
    for (int ks = 0; ks < 4; ++ks) {
        const bf16x8 p = *(const LAS bf16x8*)(Ps + (i0 + fr) * 136 + ks * 32 + fq * 8);
#pragma unroll
        for (int t = 0; t < 8; ++t) ao[t] = __builtin_amdgcn_mfma_f32_16x16x32_bf16(*(const LAS bf16x8*)(Vt + (t * 16 + fr) * 136 + ks * 32 + fq * 8), p, ao[t], 0, 0, 0);
        __builtin_amdgcn_sched_barrier(0);
    }
    {
        const float df = fast_exp2(lgf * (float)(i + 1)), db = fast_exp2(lgb * (float)(128 - i));
        float ss = 0.f;
#pragma unroll
        for (int t = 0; t < 8; ++t) { ao[t] = ao[t] + df * af_[t] + db * ab_[t]; ss += (ao[t][0] * ao[t][0] + ao[t][1] * ao[t][1]) + (ao[t][2] * ao[t][2] + ao[t][3] * ao[t][3]); }
        ss += __shfl_xor(ss, 16); ss += __shfl_xor(ss, 32);
        const float rs = 1.0f / sqrtf(ss * (1.0f / 128.0f) + EPS);
        bf16* orow = cat + (row0 + i) * D + 512 + h * 128 + 4 * fq;
#pragma unroll
        for (int t = 0; t < 8; ++t) { const f32x4 g = (f32x4){bf2f(gr[t].x & 0xffffu), bf2f(gr[t].x >> 16), bf2f(gr[t].y & 0xffffu), bf2f(gr[t].y >> 16)}; const f32x4 wv = *(const GAS f32x4*)(rnw + t * 16 + 4 * fq);
            f32x4 sg; sg[0] = g[0] * sigmoidf_(g[0]); sg[1] = g[1] * sigmoidf_(g[1]); sg[2] = g[2] * sigmoidf_(g[2]); sg[3] = g[3] * sigmoidf_(g[3]);
            st4bf(orow + t * 16, ao[t] * rs * wv * sg); }
    }
    __syncthreads();
}
template <int NH, int NC, int PITCH, int COL0>
__device__ __forceinline__ void p_vt8(Frame& F, unsigned char* vt) {
    const int gw = F.vcu * NWAVES + F.wave, NGW = F.G * NWAVES;
    LAS unsigned char* sc8 = (LAS unsigned char*)(F.lds + F.wave * 8192);
    const bf16* qkv = F.QKV();
    for (int it = gw; it < NB * NH * (RB / 64); it += NGW) {
        const int t = it % (RB / 64), h = (it / (RB / 64)) % NH, b = it / ((RB / 64) * NH);
        const bf16* src = qkv + ((size_t)b * RB + t * 64 + F.lane) * PITCH + COL0 + h * NC;
        const int slot = attn_dv::vt8_slot(F.lane);
#pragma unroll
        for (int c = 0; c < NC / 8; ++c) { const v4u v = *(const GAS v4u*)(src + c * 8);
#pragma unroll
            for (int q = 0; q < 4; ++q) { const int w = cvt4_fp8(bf2f(v[q] & 0xffffu), bf2f(v[q] >> 16), 0.f, 0.f);
                sc8[(c * 8 + 2 * q) * 64 + slot] = (unsigned char)(w & 0xff); sc8[(c * 8 + 2 * q + 1) * 64 + slot] = (unsigned char)((w >> 8) & 0xff); } }
        LDS_WAIT(); asm volatile("" ::: "memory");
        unsigned char* dst = vt + ((size_t)((b * NH + h) * NC)) * RB + t * 64;
#pragma unroll
        for (int i = 0; i < NC / 16; ++i) { const int ch = i * 64 + F.lane, col = ch >> 2, q = ch & 3; *(GAS v4u*)(dst + (size_t)col * RB + q * 16) = *(const LAS v4u*)(sc8 + col * 64 + q * 16); }
        LDS_WAIT(); asm volatile("" ::: "memory");
    }
}
__device__ __forceinline__ void p_ret_scan(Frame& F) {
    const float* ckv = F.CKV(); bf16* prev = F.PREV(); const float* rdl = F.ret_decay();
    for (int i = blockIdx.x * 512 + F.tid; i < NB * 4 * 2 * 4096; i += F.G * 512) {
        const int el = i & 4095, seq = i >> 12, dir = seq & 1, h = (seq >> 1) & 3;
        const float gC = fast_exp2(-log1pf(__expf(-rdl[dir * 4 + h])) * LOG2E * 128.0f);
        const float* src = ckv + (size_t)seq * NCH * 8192 + el * 2; bf16* dst = prev + (size_t)seq * NCH * 8192 + el * 2;
        float s0 = 0.f, s1 = 0.f;
#pragma unroll 33
        for (int s = 0; s < NCH; ++s) {
            const int n = dir ? (s < 2 ? 1 - s : NCH + 1 - s) : s;
            const f32x2 v = *(const GAS f32x2*)(src + (size_t)n * 8192);
            *(GAS unsigned*)(dst + (size_t)n * 8192) = pk2(s0, s1);
            s0 = gC * s0 + v.x; s1 = gC * s1 + v.y;
        }
    }
}
__device__ __forceinline__ void ret_out_item(Frame& F, int item) {
    const int n = item % NCH, h = (item / NCH) & 3, b = item / (NCH * 4);
    int lane = F.lane; asm volatile("" : "+v"(lane));
    const int w = F.wave, tid = w * 64 + lane, fr = lane & 15, fq = lane >> 4;
    lbf16* Qs = (lbf16*)F.lds; lbf16* Ks = (lbf16*)(F.lds + 18432); lbf16* Vt = (lbf16*)(F.lds + 36864);
    lbf16* Pf = (lbf16*)(F.lds + 71680); lbf16* Pb = (lbf16*)(F.lds + 90112); lbf16* Ps = (lbf16*)F.lds;
    const size_t row0 = (size_t)b * RB + n * 128;
    const bf16* base = F.QKV() + row0 * 3072;
    const float lgf = ret_lg2(F, 0, h), lgb = ret_lg2(F, 1, h);
    bf16* cat = F.CAT(); const float* rnw = F.ret_norm_w();
    const bf16* pf = F.PREV() + ((size_t)(((b * 4 + h) * 2 + 0) * NCH + n)) * 8192; const bf16* pb = F.PREV() + ((size_t)(((b * 4 + h) * 2 + 1) * NCH + n)) * 8192;
#pragma unroll
    for (int pass = 0; pass < 2; ++pass) { const int ch = tid + 512 * pass, row = ch >> 3, c = ch & 7;
        *(LAS v4u*)(Qs + row * 72 + c * 8) = *(const GAS v4u*)(base + (size_t)row * 3072 + C_RQ + h * 64 + c * 8);
        *(LAS v4u*)(Ks + row * 72 + c * 8) = *(const GAS v4u*)(base + (size_t)row * 3072 + C_RK + h * 64 + c * 8);
        *(LAS v4u*)(Pf + row * 72 + c * 8) = *(const GAS v4u*)(pf + row * 64 + c * 8);
        *(LAS v4u*)(Pb + row * 72 + c * 8) = *(const GAS v4u*)(pb + row * 64 + c * 8); }
    ret_stage_vt(base + C_RV + h * 128, Vt, tid);
    __syncthreads();
    const int i0 = 16 * w;
    f32x4 as[8], af_[8], ab_[8];
#pragma unroll
    for (int t = 0; t < 8; ++t) { as[t] = (f32x4){0.f, 0.f, 0.f, 0.f}; af_[t] = as[t]; ab_[t] = as[t]; }
#pragma unroll
    for (int ks = 0; ks < 2; ++ks) {
        const bf16x8 a = *(const LAS bf16x8*)(Qs + (i0 + fr) * 72 + ks * 32 + fq * 8);
#pragma unroll
        for (int t = 0; t < 8; ++t) {
            as[t]  = __builtin_amdgcn_mfma_f32_16x16x32_bf16(a, *(const LAS bf16x8*)(Ks + (t * 16 + fr) * 72 + ks * 32 + fq * 8), as[t], 0, 0, 0);
            af_[t] = __builtin_amdgcn_mfma_f32_16x16x32_bf16(a, *(const LAS bf16x8*)(Pf + (t * 16 + fr) * 72 + ks * 32 + fq * 8), af_[t], 0, 0, 0);
            ab_[t] = __builtin_amdgcn_mfma_f32_16x16x32_bf16(a, *(const LAS bf16x8*)(Pb + (t * 16 + fr) * 72 + ks * 32 + fq * 8), ab_[t], 0, 0, 0);
            if (t & 1) __builtin_amdgcn_sched_barrier(0);
        }
    }
    __syncthreads();
#pragma unroll
    for (int t = 0; t < 8; ++t)
#pragma unroll
        for (int v = 0; v < 4; ++v) { const int i = i0 + 4 * fq + v, j = t * 16 + fr, dl = i - j;
            const float dec = dl > 0 ? fast_exp2(lgf * (float)dl) : (dl < 0 ? fast_exp2(lgb * (float)(-dl)) : 2.0f);
            Ps[i * 136 + j] = (bf16)f2bf(as[t][v] * dec); }
    __syncthreads();
    f32x4 ao[8];
#pragma unroll
    for (int t = 0; t < 8; ++t) ao[t] = (f32x4){0.f, 0.f, 0.f, 0.f};
#pragma unroll
    for (int ks = 0; ks < 4; ++ks) {
        const bf16x8 a = *(const LAS bf16x8*)(Ps + (i0 + fr) * 136 + ks * 32 + fq * 8);
#pragma unroll
        for (int t = 0; t < 8; ++t) ao[t] = __builtin_amdgcn_mfma_f32_16x16x32_bf16(a, *(const LAS bf16x8*)(Vt + (t * 16 + fr) * 136 + ks * 32 + fq * 8), ao[t], 0, 0, 0);
        __builtin_amdgcn_sched_barrier(0);
    }
#pragma unroll
    for (int v = 0; v < 4; ++v) {
        const int i = i0 + 4 * fq + v;
        const float df = fast_exp2(lgf * (float)(i + 1)), db = fast_exp2(lgb * (float)(128 - i));
        float o[8], ss = 0.f;
#pragma unroll
        for (int t = 0; t < 8; ++t) { o[t] = ao[t][v] + df * af_[t][v] + db * ab_[t][v]; ss += o[t] * o[t]; }
        ss += __shfl_xor(ss, 1); ss += __shfl_xor(ss, 2); ss += __shfl_xor(ss, 4); ss += __shfl_xor(ss, 8);
        const float rs = 1.0f / sqrtf(ss * (1.0f / 128.0f) + EPS);
        const size_t r = row0 + i;
#pragma unroll
        for (int t = 0; t < 8; ++t) { const int e = t * 16 + fr;
            const float g = bf2f(base[(size_t)i * 3072 + C_RG + h * 128 + e]);
            cat[r * D + 512 + h * 128 + e] = (bf16)f2bf(o[t] * rs * rnw[e] * (g * sigmoidf_(g))); }
    }
    __syncthreads();
}
__device__ __forceinline__ void p_dfinish(Frame& F) {
    const int gw = F.vcu * NWAVES + F.wave, NGW = F.G * NWAVES;
    const float* dl_ = F.diff_lam(); bf16* cat = F.CAT();
    const float s1 = wave_sum(dl_[F.lane] * dl_[64 + F.lane]), s2 = wave_sum(dl_[128 + F.lane] * dl_[192 + F.lane]);
    const float lam = __expf(s1) - __expf(s2) + 0.2f;
    const bf16* O0 = F.OD(); const bf16* O1 = O0 + (size_t)M * 512; const float* dnw = F.diff_norm_w();
    float nw[8];
#pragma unroll
    for (int q = 0; q < 8; ++q) nw[q] = dnw[(F.lane & 15) * 8 + q] * 0.8f;
    for (int r = gw; r < M; r += NGW) {
        const v4u a = *(const GAS v4u*)(O0 + (size_t)r * 512 + F.lane * 8), b = *(const GAS v4u*)(O1 + (size_t)r * 512 + F.lane * 8);
        float d[8], ss = 0.f;
#pragma unroll
        for (int q = 0; q < 4; ++q) { d[2 * q] = bf2f(a[q] & 0xffffu) - lam * bf2f(b[q] & 0xffffu); d[2 * q + 1] = bf2f(a[q] >> 16) - lam * bf2f(b[q] >> 16); ss += d[2 * q] * d[2 * q] + d[2 * q + 1] * d[2 * q + 1]; }
        ss += __shfl_xor(ss, 1); ss += __shfl_xor(ss, 2); ss += __shfl_xor(ss, 4); ss += __shfl_xor(ss, 8);
        const float rs = 1.0f / sqrtf(ss * (1.0f / 128.0f) + EPS);
        v4u o;
#pragma unroll
        for (int q = 0; q < 4; ++q) o[q] = pk2(d[2 * q] * rs * nw[2 * q], d[2 * q + 1] * rs * nw[2 * q + 1]);
        *(GAS v4u*)(cat + (size_t)r * D + F.lane * 8) = o;
    }
}

template <class Epi, bool F8 = false> struct DenseProb {
    static constexpr bool PERM = Epi::PERM;
    const bf16* A; const bf16* Bt; int K, nM, nN, G, c; bool skipctx; Epi E;
    __device__ __forceinline__ bool next(int i, pg8::Unit& u) const {
        const int nwg = nM * nN; const long L = (long)i * G + c; if (L >= nwg) return false;
        int wgid = (int)L; { const int q = nwg / pg8::NXCD, r = nwg % pg8::NXCD, xcd = wgid % pg8::NXCD, off = wgid / pg8::NXCD; wgid = (xcd < r ? xcd * (q + 1) : r * (q + 1) + (xcd - r) * q) + off; }
        const int nig = pg8::WGM * nN, gid = wgid / nig, fm = gid * pg8::WGM, gsz = (nM - fm) < pg8::WGM ? (nM - fm) : pg8::WGM;
        int pm = fm + ((wgid % nig) % gsz); u.pn = (wgid % nig) / gsz; u.e = 0;
        if (skipctx) pm = (pm >> 5) * TPB + 1 + (pm & 31);
        u.pm = pm; return true;
    }
    __device__ __forceinline__ const char* a_base() const { return (const char*)A; }
    __device__ __forceinline__ void a_offs(const pg8::Unit& u, const int (&R)[2], const int (&C)[2], unsigned (&o)[2][2]) const {
#pragma unroll
        for (int h = 0; h < 2; ++h)
#pragma unroll
            for (int i = 0; i < 2; ++i) o[h][i] = (unsigned)((u.pm * 256 + h * 128 + R[i]) * K + C[i]) * 2u;
    }
    __device__ __forceinline__ const char* b_base(const pg8::Unit& u) const { return (const char*)Bt + (size_t)u.pn * 256 * K * 2; }
    static constexpr int NBIAS = 0; static constexpr bool FP8 = F8;
    __device__ __forceinline__ unsigned a_fix(unsigned x, int) const { return x; }
    __device__ __forceinline__ const float* bias_src(const pg8::Unit&, int) const { return nullptr; }
    __device__ __forceinline__ void epi(const f32x4 (&acc)[2][2][4][2], const pg8::Unit& u, int wr, int wc, int fr, int fq, const LAS float*) const { E(acc, u, wr, wc, fr, fq); }
};
struct EpiStoreBf16 {
    static constexpr bool PERM = true;
    bf16* O; int ldc; int rope_cols; float ascale; unsigned char* qk8; unsigned char* k8;
    __device__ __forceinline__ void operator()(const f32x4 (&acc)[2][2][4][2], const pg8::Unit& u, int wr, int wc, int fr, int fq) const {
        const int row0 = u.pm * 256 + wr * 64 + fr, col0 = u.pn * 256 + wc * 32 + 8 * fq;
        const int bq = u.pm / TPB, tt = u.pm - bq * TPB;
        const bool rope_tile = (tt != 0) && (u.pn * 256 < rope_cols);
        const float sgn = fq < 2 ? -1.0f : 1.0f;
#pragma unroll
        for (int ai = 0; ai < 2; ++ai)
#pragma unroll
            for (int m = 0; m < 4; ++m) { bf16* rowp = O + (size_t)(row0 + ai * 128 + m * 16) * ldc + col0;
                float y[2][8];
#pragma unroll
                for (int bj = 0; bj < 2; ++bj)
#pragma unroll
                    for (int i = 0; i < 8; ++i) y[bj][i] = acc[ai][bj][m][i >> 2][i & 3] * ascale;
                if (rope_tile) { const int t = (tt - 1) * 256 + ai * 128 + wr * 64 + m * 16 + fr; const float pos = (wc & 1) ? (float)(t & 63) : (float)(t >> 6);
#pragma unroll
                    for (int i = 0; i < 8; ++i) { float sn, cs; __sincosf(pos * exp2f(-(float)(8 * (fq & 1) + i) * (13.287712379549449f / 16.0f)), &sn, &cs);
#pragma unroll
                        for (int bj = 0; bj < 2; ++bj) if (u.pn * 256 + bj * 128 < rope_cols) { const float p = __shfl_xor(y[bj][i], 32); y[bj][i] = y[bj][i] * cs + sgn * p * sn; } } }
#pragma unroll
                for (int bj = 0; bj < 2; ++bj) {
                    if (k8 && u.pn == 4 && bj == 0) { *(GAS v2u*)(k8 + (size_t)(row0 + ai * 128 + m * 16) * 128 + wc * 32 + 8 * fq) = (v2u){(unsigned)cvt4_fp8(y[bj][0], y[bj][1], y[bj][2], y[bj][3]), (unsigned)cvt4_fp8(y[bj][4], y[bj][5], y[bj][6], y[bj][7])}; continue; }
                    if (qk8 && u.pn < 4) { *(GAS v2u*)(qk8 + (size_t)(row0 + ai * 128 + m * 16) * 1024 + col0 + bj * 128) = (v2u){(unsigned)cvt4_fp8(y[bj][0], y[bj][1], y[bj][2], y[bj][3]), (unsigned)cvt4_fp8(y[bj][4], y[bj][5], y[bj][6], y[bj][7])}; continue; }
                    v4u w; w.x = cvt_pk_bf16(y[bj][0], y[bj][1]); w.y = cvt_pk_bf16(y[bj][2], y[bj][3]); w.z = cvt_pk_bf16(y[bj][4], y[bj][5]); w.w = cvt_pk_bf16(y[bj][6], y[bj][7]);
                    *(GAS v4u*)(rowp + bj * 128) = w; } }
    }
};
struct EpiResid {
    static constexpr bool PERM = false;
    bf16* H; const float* MODL; int goff; const float* xin; const float* cin;
    __device__ __forceinline__ void operator()(const f32x4 (&acc)[2][2][4][2], const pg8::Unit& u, int wr, int wc, int fr, int fq) const {
        const int row0 = u.pm * 256 + wr * 64 + fr, col0 = u.pn * 256 + wc * 32 + 4 * fq;
        const int b = u.pm / TPB, tt = u.pm - b * TPB, v = tt == 0 ? 4 : b;
        const float* src = xin ? (tt == 0 ? cin + (size_t)b * CTXL * D : xin + ((size_t)b * SEQ + (tt - 1) * 256) * D) + (size_t)(wr * 64 + fr) * D + col0 : nullptr;
        const float* g = MODL + (size_t)v * 6144 + goff + col0;
        f32x4 gv[2][2];
#pragma unroll
        for (int bj = 0; bj < 2; ++bj)
#pragma unroll
            for (int n = 0; n < 2; ++n) gv[bj][n] = *(const GAS f32x4*)(g + bj * 128 + n * 16);
#pragma unroll
        for (int ai = 0; ai < 2; ++ai)
#pragma unroll
            for (int m = 0; m < 4; ++m) { bf16* rowp = H + (size_t)(row0 + ai * 128 + m * 16) * D + col0; const float* srow = src + (size_t)(ai * 128 + m * 16) * D;
#pragma unroll
                for (int bj = 0; bj < 2; ++bj)
#pragma unroll
                    for (int n = 0; n < 2; ++n) { bf16* p = rowp + bj * 128 + n * 16; const f32x4 res = xin ? *(const GAS f32x4*)(srow + bj * 128 + n * 16) : ld4bf(p); st4bf(p, res + gv[bj][n] * acc[ai][bj][m][n]); } }
    }
};
__device__ __forceinline__ void moe_tables(Frame& F, int layer) {
    __syncthreads();
    if (F.tid < 64) {
        const int e = F.lane & 31;
        const unsigned c = __hip_atomic_load(F.ctl() + CW_CNT + (layer * 32 + e) * 64, RLX_AGENT);
        const unsigned tl = (c + 255u) >> 8; unsigned inc = tl;
#pragma unroll
        for (int o = 1; o < 32; o <<= 1) { const unsigned up = __shfl_up(inc, o); if (e >= o) inc += up; }
        if (F.lane < 32) { F.MISC[MW_CNT + e] = c; F.MISC[MW_TST + e] = inc - tl; if (e == 31) F.MISC[MW_TST + NEXP] = inc; } }
    __syncthreads();
    { LAS unsigned char* te = (LAS unsigned char*)(F.lds + TILE_E_OFF);
      for (int t = F.tid; t < 576; t += NWAVES * 64) { int e = 0;
#pragma unroll
          for (int st = 16; st >= 1; st >>= 1) { if (t >= (int)F.MISC[MW_TST + e + st]) e += st; }
          te[t] = (unsigned char)e; } }
    __syncthreads();
}
struct Moe1Prob {
    static constexpr bool PERM = true;
    const bf16* Fin; const bf16* W1l; const float* b1l; const int* LIST; bf16* ACT; volatile LAS unsigned* MISC; int K, G, c;
    __device__ __forceinline__ bool next(int i, pg8::Unit& u) const {
        const int L = i * G + c, tt = (int)MISC[MW_TST + NEXP]; if (L >= tt * 8) return false;
        const int tr = L >> 3;
        u.pm = tr; u.pn = L & 7; u.e = (int)((const volatile LAS unsigned char*)((const volatile LAS unsigned char*)MISC - MISC_OFF + TILE_E_OFF))[tr]; return true;
    }
    __device__ __forceinline__ const char* a_base() const { return (const char*)Fin; }
    __device__ __forceinline__ void a_offs(const pg8::Unit& u, const int (&R)[2], const int (&C)[2], unsigned (&o)[2][2]) const {
        const int p0 = (u.pm - (int)MISC[MW_TST + u.e]) * 256, cnt = (int)MISC[MW_CNT + u.e];
#pragma unroll
        for (int h = 0; h < 2; ++h)
#pragma unroll
            for (int i = 0; i < 2; ++i) { const int p = p0 + h * 128 + R[i]; o[h][i] = (unsigned)LIST[(size_t)u.e * LIST_CAP + (p < cnt ? p : 0)]; }
    }
    static constexpr int NBIAS = 256; static constexpr bool FP8 = true;
    __device__ __forceinline__ unsigned a_fix(unsigned tok, int Ci) const { return (tok * (unsigned)K + (unsigned)Ci) * 2u; }
    __device__ __forceinline__ const float* bias_src(const pg8::Unit& u, int lane) const { return b1l + (size_t)u.e * 2048 + u.pn * 128 + (lane < 32 ? lane * 4 : 1024 + (lane - 32) * 4); }
    __device__ __forceinline__ const char* b_base(const pg8::Unit& u) const { return (const char*)W1l + ((size_t)u.e * 2048 + (size_t)u.pn * 256) * K * 2; }
    __device__ __forceinline__ void epi(const f32x4 (&acc)[2][2][4][2], const pg8::Unit& u, int wr, int wc, int fr, int fq, const LAS float* bias) const {
        const int row0 = u.pm * 256 + wr * 64 + fr, colt = wc * 32 + 8 * fq;
        f32x4 bgv[2], blv[2];
#pragma unroll
        for (int n = 0; n < 2; ++n) { bgv[n] = *(const LAS f32x4*)(bias + colt + 4 * n); blv[n] = *(const LAS f32x4*)(bias + 128 + colt + 4 * n); }
#pragma unroll
        for (int ai = 0; ai < 2; ++ai)
#pragma unroll
            for (int m = 0; m < 4; ++m) {
                unsigned w[2];
#pragma unroll
                for (int n = 0; n < 2; ++n) { const f32x4 gl = acc[ai][0][m][n] * W8_INV + bgv[n], li = acc[ai][1][m][n] * W8_INV + blv[n];
                    f32x4 g, l, e;
#pragma unroll
                    for (int j = 0; j < 4; ++j) { g[j] = fminf(gl[j], 7.0f); l[j] = __builtin_amdgcn_fmed3f(li[j], -7.0f, 7.0f); }
                    const f32x4 z = g * (-1.702f * 1.4426950408889634f);
#pragma unroll
                    for (int j = 0; j < 4; ++j) e[j] = __builtin_amdgcn_exp2f(z[j]);
                    const f32x4 den = e + 1.0f; f32x4 r;
#pragma unroll
                    for (int j = 0; j < 4; ++j) r[j] = __builtin_amdgcn_rcpf(den[j]);
                    const f32x4 a = (g * r) * (l + 1.0f);
                    w[n] = (unsigned)attn_dv::cvt4_nc(a[0], a[1], a[2], a[3]); }
                *(GAS v2u*)((unsigned char*)ACT + (size_t)(row0 + ai * 128 + m * 16) * DFF + u.pn * 128 + colt) = (v2u){w[0], w[1]}; }
    }
};
struct Moe2Prob {
    static constexpr bool PERM = true;
    const bf16* ACT; const bf16* W2l; const float* b2l; bf16* Y; volatile LAS unsigned* MISC; int K, G, c;
    __device__ __forceinline__ bool next(int i, pg8::Unit& u) const {
        const int L = i * G + c, tt = (int)MISC[MW_TST + NEXP]; if (L >= tt * 4) return false;
        const int tr = L >> 2;
        u.pm = tr; u.pn = L & 3; u.e = (int)((const volatile LAS unsigned char*)((const volatile LAS unsigned char*)MISC - MISC_OFF + TILE_E_OFF))[tr]; return true;
    }
    __device__ __forceinline__ const char* a_base() const { return (const char*)ACT; }
    __device__ __forceinline__ void a_offs(const pg8::Unit& u, const int (&R)[2], const int (&C)[2], unsigned (&o)[2][2]) const {
#pragma unroll
        for (int h = 0; h < 2; ++h)
#pragma unroll
            for (int i = 0; i < 2; ++i) o[h][i] = (unsigned)((u.pm * 256 + h * 128 + R[i]) * K + C[i]) * 2u;
    }
    __device__ __forceinline__ const char* b_base(const pg8::Unit& u) const { return (const char*)W2l + ((size_t)u.e * D + (size_t)u.pn * 256) * K * 2; }
    static constexpr int NBIAS = 256; static constexpr bool FP8 = true;
    __device__ __forceinline__ unsigned a_fix(unsigned x, int) const { return x; }
    __device__ __forceinline__ const float* bias_src(const pg8::Unit& u, int lane) const { return b2l + (size_t)u.e * D + u.pn * 256 + lane * 4; }
    __device__ __forceinline__ void epi(const f32x4 (&acc)[2][2][4][2], const pg8::Unit& u, int wr, int wc, int fr, int fq, const LAS float* bias) const {
        const int row0 = u.pm * 256 + wr * 64 + fr, col0 = u.pn * 256 + wc * 32 + 8 * fq;
        f32x4 bv[2][2];
#pragma unroll
        for (int bj = 0; bj < 2; ++bj)
#pragma unroll
            for (int n = 0; n < 2; ++n) bv[bj][n] = *(const LAS f32x4*)(bias + wc * 32 + 8 * fq + bj * 128 + 4 * n);
#pragma unroll
        for (int ai = 0; ai < 2; ++ai)
#pragma unroll
            for (int m = 0; m < 4; ++m) { bf16* rowp = Y + (size_t)(row0 + ai * 128 + m * 16) * D + col0;
#pragma unroll
                for (int bj = 0; bj < 2; ++bj) { const f32x4 v0 = acc[ai][bj][m][0] * W8_INV + bv[bj][0], v1 = acc[ai][bj][m][1] * W8_INV + bv[bj][1];
                    if (Y_FP8) { *(GAS v2u*)((unsigned char*)Y + (size_t)(row0 + ai * 128 + m * 16) * D + col0 + bj * 128) = (v2u){(unsigned)cvt4_fp8(v0[0], v0[1], v0[2], v0[3]), (unsigned)cvt4_fp8(v1[0], v1[1], v1[2], v1[3])}; continue; }
                    v4u w; w.x = cvt_pk_bf16(v0[0], v0[1]); w.y = cvt_pk_bf16(v0[2], v0[3]); w.z = cvt_pk_bf16(v1[0], v1[1]); w.w = cvt_pk_bf16(v1[2], v1[3]);
                    *(GAS v4u*)(rowp + bj * 128) = w; } }
    }
};

constexpr int PROV_OFF = MISC_OFF + 1024, PROV_CAP = 2048;
constexpr int LDS_TOTAL = PROV_OFF + PROV_CAP * 4;
__device__ __forceinline__ int tok_row(int layer, int i) { if (layer == 0) return i; const int b = i / SEQ; return b * RB + CTXL + (i - b * SEQ); }
__device__ __forceinline__ void tok_finish(Frame& F, int i, int i0, int r, const f32x2 (&pq)[16], float rbias, volatile LAS unsigned* prov, float* GATEp) {
    float p[32];
#pragma unroll
    for (int e = 0; e < 16; ++e) { p[2 * e] = pq[e].x; p[2 * e + 1] = pq[e].y; }
        float q16[16], q8[8], q4[4], q2[2], q1;
#pragma unroll
        for (int t = 0; t < 16; ++t) { const auto rr = __builtin_amdgcn_permlane32_swap(__float_as_uint(p[t]), __float_as_uint(p[16 + t]), false, false); q16[t] = __uint_as_float(rr[0]) + __uint_as_float(rr[1]); }
#pragma unroll
        for (int t = 0; t < 8; ++t) { const auto rr = __builtin_amdgcn_permlane16_swap(__float_as_uint(q16[t]), __float_as_uint(q16[8 + t]), false, false); q8[t] = __uint_as_float(rr[0]) + __uint_as_float(rr[1]); }
        { const bool up = (F.lane & 8) != 0;
#pragma unroll
          for (int t = 0; t < 4; ++t) { const float mine = up ? q8[4 + t] : q8[t], send = up ? q8[t] : q8[4 + t]; q4[t] = mine + __shfl_xor(send, 8); } }
        { const bool up = (F.lane & 4) != 0;
#pragma unroll
          for (int t = 0; t < 2; ++t) { const float mine = up ? q4[2 + t] : q4[t], send = up ? q4[t] : q4[2 + t]; q2[t] = mine + __shfl_xor(send, 4); } }
        { const bool up = (F.lane & 2) != 0; const float mine = up ? q2[1] : q2[0], send = up ? q2[0] : q2[1]; q1 = mine + __shfl_xor(send, 2); }
        q1 += __shfl_xor(q1, 1);
        const int myE = F.lane >> 1;
        float val = q1 + rbias;
        float tv[4]; int ti[4];
        { int rank = 0; const int vali = __float_as_int(val);
#pragma unroll
          for (int e = 0; e < 32; ++e) { const float ve = __int_as_float(__builtin_amdgcn_readlane(vali, 2 * e)); rank += ((ve > val) || (ve == val && e < myE)) ? 1 : 0; }
#pragma unroll
          for (int k = 0; k < 4; ++k) { const unsigned long long mk = __ballot(rank == k); const int ln = (int)__builtin_ctzll(mk); ti[k] = ln >> 1; tv[k] = __int_as_float(__builtin_amdgcn_readlane(vali, ln)); } }
        const float w1 = __expf(tv[1] - tv[0]), w2 = __expf(tv[2] - tv[0]), w3 = __expf(tv[3] - tv[0]); const float inv = 1.0f / (1.0f + w1 + w2 + w3);
        if (F.lane < 4) {
            const int ek = F.lane == 0 ? ti[0] : F.lane == 1 ? ti[1] : F.lane == 2 ? ti[2] : ti[3];
            const float gk = (F.lane == 0 ? 1.0f : F.lane == 1 ? w1 : F.lane == 2 ? w2 : w3) * inv;
            const unsigned ls = __hip_atomic_fetch_add((LAS unsigned*)(F.lds + MISC_OFF) + MW_LCNT + ek, 1u, __ATOMIC_RELAXED, __HIP_MEMORY_SCOPE_WORKGROUP);
            prov[(i - i0) * 4 + F.lane] = ((unsigned)ek << 16) | ls;
            GATEp[(size_t)r * 4 + F.lane] = gk;
        }
    }
__device__ __forceinline__ void p_token(Frame& F, int layer) {
    const int nrows = layer == 0 ? M : NB * SEQ, RPB = (nrows + F.G - 1) / F.G;
    const int i0 = blockIdx.x * RPB, i1 = (i0 + RPB < nrows) ? i0 + RPB : nrows;
    LAS float* WL = (LAS float*)F.lds;
    volatile LAS unsigned* prov = (volatile LAS unsigned*)(F.lds + PROV_OFF);
    __syncthreads();
    if (F.tid < 32) F.MISC[MW_LCNT + F.tid] = 0u;
    const float* rw = F.router_w() + (size_t)layer * D * NEXP;
#pragma unroll
    for (int p = 0; p < 2; ++p) { const int k = F.tid + 512 * p, rowL = ((k & 3) + 4 * (k >> 8)) * 64 + ((k >> 2) & 63);
#pragma unroll
        for (int q = 0; q < 8; ++q) *(LAS f32x4*)(WL + rowL * 36 + 4 * q) = *(const GAS f32x4*)(rw + (size_t)k * NEXP + 4 * q); }
    __syncthreads();
    const float* n2 = F.norm2_w() + layer * D;
    const float rbias = F.router_b()[layer * NEXP + (F.lane >> 1)];
    const float* MODl = F.MOD() + (size_t)layer * 5 * 6144; const bf16* Hp = F.H(); bf16* Ap = F.A(); float* GATEp = F.GATE();
    if (RPB * 4 <= PROV_CAP)
    for (int i = i0 + F.wave; i < i1; i += 2 * NWAVES) {
        const int iB = i + NWAVES; const bool hasB = iB < i1;
        const int rA = tok_row(layer, i), rB = tok_row(layer, hasB ? iB : i);
        const float* modA = MODl + (size_t)row_v(rA) * 6144; const float* modB = MODl + (size_t)row_v(rB) * 6144;
        f32x4 hA[4], hB[4]; const bf16* hpA = Hp + (size_t)rA * D + F.lane * 4; const bf16* hpB = Hp + (size_t)rB * D + F.lane * 4;
        float sA = 0.f, sB = 0.f;
#pragma unroll
        for (int j = 0; j < 4; ++j) { hA[j] = ld4bf(hpA + 256 * j); hB[j] = ld4bf(hpB + 256 * j); }
#pragma unroll
        for (int j = 0; j < 4; ++j) { sA += (hA[j].x * hA[j].x + hA[j].y * hA[j].y) + (hA[j].z * hA[j].z + hA[j].w * hA[j].w); sB += (hB[j].x * hB[j].x + hB[j].y * hB[j].y) + (hB[j].z * hB[j].z + hB[j].w * hB[j].w); }
        const float rsA = 1.0f / sqrtf(wave_sum(sA) * (1.0f / D) + EPS), rsB = 1.0f / sqrtf(wave_sum(sB) * (1.0f / D) + EPS);
        GAS unsigned* o8A = (GAS unsigned*)((unsigned char*)Ap + (size_t)rA * D) + F.lane;
        GAS unsigned* o8B = (GAS unsigned*)((unsigned char*)Ap + (size_t)rB * D) + F.lane;
        f32x2 pA[16], pB[16];
#pragma unroll
        for (int e = 0; e < 16; ++e) { pA[e] = (f32x2){0.f, 0.f}; pB[e] = (f32x2){0.f, 0.f}; }
#pragma unroll
        for (int j = 0; j < 4; ++j) {
            asm volatile("" ::: "memory");
            const f32x4 w = ((const GAS f32x4*)n2)[F.lane + 64 * j];
            const f32x4 aA = ((const GAS f32x4*)(modA + 4096))[F.lane + 64 * j], bA = ((const GAS f32x4*)(modA + 3072))[F.lane + 64 * j];
            const f32x4 aB = ((const GAS f32x4*)(modB + 4096))[F.lane + 64 * j], bB = ((const GAS f32x4*)(modB + 3072))[F.lane + 64 * j];
            const f32x4 yA = hA[j] * rsA * w * (1.0f + aA) + bA, yB = hB[j] * rsB * w * (1.0f + aB) + bB;
            o8A[64 * j] = (unsigned)cvt4_fp8(yA.x, yA.y, yA.z, yA.w);
            if (hasB) o8B[64 * j] = (unsigned)cvt4_fp8(yB.x, yB.y, yB.z, yB.w);
#pragma unroll
            for (int c = 0; c < 4; ++c) { const f32x2 fA = (f32x2){yA[c], yA[c]}, fB = (f32x2){yB[c], yB[c]}; const LAS float* wr_ = WL + ((c + 4 * j) * 64 + F.lane) * 36;
#pragma unroll
                for (int q = 0; q < 8; ++q) { const f32x4 w4 = *(const LAS f32x4*)(wr_ + 4 * q); const f32x2 wl = (f32x2){w4.x, w4.y}, wh = (f32x2){w4.z, w4.w};
                    pA[2 * q] += fA * wl; pA[2 * q + 1] += fA * wh; pB[2 * q] += fB * wl; pB[2 * q + 1] += fB * wh; }
                asm volatile("" : "+v"(pA[0]), "+v"(pA[1]), "+v"(pA[2]), "+v"(pA[3]), "+v"(pA[4]), "+v"(pA[5]), "+v"(pA[6]), "+v"(pA[7]), "+v"(pA[8]), "+v"(pA[9]), "+v"(pA[10]), "+v"(pA[11]), "+v"(pA[12]), "+v"(pA[13]), "+v"(pA[14]), "+v"(pA[15]) :: "memory");
                asm volatile("" : "+v"(pB[0]), "+v"(pB[1]), "+v"(pB[2]), "+v"(pB[3]), "+v"(pB[4]), "+v"(pB[5]), "+v"(pB[6]), "+v"(pB[7]), "+v"(pB[8]), "+v"(pB[9]), "+v"(pB[10]), "+v"(pB[11]), "+v"(pB[12]), "+v"(pB[13]), "+v"(pB[14]), "+v"(pB[15]) :: "memory");
                __builtin_amdgcn_sched_barrier(0); }
        }
#pragma unroll 1
        for (int rr = 0; rr < (hasB ? 2 : 1); ++rr) {
            f32x2 pq[16];
#pragma unroll
            for (int e = 0; e < 16; ++e) pq[e] = rr ? pB[e] : pA[e];
            tok_finish(F, rr ? iB : i, i0, rr ? rB : rA, pq, rbias, prov, GATEp);
        }
    }
    __syncthreads();
    int* POSp = F.POS(); int* LISTp = F.LIST();
    if (F.tid < 32) F.MISC[MW_BASE + F.tid] = __hip_atomic_fetch_add(F.ctl() + CW_CNT + (layer * 32 + F.tid) * 64, F.MISC[MW_LCNT + F.tid], RLX_AGENT);
    __syncthreads();
    if (RPB * 4 <= PROV_CAP)
    for (int idx = F.tid; idx < (i1 - i0) * 4; idx += 512) {
        const unsigned pv = prov[idx]; const int e = (int)(pv >> 16), slot = (int)(pv & 0xffffu) + (int)F.MISC[MW_BASE + e];
        const int r = tok_row(layer, i0 + (idx >> 2));
        POSp[(size_t)r * 4 + (idx & 3)] = (e << 16) | slot;
        LISTp[(size_t)e * LIST_CAP + slot] = r;
    }
    __syncthreads();
}
__device__ __forceinline__ void p_combine(Frame& F, int layer) {
    moe_tables(F, layer);
    const int gw = F.vcu * NWAVES + F.wave, NGW = F.G * NWAVES, nrows = layer == 0 ? M : NB * SEQ;
    const float* MODp = F.MOD(); bf16* Hp = F.H(); const int* POSp = F.POS(); const float* GATEp = F.GATE(); const bf16* Yp = F.Y(); bf16* Ap = F.A(); float* outp = F.out();
    const float* n1w = F.norm1_w() + D; const float* fnw = F.final_norm_w();
    const int lane = F.lane;
#define CB_PG(i_, P_, G_) do { const int r_ = tok_row(layer, (i_)); _Pragma("unroll") for (int k = 0; k < 4; ++k) { P_[k] = POSp[(size_t)r_ * 4 + k]; G_[k] = GATEp[(size_t)r_ * 4 + k]; } } while (0)
#define CB_ISSUE(i_, P_, Y_, H_) do { const int r_ = tok_row(layer, (i_)); const GAS v2u* hq_ = (const GAS v2u*)(Hp + (size_t)r_ * D) + lane; \
        _Pragma("unroll") for (int j = 0; j < 4; ++j) H_[j] = hq_[64 * j]; \
        _Pragma("unroll") for (int k = 0; k < 4; ++k) { const int e_ = P_[k] >> 16, slot_ = P_[k] & 0xffff; const size_t prow_ = (size_t)F.MISC[MW_TST + e_] * 256 + slot_; \
            const GAS int* y8_ = (const GAS int*)((const unsigned char*)Yp + prow_ * D) + lane; \
            _Pragma("unroll") for (int j = 0; j < 4; ++j) Y_[k * 4 + j] = y8_[64 * j]; } } while (0)
#define CB_FINISH(i_, G_, Y_, H_) do { const int r_ = tok_row(layer, (i_)), v_ = row_v(r_); const float* mod_ = MODp + ((size_t)layer * 5 + v_) * 6144; \
        f32x4 h[4], acc[4]; \
        _Pragma("unroll") for (int j = 0; j < 4; ++j) { h[j] = (f32x4){bf2f(H_[j].x & 0xffffu), bf2f(H_[j].x >> 16), bf2f(H_[j].y & 0xffffu), bf2f(H_[j].y >> 16)}; acc[j] = (f32x4){0.f, 0.f, 0.f, 0.f}; } \
        _Pragma("unroll") for (int k = 0; k < 4; ++k) { const float g_ = G_[k]; \
            _Pragma("unroll") for (int j = 0; j < 4; ++j) { const int w_ = Y_[k * 4 + j]; acc[j].x += g_ * __builtin_amdgcn_cvt_f32_fp8(w_, 0); acc[j].y += g_ * __builtin_amdgcn_cvt_f32_fp8(w_, 1); \
                acc[j].z += g_ * __builtin_amdgcn_cvt_f32_fp8(w_, 2); acc[j].w += g_ * __builtin_amdgcn_cvt_f32_fp8(w_, 3); } } \
        _Pragma("unroll") for (int j = 0; j < 4; ++j) { const f32x4 g2 = ((const GAS f32x4*)(mod_ + 5120))[lane + 64 * j]; h[j] = h[j] + g2 * acc[j]; } \
        if (layer == 0) { bf16* hp_ = Hp + (size_t)r_ * D + lane * 4; \
            _Pragma("unroll") for (int j = 0; j < 4; ++j) st4bf(hp_ + 256 * j, h[j]); \
            const float* mod1 = MODp + ((size_t)5 + v_) * 6144; \
            norm_mod_row(h, n1w, mod1 + 1024, mod1, (bf16*)((unsigned char*)Ap + (size_t)r_ * D * (QKV1_FP8 ? 1 : 2)), lane, QKV1_FP8 != 0); \
        } else { float s_ = 0.f; \
            _Pragma("unroll") for (int j = 0; j < 4; ++j) s_ += (h[j].x * h[j].x + h[j].y * h[j].y) + (h[j].z * h[j].z + h[j].w * h[j].w); \
            const float rs_ = 1.0f / sqrtf(wave_sum(s_) * (1.0f / D) + EPS); \
            GAS f32x4* op_ = (GAS f32x4*)(outp + (size_t)(i_) * D) + lane; \
            _Pragma("unroll") for (int j = 0; j < 4; ++j) op_[64 * j] = h[j] * rs_ * ((const GAS f32x4*)fnw)[lane + 64 * j]; } } while (0)
    static_assert(Y_FP8, "the pipelined combine reads fp8 expert rows");
    int pA[4], pB[4]; float gA[4], gB[4], gC[4]; int yA[16], yB[16]; v2u hA[4], hB[4];
    int i = gw;
    if (i < nrows) { CB_PG(i, pA, gA); CB_ISSUE(i, pA, yA, hA); }
    if (i + NGW < nrows) CB_PG(i + NGW, pB, gB);
    for (; i < nrows; i += 2 * NGW) {
        const bool hasB = i + NGW < nrows, hasA2 = i + 2 * NGW < nrows, hasB2 = i + 3 * NGW < nrows;
        if (hasB) CB_ISSUE(i + NGW, pB, yB, hB);
        _Pragma("unroll") for (int k = 0; k < 4; ++k) gC[k] = gA[k];
        if (hasA2) CB_PG(i + 2 * NGW, pA, gA);
        CB_FINISH(i, gC, yA, hA);
        if (!hasB) break;
        if (hasA2) CB_ISSUE(i + 2 * NGW, pA, yA, hA);
        _Pragma("unroll") for (int k = 0; k < 4; ++k) gC[k] = gB[k];
        if (hasB2) CB_PG(i + 3 * NGW, pB, gB);
        CB_FINISH(i + NGW, gC, yB, hB);
    }
#undef CB_PG
#undef CB_ISSUE
#undef CB_FINISH
}

constexpr int N_PHASES = 21;
__global__ void __launch_bounds__(NWAVES * 64, 2) fwd(Args args) {
    extern __shared__ __attribute__((aligned(16))) unsigned char lds[];
    Frame F;
    F.lds = (LAS unsigned char*)lds;
    F.MISC = (volatile LAS unsigned*)(F.lds + MISC_OFF);
    F.tid = threadIdx.x; F.lane = F.tid & 63; F.wave = __builtin_amdgcn_readfirstlane(F.tid >> 6);
    F.G = gridDim.x; { const int bx = blockIdx.x; F.vcu = (F.G % 8 == 0) ? (bx % 8) * (F.G / 8) + bx / 8 : bx; }
    for (int u = F.tid; u < 256; u += NWAVES * 64) ((LAS unsigned*)(F.lds + MISC_OFF))[u] = 0u;
    __syncthreads();
    const int lo = args.ph_lo, hi = args.ph_hi;
    const bool one = (hi - lo) > 1;
    if (one) (void)xcd_barrier_post((unsigned*)(F.ctl() + CW_BAR), F.MISC + 8);
#define bar (XcdBarrier{(unsigned*)(F.ctl() + CW_BAR), xb_xcc_id(), F.MISC + 8, F.wave})
#ifndef PROBE_DUP
#define PROBE_DUP -1
#endif
#define IN(k) (phase_ids(F), (lo <= (k) && (k) < hi))
#define SEAM(k) do { if (IN(k) && IN((k) + 1)) xcd_barrier(bar); } while (0)

#define PH0_BODY p0_prologue(F);
    if (IN(0)) { PH0_BODY } if (PROBE_DUP == 0 && IN(0)) { PH0_BODY } SEAM(0);
    if (IN(1)) { p1_mod_reduce(F); } SEAM(1);
    if (IN(2)) { p_norm1(F, 0); } SEAM(2);
#define PH3_BODY    \
        DenseProb<EpiStoreBf16> P{F.A(), F.WIN(), D, MT, N_IN0 / 256, F.G, (int)blockIdx.x, false, EpiStoreBf16{F.QKV(), N_IN0, 1024, 1.0f, (ATTN_QK8 && ATTN_FP8PV && ATTN_FASTEXP) ? F.QK8() : nullptr, nullptr}}; \
        pg8::gemm_phase(F.lds, P, F.wave);
    if (IN(3)) { PH3_BODY } if (PROBE_DUP == 3 && IN(3)) { PH3_BODY } if (IN(3) && IN(5)) xcd_barrier(bar);
#if ATTN_FASTEXP && ATTN_QK8
#define ATTN_CALL attn_dv::attn8<4, 1024, 512, false>(F.QK8() + ((size_t)b * RB + qb * 256) * 1024 + (2 * h + cc) * 64, F.QK8() + (size_t)b * RB * 1024 + 512 + (2 * h + cc) * 64, F.VT8() + (size_t)((b * 4 + h) * 128) * RB, \
                F.OD() + (size_t)cc * M * 512 + ((size_t)b * RB + qb * 256) * 512 + h * 128, (qb == 0 ? CTXL : RB) / 64, 0, 0, 0.f, (char*)lds, F.wave);
#define ATTN_BODY8 attn_dense_body8x
#elif ATTN_FASTEXP
#define ATTN_BODY8 attn_dense_body8x
#else
#define ATTN_BODY8 attn_dense_body8
#endif
#if ATTN_FP8PV && ATTN_FASTEXP && ATTN_QK8
#elif ATTN_FP8PV
#define ATTN_CALL attn_dv::ATTN_BODY8<N_IN0, 512>(base + (size_t)qb * 256 * N_IN0 + C_DQ + (2 * h + cc) * 64, base + C_DK + (2 * h + cc) * 64, F.VT8() + (size_t)((b * 4 + h) * 128) * RB, \
                F.OD() + (size_t)cc * M * 512 + ((size_t)b * RB + qb * 256) * 512 + h * 128, qb == 0 ? CTXL : RB, (char*)lds, F.wave);
#else
#define ATTN_CALL attn_dv::attn_dense_body<N_IN0, 512>(base + (size_t)qb * 256 * N_IN0 + C_DQ + (2 * h + cc) * 64, base + C_DK + (2 * h + cc) * 64, base + C_DV + h * 128, \
                F.OD() + (size_t)cc * M * 512 + ((size_t)b * RB + qb * 256) * 512 + h * 128, qb == 0 ? CTXL : RB, (char*)lds, F.wave);
#endif
    if (ATTN_FP8PV && IN(4)) { p_vt8<4, 128, N_IN0, C_DV>(F, F.VT8()); __syncthreads();
        if (RET_V2) { p_tr16<4, 128, C_RV>(F, F.RVT()); p_tr16<4, 64, C_RK>(F, F.RKT()); } else for (int it = blockIdx.x; it < NB * 4 * NCH; it += F.G) ret_kv_item(F, it); }
    if (ATTN_FP8PV && IN(4) && IN(5)) xcd_barrier(bar);
#define PH5_BODY    \
        for (int u = F.vcu; u < 5 * 256; u += F.G) {      \
            const int combo = (u & 255) >> 3, sub = (u & 7) + 8 * (u >> 8); \
            if (sub > 32) continue; \
            const int b = combo >> 3, h = (combo >> 1) & 3, cc = combo & 1; \
            const int qb = sub < 32 ? sub + 1 : 0;                                   \
            const bf16* base = F.QKV() + (size_t)b * RB * N_IN0; \
            ATTN_CALL \
        } \
        __syncthreads(); \
        if (!ATTN_FP8PV) for (int it = blockIdx.x; it < NB * 4 * NCH; it += F.G) ret_kv_item(F, it); \
        if (ATTN_FP8PV && RET_V2) for (int it = blockIdx.x; it < NB * 4 * NCH; it += F.G) ret_kv_item2(F, it);
    if (IN(5)) { PH5_BODY } if (PROBE_DUP == 5 && IN(5)) { PH5_BODY } SEAM(5);
#define PH6_BODY p_ret_scan(F);
    if (IN(6)) { PH6_BODY } if (PROBE_DUP == 6 && IN(6)) { PH6_BODY } SEAM(6);
#define PH7_BODY for (int it = blockIdx.x; it < NB * 4 * NCH; it += F.G) { if (RET_V2) ret_out_item2(F, it); else ret_out_item(F, it); } p_dfinish(F);
    if (IN(7)) { PH7_BODY } if (PROBE_DUP == 7 && IN(7)) { PH7_BODY } SEAM(7);
    if (IN(8)) {
        DenseProb<EpiResid> P{F.CAT(), F.WOUT0(), D, MT, D / 256, F.G, (int)blockIdx.x, false, EpiResid{F.H(), F.MOD(), 2048, F.x(), F.ctx()}};
        pg8::gemm_phase(F.lds, P, F.wave);
    } SEAM(8);
    if (IN(9)) { p_token(F, 0); } SEAM(9);
#define PH10_BODY moe_tables(F, 0); Moe1Prob P{F.A(), F.W1T(), F.moe_b1(), F.LIST(), F.ACT(), F.MISC, D / 2, F.G, F.vcu}; pg8::gemm_phase(F.lds, P, F.wave);
    if (IN(10)) { PH10_BODY } if (PROBE_DUP == 10 && IN(10)) { PH10_BODY } SEAM(10);
#define PH11_BODY moe_tables(F, 0); Moe2Prob P{F.ACT(), F.W2T(), F.moe_b2(), F.Y(), F.MISC, DFF / 2, F.G, F.vcu}; pg8::gemm_phase(F.lds, P, F.wave);
    if (IN(11)) { PH11_BODY } if (PROBE_DUP == 11 && IN(11)) { PH11_BODY } SEAM(11);
    if (IN(12)) { p_combine(F, 0); } SEAM(12);
#define PH13_BODY   \
        DenseProb<EpiStoreBf16, QKV1_FP8 != 0> P{F.A(), F.WQKV1(), QKV1_FP8 ? D / 2 : D, MT, N_QKV1 / 256, F.G, (int)blockIdx.x, false, EpiStoreBf16{F.QKV(), N_QKV1, 1152, QKV1_FP8 ? W8_INV : 1.0f, SWA_FP8 ? F.QK8() : nullptr, SWA_FP8 ? F.K81() : nullptr}}; \
        pg8::gemm_phase(F.lds, P, F.wave);
    if (IN(13)) { PH13_BODY } if (PROBE_DUP == 13 && IN(13)) { PH13_BODY } if (IN(13) && IN(15)) xcd_barrier(bar);
    if (SWA_FP8 && IN(14)) { p_vt8<2, 64, N_QKV1, C_V1>(F, F.VT81()); }
    if (SWA_FP8 && IN(14) && IN(15)) xcd_barrier(bar);
#define PH15_BODY   \
        for (int u = F.vcu; u < 8 * 256; u += F.G) { \
            const int combo = (u & 255) >> 2, sub = (u & 3) + 4 * (u >> 8); \
            const int b = combo >> 4, hq = combo & 15, kv = hq >> 3, qb = sub + 1; \
            int bs = 4 * qb - 2; if (bs < 4) bs = 4; int be = 4 * qb + 6; if (be > RB / 64) be = RB / 64; \
            const bf16* base = F.QKV() + (size_t)b * RB * N_QKV1; \
            if (SWA_FP8) attn_dv::attn8<2, 128, D, true>(F.QK8() + ((size_t)b * RB + qb * 256) * 1024 + hq * 64, F.K81() + (size_t)b * RB * 128 + kv * 64, F.VT81() + (size_t)((b * 2 + kv) * 64) * RB, \
                F.OD() + ((size_t)b * RB + qb * 256) * D + hq * 64, 4 + (be - bs), bs - 4, qb * 256, F.sinks()[hq] * LOG2E, (char*)lds, F.wave); \
            else attn_body::attn_unit<N_QKV1, D, true, 8>(base + (size_t)qb * 256 * N_QKV1 + C_Q1 + hq * 64, base + C_K1 + kv * 64, base + C_V1 + kv * 64, \
                F.OD() + ((size_t)b * RB + qb * 256) * D + hq * 64, 4 + (be - bs), bs - 4, qb * 256, F.sinks()[hq] * LOG2E, (char*)lds, F.wave); \
        } \
        __syncthreads();
    if (IN(15)) { PH15_BODY } if (PROBE_DUP == 15 && IN(15)) { PH15_BODY } SEAM(15);
    if (IN(16)) {
        DenseProb<EpiResid> P{F.OD(), F.WOUT1(), D, NB * 32, D / 256, F.G, (int)blockIdx.x, true, EpiResid{F.H(), F.MOD() + 5 * 6144, 2048, nullptr, nullptr}};
        pg8::gemm_phase(F.lds, P, F.wave);
    } SEAM(16);
    if (IN(17)) { p_token(F, 1); } SEAM(17);
#define PH18_BODY moe_tables(F, 1); Moe1Prob P{F.A(), F.W1T() + (size_t)NEXP * 2048 * D / 2, F.moe_b1() + NEXP * 2048, F.LIST(), F.ACT(), F.MISC, D / 2, F.G, F.vcu}; pg8::gemm_phase(F.lds, P, F.wave);
    if (IN(18)) { PH18_BODY } if (PROBE_DUP == 18 && IN(18)) { PH18_BODY } SEAM(18);
#define PH19_BODY moe_tables(F, 1); Moe2Prob P{F.ACT(), F.W2T() + (size_t)NEXP * D * DFF / 2, F.moe_b2() + NEXP * D, F.Y(), F.MISC, DFF / 2, F.G, F.vcu}; pg8::gemm_phase(F.lds, P, F.wave);
    if (IN(19)) { PH19_BODY } if (PROBE_DUP == 19 && IN(19)) { PH19_BODY } SEAM(19);
#define PH20_BODY p_combine(F, 1);
    if (IN(20)) { PH20_BODY } if (PROBE_DUP == 20 && IN(20)) { PH20_BODY }
#undef IN
#undef SEAM
}

extern "C" void kernel_launch(void* const* d_in, const int* in_sizes, int n_in, void* d_out, int out_size, void* d_ws, size_t ws_size, hipStream_t stream) {
    static int grid = 0;
    if (grid == 0) {
        if (n_in != 24 || in_sizes[0] != NB * SEQ * D || out_size != NB * SEQ * D || ws_size < WS_END) {
            fprintf(stderr, "kernel_launch: unexpected shapes (n_in %d, in0 %d, out %d, ws %zu, need %zu); nothing launched\n", n_in, n_in > 0 ? in_sizes[0] : -1, out_size, ws_size, (size_t)WS_END); grid = -1; return; }
        int dev = 0, cus = 0, per_cu = 0;
        if (hipGetDevice(&dev) != hipSuccess || hipDeviceGetAttribute(&cus, hipDeviceAttributeMultiprocessorCount, dev) != hipSuccess) { grid = -1; return; }
        if (hipFuncSetAttribute((const void*)fwd, hipFuncAttributeMaxDynamicSharedMemorySize, LDS_TOTAL) != hipSuccess) { fprintf(stderr, "kernel_launch: hipFuncSetAttribute failed\n"); grid = -1; return; }
        if (hipOccupancyMaxActiveBlocksPerMultiprocessor(&per_cu, (const void*)fwd, NWAVES * 64, LDS_TOTAL) != hipSuccess || per_cu < 1)
            fprintf(stderr, "kernel_launch: note: occupancy query reports %d workgroups per CU\n", per_cu);
        (void)hipGetLastError();
        grid = cus;
    }
    if (grid < 0) return;
    if (hipMemsetAsync((char*)d_ws + WS_CTL, 0, CTL_ZERO_BYTES, stream) != hipSuccess) return;
    Args a{};
    for (int i = 0; i < 24; ++i) a.in[i] = (const float*)d_in[i];
    a.out = (float*)d_out; a.ws = (unsigned char*)d_ws;
#if MK_ONE_LAUNCH
    a.ph_lo = 0; a.ph_hi = N_PHASES;
    hipLaunchKernelGGL(fwd, dim3(grid), dim3(NWAVES * 64), LDS_TOTAL, stream, a);
#else
    for (int p = 0; p < N_PHASES; ++p) { a.ph_lo = p; a.ph_hi = p + 1; hipLaunchKernelGGL(fwd, dim3(grid), dim3(NWAVES * 64), LDS_TOTAL, stream, a); }
#endif
}
```

```cpp
#include <hip/hip_runtime.h>
#include <hip/hip_bf16.h>
#include <cstdio>
#include <cstdint>

#ifndef OUT_FP8
#define OUT_FP8 1
#endif
#define OUT_ASC 8.0f
#ifndef ATTN_FP8PV
#define ATTN_FP8PV 1
#endif
#ifndef QKV1_FP8
#define QKV1_FP8 1
#endif
#ifndef RET_V2
#define RET_V2 1
#endif
#ifndef SWA_FP8
#define SWA_FP8 1
#endif
#ifndef ATTN_QK8
#define ATTN_QK8 1
#endif
#ifndef Y_FP8
#define Y_FP8 1
#endif
#ifndef ATTN_FASTEXP
#define ATTN_FASTEXP 1
#endif
#ifndef MK_ONE_LAUNCH
#define MK_ONE_LAUNCH 1
#endif

#define GAS __attribute__((address_space(1)))
#define LAS __attribute__((address_space(3)))
typedef unsigned short bf16;
typedef unsigned v4u __attribute__((ext_vector_type(4)));
typedef unsigned v2u __attribute__((ext_vector_type(2)));
typedef float f32x4 __attribute__((ext_vector_type(4)));
typedef float f32x2 __attribute__((ext_vector_type(2)));
typedef float f32x16 __attribute__((ext_vector_type(16)));
typedef short bf16x8 __attribute__((ext_vector_type(8)));
typedef short s16x4 __attribute__((ext_vector_type(4)));
typedef int v8i __attribute__((ext_vector_type(8)));
typedef int v4i __attribute__((ext_vector_type(4)));
typedef GAS unsigned gu32;
#define RLX_AGENT __ATOMIC_RELAXED, __HIP_MEMORY_SCOPE_AGENT
#define LDS_WAIT() asm volatile("s_waitcnt lgkmcnt(0)" ::: "memory")
#define VM_WAIT() asm volatile("s_waitcnt vmcnt(0)" ::: "memory")

constexpr int NB = 4, SEQ = 8192, CTXL = 256, D = 1024;
constexpr int RB = SEQ + CTXL;
constexpr int M = NB * RB;
constexpr int TPB = RB / 256;
constexpr int MT = M / 256;
constexpr int NEXP = 32, DFF = 1024;
constexpr int N_IN0 = 3072, N_QKV1 = 1280;
constexpr int NCH = RB / 128;
constexpr float EPS = 1e-6f;
constexpr float LOG2E = 1.4426950408889634f;
constexpr float C2 = 0.125f * LOG2E;
constexpr int C_DQ = 0, C_DK = 512, C_DV = 1024, C_RQ = 1536, C_RK = 1792, C_RV = 2048, C_RG = 2560;
constexpr int C_Q1 = 0, C_K1 = 1024, C_V1 = 1152;
constexpr int MOE_CAP_ROWS = 143360;
constexpr int LIST_CAP = M;

constexpr size_t MiB = 1u << 20;
constexpr size_t WS_CTL = 0, CTL_ZERO_BYTES = 1 * MiB;
constexpr size_t WS_MODP = 1 * MiB;
constexpr size_t WS_MOD = 5 * MiB;
constexpr size_t WS_LIST = 6 * MiB;
constexpr size_t WS_POS = 11 * MiB;
constexpr size_t WS_GATE = 12 * MiB;
constexpr size_t WS_WIN = 13 * MiB;
constexpr size_t WS_WOUT0 = 19 * MiB;
constexpr size_t WS_WQKV1 = 21 * MiB;
constexpr size_t WS_WOUT1 = 24 * MiB;
constexpr size_t WS_H = 26 * MiB;
constexpr size_t WS_A = 158 * MiB;
constexpr size_t WS_QKV = 224 * MiB;
constexpr size_t WS_OD = 422 * MiB;
constexpr size_t WS_CAT = 488 * MiB;
constexpr size_t WS_CKV = 554 * MiB;
constexpr size_t WS_PREV = 620 * MiB;
constexpr size_t WS_ACT = 653 * MiB;
constexpr size_t WS_QK8 = 820 * MiB;
constexpr size_t WS_RVT = 880 * MiB;
constexpr size_t WS_RKT = 914 * MiB;
constexpr size_t WS_K81 = 860 * MiB;
constexpr size_t WS_VT81 = 870 * MiB;
constexpr size_t WS_VT8 = 800 * MiB;
constexpr size_t WS_Y = 933 * MiB;
constexpr size_t WS_W1T = 1213 * MiB;
constexpr size_t WS_W2T = 1469 * MiB;
constexpr size_t WS_END = 1597 * MiB;
static_assert(WS_H + (size_t)M * D * 4 <= WS_A && WS_A + (size_t)M * D * 2 <= WS_QKV && WS_QKV + (size_t)M * 3072 * 2 <= WS_OD, "ws map");
static_assert(WS_ACT + (size_t)MOE_CAP_ROWS * 1024 * 2 <= WS_Y && WS_Y + (size_t)MOE_CAP_ROWS * 1024 * 2 <= WS_W1T, "ws map 2");
constexpr int CW_TMO = 0;
constexpr int CW_MODC = 6144;
constexpr int CW_CNT = 1024;
constexpr int CW_BAR = 8192;

constexpr int RING_BYTES = 131072;
constexpr int ROUTER_LDS = 1024 * 36 * 4;
constexpr int MISC_OFF = ROUTER_LDS;
constexpr int LDS_BYTES = MISC_OFF + 1024;
constexpr int MW_TST = 16, MW_CNT = 64, MW_LCNT = 96, MW_BASE = 128;
constexpr int TILE_E_OFF = 131072 + 4096;

__device__ __forceinline__ int lane_id() { const int l = (int)__builtin_amdgcn_mbcnt_hi(~0u, __builtin_amdgcn_mbcnt_lo(~0u, 0u)); __builtin_assume(l >= 0 && l < 64); return l; }
__device__ __forceinline__ unsigned f2bf(float f) { unsigned u = __builtin_bit_cast(unsigned, f); return (u + 0x7fffu + ((u >> 16) & 1u)) >> 16; }
__device__ __forceinline__ float bf2f(unsigned b) { return __builtin_bit_cast(float, b << 16); }
__device__ __forceinline__ unsigned pk2(float lo, float hi) { return f2bf(lo) | (f2bf(hi) << 16); }
__device__ __forceinline__ unsigned cvt_pk_bf16(float lo, float hi) { unsigned r; asm volatile("v_cvt_pk_bf16_f32 %0, %1, %2" : "=v"(r) : "v"(lo), "v"(hi)); return r; }
__device__ __forceinline__ f32x4 ld4bf(const bf16* p) { const v2u u = *(const GAS v2u*)p; return (f32x4){bf2f(u.x & 0xffffu), bf2f(u.x >> 16), bf2f(u.y & 0xffffu), bf2f(u.y >> 16)}; }
__device__ __forceinline__ void st4bf(bf16* p, f32x4 v) { v2u u; u.x = pk2(v.x, v.y); u.y = pk2(v.z, v.w); *(GAS v2u*)p = u; }
template <int X> __device__ __forceinline__ float dpp_xor(float x) {
    const int v = __float_as_int(x);
    if (X == 1) return __int_as_float(__builtin_amdgcn_update_dpp(v, v, 0xB1, 0xF, 0xF, false));
    if (X == 2) return __int_as_float(__builtin_amdgcn_update_dpp(v, v, 0x4E, 0xF, 0xF, false));
    if (X == 8) return __int_as_float(__builtin_amdgcn_update_dpp(v, v, 0x128, 0xF, 0xF, false));
    const int m = __builtin_amdgcn_update_dpp(v, v, 0x141, 0xF, 0xF, false);
    return __int_as_float(__builtin_amdgcn_update_dpp(m, m, 0x1B, 0xF, 0xF, false));
}
__device__ __forceinline__ float wave_sum(float v) {
    v += dpp_xor<1>(v); v += dpp_xor<2>(v); v += dpp_xor<4>(v); v += dpp_xor<8>(v);
    { const auto rr = __builtin_amdgcn_permlane16_swap(__float_as_uint(v), __float_as_uint(v), false, false); v = __uint_as_float(rr[0]) + __uint_as_float(rr[1]); }
    { const auto rr = __builtin_amdgcn_permlane32_swap(__float_as_uint(v), __float_as_uint(v), false, false); v = __uint_as_float(rr[0]) + __uint_as_float(rr[1]); }
    return v;
}
__device__ __forceinline__ int cvt4_fp8(float a, float b, float c, float d) {
    int w = 0;
    w = __builtin_amdgcn_cvt_pk_fp8_f32(__builtin_amdgcn_fmed3f(a, -448.f, 448.f), __builtin_amdgcn_fmed3f(b, -448.f, 448.f), w, false);
    w = __builtin_amdgcn_cvt_pk_fp8_f32(__builtin_amdgcn_fmed3f(c, -448.f, 448.f), __builtin_amdgcn_fmed3f(d, -448.f, 448.f), w, true);
    return w;
}
constexpr float W8_SCALE = 256.0f, W8_INV = 1.0f / 256.0f;
__device__ __forceinline__ float fast_exp2(float x) { return __builtin_amdgcn_exp2f(x); }
__device__ __forceinline__ float sigmoidf_(float x) { return __builtin_amdgcn_rcpf(1.0f + __builtin_amdgcn_exp2f(-1.4426950408889634f * x)); }

namespace pg8 {
constexpr int BM = 256, BK = 64, HALF = 128, HTB = HALF * BK * 2, STAGE_BYTES = 8 * HTB, NXCD = 8, WGM = 8, BIAS_LDS_OFF = STAGE_BYTES;
__host__ __device__ __forceinline__ int lds_byte(int r, int c) { const int st = (r >> 4) * 2 + (c >> 5), rr = r & 15, cc = c & 31, ob = rr * 64 + cc * 2; return st * 1024 + (ob ^ (((ob >> 9) & 1) << 5)); }
__host__ __device__ __forceinline__ void stage_rc(int b, int& R, int& C) { const int st = b / 1024, sb = b % 1024, swz = sb ^ (((sb >> 9) & 1) << 5); R = (st >> 1) * 16 + swz / 64; C = (st & 1) * 32 + (swz % 64) / 2; }
__host__ __device__ __forceinline__ int perm32(int rho) { const int n = rho >> 4, i = rho & 15; return 8 * (i >> 2) + 4 * n + (i & 3); }
struct Unit { int pm, pn, e; };

template <class P>
__device__ __forceinline__ void gemm_phase(LAS unsigned char* lds, const P& S, const int wid) {
    __builtin_assume(wid >= 0 && wid < 8);
    const int lane = lane_id(), tid = wid * 64 + lane, wr = wid >> 2, wc = wid & 3, fr = lane & 15, fq = lane >> 4;
    const int K = S.K, nt = K / BK;
    int R[2], C[2]; unsigned voffB[2];
#pragma unroll
    for (int i = 0; i < 2; ++i) { stage_rc(tid * 16 + i * 8192, R[i], C[i]); const int Rb = P::PERM ? ((R[i] & ~31) + perm32(R[i] & 31)) : R[i]; voffB[i] = (unsigned)(Rb * K + C[i]) * 2u; }
    const size_t kstep = (size_t)(BK * 2);
    const size_t hstep = (size_t)HALF * K * 2;
    const unsigned ldsw = (unsigned)wid * 1024u;
    const int aoff = lds_byte(wr * 64 + fr, fq * 8), boff = lds_byte(wc * 32 + fr, fq * 8);
#define PG8_SA(b, h) (((b) * 2 + (h)) * HTB)
#define PG8_SB(b, h) ((4 + (b) * 2 + (h)) * HTB)
#define PG8_STAGE(bufoff, gbase, voff) do { _Pragma("unroll") for (int _i = 0; _i < 2; ++_i) \
        __builtin_amdgcn_global_load_lds((const unsigned*)((const char*)(gbase) + (voff)[_i]), (LAS unsigned*)(lds + (bufoff) + ldsw + _i * 8192), 16, 0, 0); } while (0)
#define PG8_LD8(p) ({ const v4i lo_ = *(const LAS v4i*)(p), hi_ = *(const LAS v4i*)((p) + 1024); (v8i){lo_[0], lo_[1], lo_[2], lo_[3], hi_[0], hi_[1], hi_[2], hi_[3]}; })
#define PG8_LDA(dst, b, h) do { if constexpr (P::FP8) { _Pragma("unroll") for (int m = 0; m < 4; ++m) dst##8[m] = PG8_LD8(lds + PG8_SA(b, h) + aoff + m * 2048); } \
        else { _Pragma("unroll") for (int m = 0; m < 4; ++m) _Pragma("unroll") for (int k = 0; k < 2; ++k) dst[m][k] = *(const LAS bf16x8*)(lds + PG8_SA(b, h) + aoff + m * 2048 + k * 1024); } } while (0)
#define PG8_LDB(dst, b, h) do { if constexpr (P::FP8) { _Pragma("unroll") for (int n = 0; n < 2; ++n) dst##8[n] = PG8_LD8(lds + PG8_SB(b, h) + boff + n * 2048); } \
        else { _Pragma("unroll") for (int n = 0; n < 2; ++n) _Pragma("unroll") for (int k = 0; k < 2; ++k) dst[n][k] = *(const LAS bf16x8*)(lds + PG8_SB(b, h) + boff + n * 2048 + k * 1024); } } while (0)
#define PG8_MMA(ai, bj, At, Bt) do { __builtin_amdgcn_s_setprio(1); \
        if constexpr (P::FP8) { _Pragma("unroll") for (int m = 0; m < 4; ++m) _Pragma("unroll") for (int n = 0; n < 2; ++n) \
            asm volatile("v_mfma_f32_16x16x128_f8f6f4 %0, %1, %2, %0" : "+v"(acc[ai][bj][m][n]) : "v"(Bt##8[n]), "v"(At##8[m]), "v"(scale1)); } \
        else { _Pragma("unroll") for (int m = 0; m < 4; ++m) _Pragma("unroll") for (int n = 0; n < 2; ++n) _Pragma("unroll") for (int k = 0; k < 2; ++k) \
            acc[ai][bj][m][n] = __builtin_amdgcn_mfma_f32_16x16x32_bf16(Bt[n][k], At[m][k], acc[ai][bj][m][n], 0, 0, 0); } \
        __builtin_amdgcn_s_setprio(0); } while (0)
#define PG8_WAIT_V(n) asm volatile("s_waitcnt vmcnt(" #n ")" ::: "memory")
#define PG8_WAIT_L(n) asm volatile("s_waitcnt lgkmcnt(" #n ")" ::: "memory")
#define PG8_BAR __builtin_amdgcn_s_barrier()
#define PG8_SCHED __builtin_amdgcn_sched_barrier(0)
    Unit cur, nxt; int ui = 0;
    if (!S.next(0, cur)) return;
    f32x4 acc[2][2][4][2];
#pragma unroll
    for (int a = 0; a < 2; ++a)
#pragma unroll
        for (int b = 0; b < 2; ++b)
#pragma unroll
            for (int m = 0; m < 4; ++m)
#pragma unroll
                for (int n = 0; n < 2; ++n) acc[a][b][m][n] = (f32x4){0.f, 0.f, 0.f, 0.f};
    const int scale1 = 0x7F7F7F7F;
    bf16x8 At[4][2], B0[2][2], B1[2][2]; v8i At8[4], B08[2], B18[2];
    unsigned aoc[2][2], aon[2][2];
    S.a_offs(cur, R, C, aoc);
#pragma unroll
    for (int h = 0; h < 2; ++h)
#pragma unroll
        for (int i = 0; i < 2; ++i) aoc[h][i] = S.a_fix(aoc[h][i], C[i]);
    const char* Ab = S.a_base();
    const char* cB = S.b_base(cur);
    if constexpr (P::NBIAS > 0) { if (wid == 0) __builtin_amdgcn_global_load_lds((const unsigned*)S.bias_src(cur, lane), (LAS unsigned*)(lds + BIAS_LDS_OFF), 16, 0, 0); }
    PG8_STAGE(PG8_SB(0, 0), cB, voffB); PG8_STAGE(PG8_SB(0, 1), cB + hstep, voffB); PG8_STAGE(PG8_SA(0, 0), Ab, aoc[0]); PG8_STAGE(PG8_SA(0, 1), Ab, aoc[1]);
    if (wr == 1) PG8_BAR;
    PG8_WAIT_V(2); PG8_BAR;
    PG8_STAGE(PG8_SB(1, 0), cB + kstep, voffB); PG8_STAGE(PG8_SA(1, 0), Ab + kstep, aoc[0]); PG8_STAGE(PG8_SB(1, 1), cB + hstep + kstep, voffB);
    PG8_WAIT_V(6); PG8_BAR;
    for (;;) {
        const bool has_next = S.next(ui + 1, nxt);
        if (has_next) S.a_offs(nxt, R, C, aon);
        else { aon[0][0] = aoc[0][0]; aon[0][1] = aoc[0][1]; aon[1][0] = aoc[1][0]; aon[1][1] = aoc[1][1]; }
        if constexpr (P::NBIAS > 0) { if (has_next && wid == 0) __builtin_amdgcn_global_load_lds((const unsigned*)S.bias_src(nxt, lane), (LAS unsigned*)(lds + BIAS_LDS_OFF + ((ui + 1) % 3) * 1024), 16, 0, 0); }
        const char* nB = has_next ? S.b_base(nxt) : cB;
#pragma unroll 1
        for (int t = 0; t < nt; t += 2) {
            const bool last = (t == nt - 2);
            const char* a1 = Ab + (size_t)(t + 1) * kstep;
            const char* a2 = last ? Ab : Ab + (size_t)(t + 2) * kstep; const char* b2 = last ? nB : cB + (size_t)(t + 2) * kstep;
            const char* a3 = a2 + kstep; const char* b3 = b2 + kstep;
            unsigned o2[2][2];
            o2[0][0] = aoc[0][0]; o2[0][1] = aoc[0][1]; o2[1][0] = aoc[1][0]; o2[1][1] = aoc[1][1];
            if (last && has_next) {
#pragma unroll
                for (int h = 0; h < 2; ++h)
#pragma unroll
                    for (int i = 0; i < 2; ++i) { unsigned x = aon[h][i]; asm volatile("" : "+v"(x)); aon[h][i] = S.a_fix(x, C[i]); o2[h][i] = aon[h][i]; }
            }
            PG8_LDB(B0, 0, 0); PG8_LDB(B1, 0, 1); PG8_SCHED; PG8_LDA(At, 0, 0); PG8_STAGE(PG8_SA(1, 1), a1, aoc[1]);
            PG8_WAIT_V(8); PG8_WAIT_L(0); PG8_BAR; PG8_MMA(0, 0, At, B0); PG8_MMA(0, 1, At, B1); PG8_BAR; PG8_SCHED;
            PG8_LDA(At, 0, 1); PG8_STAGE(PG8_SB(0, 0), b2, voffB); PG8_STAGE(PG8_SB(0, 1), b2 + hstep, voffB); PG8_STAGE(PG8_SA(0, 0), a2, o2[0]);
            PG8_WAIT_V(8); PG8_WAIT_L(0); PG8_BAR; PG8_MMA(1, 0, At, B0); PG8_MMA(1, 1, At, B1); PG8_BAR; PG8_SCHED;
            PG8_LDB(B0, 1, 0); PG8_LDB(B1, 1, 1); PG8_SCHED; PG8_LDA(At, 1, 0); PG8_STAGE(PG8_SA(0, 1), a2, o2[1]);
            PG8_WAIT_V(8); PG8_WAIT_L(0); PG8_BAR; PG8_MMA(0, 0, At, B0); PG8_MMA(0, 1, At, B1); PG8_BAR; PG8_SCHED;
            PG8_LDA(At, 1, 1); PG8_STAGE(PG8_SB(1, 0), b3, voffB); PG8_STAGE(PG8_SB(1, 1), b3 + hstep, voffB); PG8_STAGE(PG8_SA(1, 0), a3, o2[0]);
            PG8_WAIT_V(8); PG8_WAIT_L(0); PG8_BAR; PG8_MMA(1, 0, At, B0); PG8_MMA(1, 1, At, B1); PG8_BAR; PG8_SCHED;
        }
        if (wr == 0) PG8_BAR;
        if constexpr (P::FP8) asm volatile("s_nop 15\n\ts_nop 15" ::: "memory");
        S.epi(acc, cur, wr, wc, fr, fq, (const LAS float*)(lds + BIAS_LDS_OFF + (ui % 3) * 1024));
        if (!has_next) break;
#pragma unroll
        for (int a = 0; a < 2; ++a)
#pragma unroll
            for (int b = 0; b < 2; ++b)
#pragma unroll
                for (int m = 0; m < 4; ++m)
#pragma unroll
                    for (int n = 0; n < 2; ++n) acc[a][b][m][n] = (f32x4){0.f, 0.f, 0.f, 0.f};
        cur = nxt; cB = nB; ++ui;
        aoc[0][0] = aon[0][0]; aoc[0][1] = aon[0][1]; aoc[1][0] = aon[1][0]; aoc[1][1] = aon[1][1];
        if (wr == 1) PG8_BAR;
    }
    PG8_WAIT_V(0);
    PG8_BAR;
#undef PG8_SA
#undef PG8_SB
#undef PG8_STAGE
#undef PG8_LDA
#undef PG8_LDB
#undef PG8_MMA
#undef PG8_WAIT_V
#undef PG8_WAIT_L
#undef PG8_BAR
#undef PG8_SCHED
}
}

namespace attn_body {
constexpr int NW = 8, QBLK = 32, QB = QBLK * NW, KVBLK = 64;
__device__ __forceinline__ int crow(int r, int hi) { return (r & 3) + 8 * (r >> 2) + 4 * hi; }
#define SBAR() __builtin_amdgcn_sched_barrier(0)
__device__ __forceinline__ void wmask(f32x16& p0, f32x16& p1, int dbase, int hi) {
    const float NEG = -INFINITY; const int kb = dbase + 4 * hi;
#pragma unroll
    for (int r = 0; r < 16; ++r) { const int d0 = kb + (r & 3) + 8 * (r >> 2); if (d0 > 128 || d0 < -128) p0[r] = NEG; const int d1 = d0 + 32; if (d1 > 128 || d1 < -128) p1[r] = NEG; }
}
constexpr int NSLOT = 3, SLOTB = 8192;
constexpr int LDS_K = 0, LDS_V = NSLOT * SLOTB, LDS_WS = 2 * NSLOT * SLOTB, LDS_OST = LDS_WS + NW * 64 * 4, LDS_BYTES = LDS_OST + NW * 4096;
__device__ __forceinline__ void glds16(const void* gsrc, unsigned lds_dst) { unsigned keep;
    asm volatile("s_mov_b32 %0, m0\n\ts_mov_b32 m0, %2\n\ts_nop 0\n\tglobal_load_lds_dwordx4 %1, off\n\ts_mov_b32 m0, %0" : "=&s"(keep) : "v"(gsrc), "s"(lds_dst) : "memory"); }
__device__ __forceinline__ float max3f(float a, float b, float c) { float r; asm("v_max3_f32 %0, %1, %2, %3" : "=v"(r) : "v"(a), "v"(b), "v"(c)); return r; }
__device__ __forceinline__ float max2f(float a, float b) { float r; asm("v_max_f32_e32 %0, %1, %2" : "=v"(r) : "v"(a), "v"(b)); return r; }
__device__ __forceinline__ float fadd_s(float a, float b) { float r; asm("v_add_f32_e32 %0, %1, %2" : "=v"(r) : "v"(a), "v"(b)); return r; }
__device__ __forceinline__ float fsub_s(float a, float b) { float r; asm("v_sub_f32_e32 %0, %1, %2" : "=v"(r) : "v"(a), "v"(b)); return r; }
typedef float f32x2_t __attribute__((ext_vector_type(2))); typedef __bf16 bf16x2_t __attribute__((ext_vector_type(2)));
__device__ __forceinline__ unsigned cvtpk_s(float lo, float hi) { f32x2_t v = {lo, hi}; bf16x2_t b = __builtin_convertvector(v, bf16x2_t); return __builtin_bit_cast(unsigned, b); }
#define WAIT_BAR(N) asm volatile("s_waitcnt vmcnt(" #N ") lgkmcnt(0)\n\ts_barrier" ::: "memory")

__device__ __forceinline__ void qkt(f32x16& p0, f32x16& p1, const char* Kslot, const bf16x8* qr, const f32x16& negm, int r32, int hi) {
    const char* kb = Kslot + hi * 1024 + r32 * 16;
#pragma unroll
    for (int d0 = 0; d0 < 4; ++d0) {
        const bf16x8 b0 = *reinterpret_cast<const bf16x8*>(kb + d0 * 2048);
        const bf16x8 b1 = *reinterpret_cast<const bf16x8*>(kb + d0 * 2048 + 512);
        if (d0 == 0) { p0 = __builtin_amdgcn_mfma_f32_32x32x16_bf16(b0, qr[0], negm, 0, 0, 0); p1 = __builtin_amdgcn_mfma_f32_32x32x16_bf16(b1, qr[0], negm, 0, 0, 0); }
        else { p0 = __builtin_amdgcn_mfma_f32_32x32x16_bf16(b0, qr[d0], p0, 0, 0, 0); p1 = __builtin_amdgcn_mfma_f32_32x32x16_bf16(b1, qr[d0], p1, 0, 0, 0); } }
}
typedef __attribute__((address_space(3))) const char* lds_cptr;
typedef short v4i16_t __attribute__((ext_vector_type(4)));
__device__ __forceinline__ void kload8(bf16x8* kf, lds_cptr kp) {
    kf[0] = *(const LAS bf16x8*)(kp);        kf[1] = *(const LAS bf16x8*)(kp + 512);
    kf[2] = *(const LAS bf16x8*)(kp + 2048); kf[3] = *(const LAS bf16x8*)(kp + 2560);
    kf[4] = *(const LAS bf16x8*)(kp + 4096); kf[5] = *(const LAS bf16x8*)(kp + 4608);
    kf[6] = *(const LAS bf16x8*)(kp + 6144); kf[7] = *(const LAS bf16x8*)(kp + 6656);
}
__device__ __forceinline__ void kload2(bf16x8* kf, lds_cptr kp, int j) { kf[2 * j] = *(const LAS bf16x8*)(kp + j * 2048); kf[2 * j + 1] = *(const LAS bf16x8*)(kp + j * 2048 + 512); }
__device__ __forceinline__ s16x4 vtr(lds_cptr p) { return __builtin_bit_cast(s16x4, __builtin_amdgcn_ds_read_tr16_b64_v4i16((LAS v4i16_t*)p)); }
__device__ __forceinline__ float rowmax(const f32x16& p0, const f32x16& p1) {
    float a = max3f(p0[0], p0[1], p1[0]), b = max3f(p0[2], p0[3], p1[1]); a = max3f(a, p1[2], p1[3]);
#pragma unroll
    for (int r = 4; r < 16; r += 4) { a = max3f(a, p0[r], p0[r + 1]); b = max3f(b, p0[r + 2], p0[r + 3]); a = max3f(a, p1[r], p1[r + 1]); b = max3f(b, p1[r + 2], p1[r + 3]); }
    const float m = max2f(a, b);
    auto rr = __builtin_amdgcn_permlane32_swap(__float_as_uint(m), __float_as_uint(m), false, false);
    return max2f(__uint_as_float(rr[0]), __uint_as_float(rr[1]));
}
__device__ __forceinline__ void pv(f32x16* o, int vb, bf16x8 pa0, bf16x8 pa1, bf16x8 pa2, bf16x8 pa3) {
#pragma unroll
    for (int d0 = 0; d0 < 2; ++d0) { s16x4 lo[4], hi[4];
#pragma unroll
        for (int ks = 0; ks < 4; ++ks) {
            asm volatile("ds_read_b64_tr_b16 %0,%1 offset:%c2" : "=&v"(lo[ks]) : "v"(vb), "i"(d0 * 4096 + ks * 1024) : "memory");
            asm volatile("ds_read_b64_tr_b16 %0,%1 offset:%c2" : "=&v"(hi[ks]) : "v"(vb), "i"(d0 * 4096 + ks * 1024 + 512) : "memory"); }
        asm volatile("s_waitcnt lgkmcnt(0)" ::: "memory"); SBAR();
#define PK(k) (bf16x8){lo[k][0], lo[k][1], lo[k][2], lo[k][3], hi[k][0], hi[k][1], hi[k][2], hi[k][3]}
        o[d0] = __builtin_amdgcn_mfma_f32_32x32x16_bf16(pa0, PK(0), o[d0], 0, 0, 0);
        o[d0] = __builtin_amdgcn_mfma_f32_32x32x16_bf16(pa1, PK(1), o[d0], 0, 0, 0);
        o[d0] = __builtin_amdgcn_mfma_f32_32x32x16_bf16(pa2, PK(2), o[d0], 0, 0, 0);
        o[d0] = __builtin_amdgcn_mfma_f32_32x32x16_bf16(pa3, PK(3), o[d0], 0, 0, 0);
#undef PK
    }
}

template <int PITCH, int OPITCH, bool SWA, int THRL>
__device__ __forceinline__ void attn_unit(const bf16* Q0, const bf16* __restrict__ Kh, const bf16* __restrict__ Vh, bf16* O0, int NT, int boff, int qrow0, float sinkl2, char* shm, const int wid) {
    const int lane = lane_id(), tid = wid * 64 + lane, r32 = lane & 31, hi = lane >> 5;
    const bf16* Qw = Q0 + (long)(wid * QBLK) * PITCH;
    const unsigned lds0 = (unsigned)(uintptr_t)shm;
    float* wsf = (float*)(shm + LDS_WS) + wid * 64;
    const bf16* ksrc = Kh + (long)lane * PITCH + wid * 8;
    const bf16* vsrc = Vh + (long)(16 * (wid & 3) + (lane >> 2)) * PITCH + (wid >> 2) * 32 + (lane & 3) * 8;
    const unsigned kdst = lds0 + LDS_K + wid * 1024, vdst = lds0 + LDS_V + wid * 1024;
#define TILE(t) (((t) < 4) ? (t) : ((t) + boff))
#define DMA_K(t, slot) glds16(ksrc + (long)TILE(t) * KVBLK * PITCH, (unsigned)__builtin_amdgcn_readfirstlane(kdst + (slot)))
#define DMA_V(t, slot) glds16(vsrc + (long)TILE(t) * KVBLK * PITCH, (unsigned)__builtin_amdgcn_readfirstlane(vdst + (slot)))
    const int vb0 = (int)(lds0 + LDS_V) + ((lane >> 4) & 1) * 32 + (lane & 3) * 8 + (4 * hi + ((lane & 15) >> 2)) * 64;
    const char* Kbase = shm + LDS_K; bf16x8 kf[8];
    const lds_cptr shm3 = (lds_cptr)shm; const lds_cptr kp0 = shm3 + LDS_K + hi * 1024 + r32 * 16; const lds_cptr vp0 = shm3 + LDS_V + ((lane >> 4) & 1) * 32 + (lane & 3) * 8 + (4 * hi + ((lane & 15) >> 2)) * 64;
    DMA_K(0, 0); DMA_V(0, 0); DMA_K(1, SLOTB);
    bf16x8 qr[4];
#pragma unroll
    for (int d0 = 0; d0 < 4; ++d0) qr[d0] = *reinterpret_cast<const bf16x8*>(&Qw[(long)r32 * PITCH + d0 * 16 + hi * 8]);
    float mhat = 0.f, l_reg = 0.f; f32x16 o[2]; o[0] = f32x16{}; o[1] = f32x16{}; f32x16 negm = f32x16{}; asm volatile("" : "+v"(negm));
    const int qrel = qrow0 + wid * QBLK + r32;
#define AMASK(P0, P1, t) do { if (SWA) { if ((t) >= 4) wmask(P0, P1, 64 * TILE(t) - qrel, hi); } } while (0)
    bool resc = false;
#define START(P0, P1) do { const float rm = rowmax(P0, P1); resc = false; \
    { const float dl = rm; mhat = fadd_s(mhat, dl); \
      _Pragma("unroll") for (int r = 0; r < 16; ++r) { P0[r] = fsub_s(P0[r], dl); P1[r] = fsub_s(P1[r], dl); } \
      _Pragma("unroll") for (int r = 0; r < 16; ++r) negm[r] = -mhat; asm volatile("" : "+v"(negm)); } \
    _Pragma("unroll") for (int r = 0; r < 16; ++r) P0[r] = __builtin_amdgcn_exp2f(P0[r]); } while (0)
#define RESC() do { if (resc) { asm volatile("s_waitcnt lgkmcnt(0)" ::: "memory"); \
      _Pragma("unroll") for (int d_ = 0; d_ < 2; ++d_) _Pragma("unroll") for (int r = 0; r < 16; ++r) o[d_][r] *= wsf[crow(r, hi)]; } } while (0)
    f32x16 pA0, pA1, pB0, pB1;
    int sl_prev = 0, sl_cur = 0, sl_next = SLOTB;
#define ROT() do { sl_prev = sl_cur; sl_cur = sl_next; sl_next = (sl_next == (NSLOT - 1) * SLOTB) ? 0 : sl_next + SLOTB; } while (0)
    DMA_K(2, 2 * SLOTB);
    WAIT_BAR(3);
    qkt(pA0, pA1, Kbase, qr, negm, r32, hi); asm volatile("s_nop 15\n\ts_nop 7" : "+v"(pA0), "+v"(pA1)); AMASK(pA0, pA1, 0);
    START(pA0, pA1);
    _Pragma("unroll") for (int r = 0; r < 16; ++r) pA1[r] = __builtin_amdgcn_exp2f(pA1[r]);
    WAIT_BAR(0);
    DMA_K(3, 0); DMA_V(1, SLOTB);
    ROT();
    kload8(kf, kp0 + sl_cur);
    WAIT_BAR(2);
    s16x4 vlo[8], vhi[8]; v4u pw0, pw1, pw2, pw3;
#define PKW(P, B) cvtpk_s(P[B], P[B + 1])
#define PAF(k) __builtin_bit_cast(bf16x8, pw##k)
#define VFR(i) (bf16x8){vlo[i][0], vlo[i][1], vlo[i][2], vlo[i][3], vhi[i][0], vhi[i][1], vhi[i][2], vhi[i][3]}
#define PIN(x) asm volatile("" : "+v"(x))
#define MX3(a, b, c) __builtin_fmaxf(__builtin_fmaxf((a), (b)), (c))
#define GAPA(MF, A0, A1, A2, A3, W0, W1, PW) do { MF; sacc += A0; sacc += A1; sacc += A2; sacc += A3; PIN(sacc); W0; W1; PIN(PW); SBAR(); } while (0)
#define EX(v) __builtin_amdgcn_exp2f(v)
#define GAPB(MF, X, B) do { MF; X[B] = EX(X[B]); X[B + 1] = EX(X[B + 1]); X[B + 2] = EX(X[B + 2]); X[B + 3] = EX(X[B + 3]); PIN(X); SBAR(); } while (0)
#define VRD(i) do { vlo[i] = vtr(vp_ + (((i) >> 2) * 4096 + ((i) & 3) * 1024)); vhi[i] = vtr(vp_ + (((i) >> 2) * 4096 + ((i) & 3) * 1024 + 512)); } while (0)
#define KRD(G, j) do { if (G) { kload2(kf, kp0 + sl_next, j); SBAR(); } } while (0)
#define STEP(C0, C1, P0, P1, t, GK, GV, GL) do { SBAR(); \
    const lds_cptr vp_ = vp0 + sl_prev; \
    VRD(0); SBAR(); float sacc = (P0[0] + P0[1]); \
    GAPA(C0 = __builtin_amdgcn_mfma_f32_32x32x16_bf16(kf[0], qr[0], negm, 0, 0, 0), P0[2], P0[3], P0[4], P0[5],     pw0[0] = PKW(P0, 0), pw0[1] = PKW(P0, 2), pw0); \
    VRD(4); SBAR(); GAPA(C1 = __builtin_amdgcn_mfma_f32_32x32x16_bf16(kf[1], qr[0], negm, 0, 0, 0), P0[6], P0[7], P0[8], P0[9],     pw0[2] = PKW(P0, 4), pw0[3] = PKW(P0, 6), pw0); \
    VRD(1); SBAR(); GAPA(C0 = __builtin_amdgcn_mfma_f32_32x32x16_bf16(kf[2], qr[1], C0, 0, 0, 0),   P0[10], P0[11], P0[12], P0[13], pw1[0] = PKW(P0, 8), pw1[1] = PKW(P0, 10), pw1); \
    VRD(5); SBAR(); GAPA(C1 = __builtin_amdgcn_mfma_f32_32x32x16_bf16(kf[3], qr[1], C1, 0, 0, 0),   P0[14], P0[15], P1[0], P1[1],   pw1[2] = PKW(P0, 12), pw1[3] = PKW(P0, 14), pw1); \
    VRD(2); SBAR(); GAPA(C0 = __builtin_amdgcn_mfma_f32_32x32x16_bf16(kf[4], qr[2], C0, 0, 0, 0),   P1[2], P1[3], P1[4], P1[5],     pw2[0] = PKW(P1, 0), pw2[1] = PKW(P1, 2), pw2); \
    VRD(6); SBAR(); GAPA(C1 = __builtin_amdgcn_mfma_f32_32x32x16_bf16(kf[5], qr[2], C1, 0, 0, 0),   P1[6], P1[7], P1[8], P1[9],     pw2[2] = PKW(P1, 4), pw2[3] = PKW(P1, 6), pw2); \
    VRD(3); SBAR(); GAPA(C0 = __builtin_amdgcn_mfma_f32_32x32x16_bf16(kf[6], qr[3], C0, 0, 0, 0),   P1[10], P1[11], P1[12], P1[13], pw3[0] = PKW(P1, 8), pw3[1] = PKW(P1, 10), pw3); \
    VRD(7); SBAR(); GAPA(C1 = __builtin_amdgcn_mfma_f32_32x32x16_bf16(kf[7], qr[3], C1, 0, 0, 0),   P1[14], P1[15], 0.f, 0.f,       pw3[2] = PKW(P1, 12), pw3[3] = PKW(P1, 14), pw3); \
    l_reg += sacc; \
    if (GK) { DMA_K((t) + 3, sl_cur); } if (GV) { DMA_V((t) + 1, sl_next); } \
    AMASK(C0, C1, t); \
    { float a = MX3(C0[0], C0[1], C1[0]), b = MX3(C0[2], C0[3], C1[1]); a = MX3(a, C1[2], C1[3]); \
      _Pragma("unroll") for (int r = 4; r < 16; r += 4) { a = MX3(a, C0[r], C0[r + 1]); b = MX3(b, C0[r + 2], C0[r + 3]); a = MX3(a, C1[r], C1[r + 1]); b = MX3(b, C1[r + 2], C1[r + 3]); } \
      float rm = __builtin_fmaxf(a, b); { auto rr = __builtin_amdgcn_permlane32_swap(__float_as_uint(rm), __float_as_uint(rm), false, false); rm = __builtin_fmaxf(__uint_as_float(rr[0]), __uint_as_float(rr[1])); } \
      resc = false; \
      if (__builtin_expect(__any(rm > (float)THRL), 0)) { const float dl = __builtin_fmaxf(rm, 0.f); mhat += dl; \
        _Pragma("unroll") for (int r = 0; r < 16; ++r) { C0[r] -= dl; C1[r] -= dl; } \
        _Pragma("unroll") for (int r = 0; r < 16; ++r) negm[r] = -mhat; asm volatile("" : "+v"(negm)); \
        const float f = __builtin_amdgcn_exp2f(-dl); l_reg *= f; if (hi == 0) wsf[r32] = f; resc = true; } } \
    SBAR(); \
    GAPB(o[0] = __builtin_amdgcn_mfma_f32_32x32x16_bf16(PAF(0), VFR(0), o[0], 0, 0, 0), C0, 0); \
    GAPB(o[1] = __builtin_amdgcn_mfma_f32_32x32x16_bf16(PAF(0), VFR(4), o[1], 0, 0, 0), C0, 4); \
    KRD(GL, 0); GAPB(o[0] = __builtin_amdgcn_mfma_f32_32x32x16_bf16(PAF(1), VFR(1), o[0], 0, 0, 0), C0, 8); \
    KRD(GL, 1); GAPB(o[1] = __builtin_amdgcn_mfma_f32_32x32x16_bf16(PAF(1), VFR(5), o[1], 0, 0, 0), C0, 12); \
    KRD(GL, 2); GAPB(o[0] = __builtin_amdgcn_mfma_f32_32x32x16_bf16(PAF(2), VFR(2), o[0], 0, 0, 0), C1, 0); \
    KRD(GL, 3); GAPB(o[1] = __builtin_amdgcn_mfma_f32_32x32x16_bf16(PAF(2), VFR(6), o[1], 0, 0, 0), C1, 4); \
    GAPB(o[0] = __builtin_amdgcn_mfma_f32_32x32x16_bf16(PAF(3), VFR(3), o[0], 0, 0, 0), C1, 8); \
    GAPB(o[1] = __builtin_amdgcn_mfma_f32_32x32x16_bf16(PAF(3), VFR(7), o[1], 0, 0, 0), C1, 12); \
    } while (0)
    int t = 1;
    for (; t + 5 < NT; t += 2) {
        STEP(pB0, pB1, pA0, pA1, t, true, true, true);     WAIT_BAR(2); RESC(); ROT();
        STEP(pA0, pA1, pB0, pB1, t + 1, true, true, true); WAIT_BAR(2); RESC(); ROT();
    }
#define ENDW(tt) do { if ((tt) + 3 < NT) { WAIT_BAR(2); } else if ((tt) + 2 < NT) { WAIT_BAR(1); } else { WAIT_BAR(0); } } while (0)
    for (; t + 1 < NT; t += 2) {
        STEP(pB0, pB1, pA0, pA1, t, (t + 3 < NT), (t + 1 < NT), (t + 1 < NT));       ENDW(t);     RESC(); ROT();
        STEP(pA0, pA1, pB0, pB1, t + 1, (t + 4 < NT), (t + 2 < NT), (t + 2 < NT));   ENDW(t + 1); RESC(); ROT();
    }
    STEP(pB0, pB1, pA0, pA1, NT - 1, false, false, false); RESC();
    { float sacc = pB0[0] + pB0[1]; _Pragma("unroll") for (int r = 2; r < 16; ++r) sacc += pB0[r]; _Pragma("unroll") for (int r = 0; r < 16; ++r) sacc += pB1[r]; l_reg += sacc;
      pw0 = (v4u){PKW(pB0, 0), PKW(pB0, 2), PKW(pB0, 4), PKW(pB0, 6)}; pw1 = (v4u){PKW(pB0, 8), PKW(pB0, 10), PKW(pB0, 12), PKW(pB0, 14)}; pw2 = (v4u){PKW(pB1, 0), PKW(pB1, 2), PKW(pB1, 4), PKW(pB1, 6)}; pw3 = (v4u){PKW(pB1, 8), PKW(pB1, 10), PKW(pB1, 12), PKW(pB1, 14)};
      SBAR(); pv(o, vb0 + sl_cur, PAF(0), PAF(1), PAF(2), PAF(3)); }
#undef PKW
#undef PAF
#undef VFR
#undef PIN
#undef MX3
#undef GAPA
#undef GAPB
#undef EX
#undef VRD
#undef KRD
#undef STEP
#undef ENDW
    { auto rr = __builtin_amdgcn_permlane32_swap(__float_as_uint(l_reg), __float_as_uint(l_reg), false, false); l_reg = __uint_as_float(rr[0]) + __uint_as_float(rr[1]); }
    if (SWA) l_reg += __builtin_amdgcn_exp2f(sinkl2 - mhat);
    if (hi == 0) wsf[32 + r32] = l_reg; asm volatile("s_waitcnt lgkmcnt(0)" ::: "memory");
    float rli[16];
#pragma unroll
    for (int r = 0; r < 16; ++r) rli[r] = __builtin_amdgcn_rcpf(wsf[32 + crow(r, hi)]);
    bf16* Ow = O0 + (long)(wid * QBLK) * OPITCH;
    { bf16* stg = (bf16*)(shm + LDS_OST) + wid * 2048;
#pragma unroll
      for (int r = 0; r < 16; ++r) { const int orow = crow(r, hi);
#pragma unroll
        for (int d0 = 0; d0 < 2; ++d0) stg[orow * 64 + d0 * 32 + r32] = (bf16)f2bf(o[d0][r] * rli[r]); }
      asm volatile("s_waitcnt lgkmcnt(0)" ::: "memory");
#pragma unroll
      for (int i = 0; i < 4; ++i) { const int row = i * 8 + (lane >> 3), ch = lane & 7; const v4u v = *(const v4u*)(stg + row * 64 + ch * 8); *(v4u*)(Ow + (long)row * OPITCH + ch * 8) = v; } }
    asm volatile("s_waitcnt lgkmcnt(0)\n\ts_barrier" ::: "memory");
#undef DMA_K
#undef DMA_V
#undef TILE
#undef AMASK
#undef START
#undef RESC
#undef ROT
}
#undef SBAR
#undef WAIT_BAR
}

namespace attn_dv {
constexpr int NW = 8, QBLK = 32, KVBLK = 64;
constexpr int SHM_V = KVBLK * 128 * 2, SHM_K = KVBLK * 64 * 2, SHM_ATTN = 2 * SHM_V + 2 * SHM_K + NW * 64 * 4;
constexpr float THR = 8.f;
#define KSWZ64(row, colB) ((row) * 128 + ((colB) ^ ((((row) >> 1) & 7) << 4)))
#define SBAR() __builtin_amdgcn_sched_barrier(0)
__device__ __forceinline__ int crow(int r, int hi) { return (r & 3) + 8 * (r >> 2) + 4 * hi; }
__device__ __forceinline__ unsigned cvtpk(float lo, float hi) { unsigned r; asm volatile("v_cvt_pk_bf16_f32 %0, %1, %2" : "=v"(r) : "v"(lo), "v"(hi)); return r; }
__device__ __forceinline__ void partialSM(f32x16& p0, f32x16& p1, float& m_reg, float& mn, float& alpha) {
    float pmax = p0[0];
#pragma unroll
    for (int r = 1; r < 16; ++r) pmax = fmaxf(pmax, p0[r]);
#pragma unroll
    for (int r = 0; r < 16; ++r) pmax = fmaxf(pmax, p1[r]);
    { auto rr = __builtin_amdgcn_permlane32_swap(__float_as_uint(pmax), __float_as_uint(pmax), false, false); pmax = fmaxf(__uint_as_float(rr[0]), __uint_as_float(rr[1])); }
    if (__builtin_expect(__all(pmax - m_reg <= THR), 1)) { mn = m_reg; alpha = 1.f; }
    else { mn = fmaxf(m_reg, pmax); alpha = __builtin_amdgcn_exp2f(m_reg - mn); m_reg = mn; }
#pragma unroll
    for (int r = 0; r < 16; ++r) p0[r] = p0[r] - mn;
#pragma unroll
    for (int r = 0; r < 16; ++r) p1[r] = p1[r] - mn;
#pragma unroll
    for (int r = 0; r < 16; ++r) p0[r] = __builtin_amdgcn_exp2f(p0[r]);
}
__device__ __forceinline__ void finishSM(f32x16& p0, f32x16& p1, float alpha, float& l_reg, bf16x8& pa0, bf16x8& pa1, bf16x8& pa2, bf16x8& pa3) {
#pragma unroll
    for (int r = 0; r < 16; ++r) p1[r] = __builtin_amdgcn_exp2f(p1[r]);
    float ps = 0;
#pragma unroll
    for (int r = 0; r < 16; ++r) ps += p0[r];
#pragma unroll
    for (int r = 0; r < 16; ++r) ps += p1[r];
    { auto rr = __builtin_amdgcn_permlane32_swap(__float_as_uint(ps), __float_as_uint(ps), false, false); ps = __uint_as_float(rr[0]) + __uint_as_float(rr[1]); }
    l_reg = l_reg * alpha + ps;
#define PK4(P, BASE, OUT) do { unsigned a0 = cvtpk(P[BASE + 0], P[BASE + 1]), a1 = cvtpk(P[BASE + 2], P[BASE + 3]);   \
    unsigned b0 = cvtpk(P[BASE + 4], P[BASE + 5]), b1 = cvtpk(P[BASE + 6], P[BASE + 7]);                              \
    auto r0 = __builtin_amdgcn_permlane32_swap(a0, b0, false, false); auto r1 = __builtin_amdgcn_permlane32_swap(a1, b1, false, false); \
    v4u w = {r0[0], r1[0], r0[1], r1[1]}; OUT = __builtin_bit_cast(bf16x8, w); } while (0)
    PK4(p0, 0, pa0); PK4(p0, 8, pa1); PK4(p1, 0, pa2); PK4(p1, 8, pa3);
#undef PK4
}
__device__ __forceinline__ void qkt(f32x16& p0, f32x16& p1, const char* Ks, const bf16x8* qr, int r32, int hi) {
    p0 = f32x16{}; p1 = f32x16{};
#pragma unroll
    for (int d0 = 0; d0 < 4; ++d0) { const int cb = (d0 * 16 + hi * 8) * 2;
        const bf16x8 b0 = *reinterpret_cast<const bf16x8*>(Ks + KSWZ64(r32, cb));
        const bf16x8 b1 = *reinterpret_cast<const bf16x8*>(Ks + KSWZ64(32 + r32, cb));
        p0 = __builtin_amdgcn_mfma_f32_32x32x16_bf16(b0, qr[d0], p0, 0, 0, 0);
        p1 = __builtin_amdgcn_mfma_f32_32x32x16_bf16(b1, qr[d0], p1, 0, 0, 0); }
}
__device__ __forceinline__ int v_st(int k, int c) { const int kk = (k & ~0xC) | ((k & 4) << 1) | ((k & 8) >> 1); return ((kk >> 3) * 4 + (c >> 5)) * 512 + ((kk & 7) * 32 + (c & 31)) * 2; }
__device__ __forceinline__ int v_rd_base(int lane) { return ((lane & 3) << 3) | (((lane >> 2) & 3) << 6) | (((lane >> 4) & 1) << 5) | (((lane >> 5) & 1) << 8); }
constexpr int v_rd_off(int d0, int ks, int half) { return d0 * 512 + ks * 4096 + half * 2048; }
template <int OFF> __device__ __forceinline__ s16x4 tr_read(int vb) { s16x4 r; asm volatile("ds_read_b64_tr_b16 %0, %1 offset:%2" : "=&v"(r) : "v"(vb), "i"(OFF) : "memory"); return r; }
template <int D0> __device__ __forceinline__ void pv_one(f32x16& od, int vb, bf16x8 pa0, bf16x8 pa1, bf16x8 pa2, bf16x8 pa3) {
    const s16x4 l0 = tr_read<v_rd_off(D0, 0, 0)>(vb), h0 = tr_read<v_rd_off(D0, 0, 1)>(vb), l1 = tr_read<v_rd_off(D0, 1, 0)>(vb), h1 = tr_read<v_rd_off(D0, 1, 1)>(vb);
    const s16x4 l2 = tr_read<v_rd_off(D0, 2, 0)>(vb), h2 = tr_read<v_rd_off(D0, 2, 1)>(vb), l3 = tr_read<v_rd_off(D0, 3, 0)>(vb), h3 = tr_read<v_rd_off(D0, 3, 1)>(vb);
    asm volatile("s_waitcnt lgkmcnt(0)" ::: "memory"); SBAR();
#define PK(L, H) (bf16x8){L[0], L[1], L[2], L[3], H[0], H[1], H[2], H[3]}
    od = __builtin_amdgcn_mfma_f32_32x32x16_bf16(pa0, PK(l0, h0), od, 0, 0, 0);
    od = __builtin_amdgcn_mfma_f32_32x32x16_bf16(pa1, PK(l1, h1), od, 0, 0, 0);
    od = __builtin_amdgcn_mfma_f32_32x32x16_bf16(pa2, PK(l2, h2), od, 0, 0, 0);
    od = __builtin_amdgcn_mfma_f32_32x32x16_bf16(pa3, PK(l3, h3), od, 0, 0, 0);
#undef PK
}
__device__ __forceinline__ void pv_d0(f32x16* o, int vb, bf16x8 pa0, bf16x8 pa1, bf16x8 pa2, bf16x8 pa3) {
    pv_one<0>(o[0], vb, pa0, pa1, pa2, pa3); pv_one<1>(o[1], vb, pa0, pa1, pa2, pa3); pv_one<2>(o[2], vb, pa0, pa1, pa2, pa3); pv_one<3>(o[3], vb, pa0, pa1, pa2, pa3);
}
constexpr int SHM_ATTN3 = 3 * SHM_V + 3 * SHM_K + NW * 64 * 4;
template <int LDP, int LDO>
__device__ __forceinline__ void attn_dense_body(const bf16* __restrict__ Qb, const bf16* __restrict__ Kh, const bf16* __restrict__ Vh, bf16* __restrict__ Ob, int seq, char* lds, const int wid) {
    const int lane = lane_id(), tid = wid * 64 + lane, r32 = lane & 31, hi = lane >> 5;
    char* V_lds = lds; char* K_lds = lds + 3 * SHM_V;
    float* ws = (float*)(lds + 3 * SHM_V + 3 * SHM_K) + wid * 64; float* li_l = ws; float* al_l = ws + 32;
    float m_reg = -1e30f, l_reg = 0; f32x16 o[4] = {}; bf16x8 qr[4];
    const bf16* Qw = Qb + (long)(wid * QBLK + r32) * LDP + hi * 8;
#pragma unroll
    for (int d0 = 0; d0 < 4; ++d0) qr[d0] = *reinterpret_cast<const bf16x8*>(Qw + d0 * 16);
    const int sr = tid >> 4, sc = (tid & 15) * 8, vst0 = v_st(sr, sc), vst1 = v_st(32 + sr, sc);
    const int kr = tid >> 3, kc = (tid & 7) * 8, kst = KSWZ64(kr, kc * 2);
    const int vb0 = (int)(uintptr_t)V_lds + v_rd_base(lane);
    bf16x8 vs0, vs1, ks0;
#define SLOAD(k0) do { vs0 = *reinterpret_cast<const bf16x8*>(&Vh[(long)((k0) + sr) * LDP + sc]); vs1 = *reinterpret_cast<const bf16x8*>(&Vh[(long)((k0) + 32 + sr) * LDP + sc]); \
    ks0 = *reinterpret_cast<const bf16x8*>(&Kh[(long)((k0) + kr) * LDP + kc]); } while (0)
#define SWRITE(s) do { *(bf16x8*)(V_lds + (s) * SHM_V + vst0) = vs0; *(bf16x8*)(V_lds + (s) * SHM_V + vst1) = vs1; *(bf16x8*)(K_lds + (s) * SHM_K + kst) = ks0; } while (0)
#define RESC(a) do { if (__any((a) < 1.f)) { if (hi == 0) al_l[r32] = (a); asm volatile("s_waitcnt lgkmcnt(0)" ::: "memory"); \
    _Pragma("unroll") for (int d = 0; d < 4; ++d) _Pragma("unroll") for (int r = 0; r < 16; ++r) o[d][r] *= al_l[crow(r, hi)]; } } while (0)
#define LBAR() do { asm volatile("s_waitcnt lgkmcnt(0)" ::: "memory"); __builtin_amdgcn_s_barrier(); asm volatile("" ::: "memory"); } while (0)
    f32x16 pA0, pA1, pB0, pB1; float mnA, mnB, alA, alB; bf16x8 pa0, pa1, pa2, pa3; const int NT = seq / KVBLK;
    int s0 = 0, s1 = 1, s2 = 2;
#define ROT3() do { const int t_ = s0; s0 = s1; s1 = s2; s2 = t_; } while (0)
    SLOAD(0); SWRITE(0); SLOAD(KVBLK); LBAR();
    qkt(pA0, pA1, K_lds, qr, r32, hi); partialSM(pA0, pA1, m_reg, mnA, alA);
    SWRITE(1); if (2 < NT) SLOAD(2 * KVBLK); LBAR();
#define STEP3(X0, X1, mnX, alX, Y0, Y1, alY, j) do { \
        if ((j) + 1 < NT) SWRITE(s2); SBAR(); \
        if ((j) + 2 < NT) SLOAD(((j) + 2) * KVBLK); SBAR(); \
        qkt(X0, X1, K_lds + s1 * SHM_K, qr, r32, hi); \
        finishSM(Y0, Y1, alY, l_reg, pa0, pa1, pa2, pa3); SBAR(); \
        pv_d0(o, vb0 + s0 * SHM_V, pa0, pa1, pa2, pa3); partialSM(X0, X1, m_reg, mnX, alX); \
        RESC(alX); LBAR(); ROT3(); } while (0)
    int j = 1;
    for (; j + 1 < NT; j += 2) {
        STEP3(pB0, pB1, mnB, alB, pA0, pA1, alA, j);
        STEP3(pA0, pA1, mnA, alA, pB0, pB1, alB, j + 1);
    }
    STEP3(pB0, pB1, mnB, alB, pA0, pA1, alA, NT - 1);
    finishSM(pB0, pB1, alB, l_reg, pa0, pa1, pa2, pa3); SBAR();
    pv_d0(o, vb0 + s0 * SHM_V, pa0, pa1, pa2, pa3);
    if (hi == 0) li_l[r32] = l_reg; asm volatile("s_waitcnt lgkmcnt(0)" ::: "memory");
    float rli[16];
#pragma unroll
    for (int r = 0; r < 16; ++r) rli[r] = __builtin_amdgcn_rcpf(li_l[crow(r, hi)]);
    bf16* Ow = Ob + (long)(wid * QBLK) * LDO;
#pragma unroll
    for (int r = 0; r < 16; ++r) { const int orow = crow(r, hi);
#pragma unroll
        for (int d0 = 0; d0 < 4; ++d0) Ow[(long)orow * LDO + d0 * 32 + r32] = (bf16)f2bf(o[d0][r] * rli[r]); }
    LBAR();
#undef SLOAD
#undef SWRITE
#undef RESC
#undef LBAR
#undef ROT3
#undef STEP3
}

constexpr int SHM_V8 = 128 * 80, SHM_ATTN8 = 3 * SHM_V8 + 3 * SHM_K + NW * 64 * 4;
__device__ __forceinline__ int cvt4_nc(float a, float b, float c, float d) { int w = 0; w = __builtin_amdgcn_cvt_pk_fp8_f32(a, b, w, false); w = __builtin_amdgcn_cvt_pk_fp8_f32(c, d, w, true); return w; }
__device__ __forceinline__ int vt8_slot(int ko) { const int k5 = ko & 31, hi = (k5 >> 2) & 1, r = (k5 & 3) + 4 * (k5 >> 3); return hi * 32 + (ko >> 5) * 16 + r; }
__device__ __forceinline__ void finishSM8(f32x16& p0, f32x16& p1, float alpha, float& l_reg, v8i& pa) {
#pragma unroll
    for (int r = 0; r < 16; ++r) p1[r] = __builtin_amdgcn_exp2f(p1[r]);
    float ps = 0;
#pragma unroll
    for (int r = 0; r < 16; ++r) ps += p0[r];
#pragma unroll
    for (int r = 0; r < 16; ++r) ps += p1[r];
    { auto rr = __builtin_amdgcn_permlane32_swap(__float_as_uint(ps), __float_as_uint(ps), false, false); ps = __uint_as_float(rr[0]) + __uint_as_float(rr[1]); }
    l_reg = l_reg * alpha + ps;
    pa = (v8i){cvt4_nc(p0[0], p0[1], p0[2], p0[3]), cvt4_nc(p0[4], p0[5], p0[6], p0[7]), cvt4_nc(p0[8], p0[9], p0[10], p0[11]), cvt4_nc(p0[12], p0[13], p0[14], p0[15]),
               cvt4_nc(p1[0], p1[1], p1[2], p1[3]), cvt4_nc(p1[4], p1[5], p1[6], p1[7]), cvt4_nc(p1[8], p1[9], p1[10], p1[11]), cvt4_nc(p1[12], p1[13], p1[14], p1[15])};
}
__device__ __forceinline__ void pv8(f32x16* o, const char* Vs, v8i pa, int r32, int hi, int scale1) {
    v8i vb[4];
#pragma unroll
    for (int d0 = 0; d0 < 4; ++d0) { const char* p = Vs + (d0 * 32 + r32) * 80 + hi * 32; const v4i lo = *reinterpret_cast<const v4i*>(p), hh = *reinterpret_cast<const v4i*>(p + 16);
        vb[d0] = (v8i){lo[0], lo[1], lo[2], lo[3], hh[0], hh[1], hh[2], hh[3]}; }
    asm volatile("s_waitcnt lgkmcnt(0)\n\ts_nop 3" ::: "memory"); SBAR();
#pragma unroll
    for (int d0 = 0; d0 < 4; ++d0)
        asm volatile("v_mfma_f32_32x32x64_f8f6f4 %0, %1, %2, %0" : "+v"(o[d0]) : "v"(pa), "v"(vb[d0]), "v"(scale1));
    SBAR();
}
template <int LDP, int LDO>
__device__ __forceinline__ void attn_dense_body8(const bf16* __restrict__ Qb, const bf16* __restrict__ Kh, const unsigned char* __restrict__ Vt, bf16* __restrict__ Ob, int seq, char* lds, const int wid) {
    const int lane = lane_id(), tid = wid * 64 + lane, r32 = lane & 31, hi = lane >> 5;
    char* V_lds = lds; char* K_lds = lds + 3 * SHM_V8;
    float* ws = (float*)(lds + 3 * SHM_V8 + 3 * SHM_K) + wid * 64; float* li_l = ws; float* al_l = ws + 32;
    float m_reg = -1e30f, l_reg = 0; f32x16 o[4] = {}; bf16x8 qr[4];
    const int scale1 = 0x7F7F7F7F;
    const bf16* Qw = Qb + (long)(wid * QBLK + r32) * LDP + hi * 8;
#pragma unroll
    for (int d0 = 0; d0 < 4; ++d0) qr[d0] = *reinterpret_cast<const bf16x8*>(Qw + d0 * 16);
    const int vcol = tid >> 2, vq = tid & 3, vst = vcol * 80 + vq * 16;
    const unsigned char* vsrc = Vt + (long)vcol * RB + vq * 16;
    const int kr = tid >> 3, kc = (tid & 7) * 8, kst = KSWZ64(kr, kc * 2);
    v4i vs0; bf16x8 ks0;
#define SLOAD(k0) do { vs0 = *reinterpret_cast<const v4i*>(vsrc + (k0)); ks0 = *reinterpret_cast<const bf16x8*>(&Kh[(long)((k0) + kr) * LDP + kc]); } while (0)
#define SWRITE(s) do { *(v4i*)(V_lds + (s) * SHM_V8 + vst) = vs0; *(bf16x8*)(K_lds + (s) * SHM_K + kst) = ks0; } while (0)
#define RESC(a) do { if (__any((a) < 1.f)) { if (hi == 0) al_l[r32] = (a); asm volatile("s_waitcnt lgkmcnt(0)" ::: "memory"); \
    _Pragma("unroll") for (int d = 0; d < 4; ++d) _Pragma("unroll") for (int r = 0; r < 16; ++r) o[d][r] *= al_l[crow(r, hi)]; } } while (0)
#define LBAR() do { asm volatile("s_waitcnt lgkmcnt(0)" ::: "memory"); __builtin_amdgcn_s_barrier(); asm volatile("" ::: "memory"); } while (0)
    f32x16 pA0, pA1, pB0, pB1; float mnA, mnB, alA, alB; v8i pa; const int NT = seq / KVBLK;
    int s0 = 0, s1 = 1, s2 = 2;
#define ROT3() do { const int t_ = s0; s0 = s1; s1 = s2; s2 = t_; } while (0)
    SLOAD(0); SWRITE(0); SLOAD(KVBLK); LBAR();
    qkt(pA0, pA1, K_lds, qr, r32, hi); partialSM(pA0, pA1, m_reg, mnA, alA);
    SWRITE(1); if (2 < NT) SLOAD(2 * KVBLK); LBAR();
#define STEP3(X0, X1, mnX, alX, Y0, Y1, alY, j) do { \
        if ((j) + 1 < NT) SWRITE(s2); SBAR(); \
        if ((j) + 2 < NT) SLOAD(((j) + 2) * KVBLK); SBAR(); \
        qkt(X0, X1, K_lds + s1 * SHM_K, qr, r32, hi); \
        finishSM8(Y0, Y1, alY, l_reg, pa); SBAR(); \
        pv8(o, V_lds + s0 * SHM_V8, pa, r32, hi, scale1); partialSM(X0, X1, m_reg, mnX, alX); \
        RESC(alX); LBAR(); ROT3(); } while (0)
    int j = 1;
    for (; j + 1 < NT; j += 2) {
        STEP3(pB0, pB1, mnB, alB, pA0, pA1, alA, j);
        STEP3(pA0, pA1, mnA, alA, pB0, pB1, alB, j + 1);
    }
    STEP3(pB0, pB1, mnB, alB, pA0, pA1, alA, NT - 1);
    finishSM8(pB0, pB1, alB, l_reg, pa); SBAR();
    pv8(o, V_lds + s0 * SHM_V8, pa, r32, hi, scale1);
    if (hi == 0) li_l[r32] = l_reg; asm volatile("s_waitcnt lgkmcnt(0)\n\ts_nop 15\n\ts_nop 15\n\ts_nop 15\n\ts_nop 15\n\ts_nop 15" ::: "memory");
    float rli[16];
#pragma unroll
    for (int r = 0; r < 16; ++r) rli[r] = __builtin_amdgcn_rcpf(li_l[crow(r, hi)]);
    bf16* Ow = Ob + (long)(wid * QBLK) * LDO;
#pragma unroll
    for (int r = 0; r < 16; ++r) { const int orow = crow(r, hi);
#pragma unroll
        for (int d0 = 0; d0 < 4; ++d0) Ow[(long)orow * LDO + d0 * 32 + r32] = (bf16)f2bf(o[d0][r] * rli[r]); }
    LBAR();
#undef SLOAD
#undef SWRITE
#undef RESC
#undef LBAR
#undef ROT3
#undef STEP3
}

__device__ __forceinline__ void pack8x(const f32x16& p0, const f32x16& p1, v8i& pa) {
    unsigned w[8];
#pragma unroll
    for (int g = 0; g < 4; ++g) { unsigned a = 0, b = 0;
#pragma unroll
        for (int i = 0; i < 4; ++i) { a = __builtin_amdgcn_cvt_pk_u8_f32(p0[4 * g + i], i, a); b = __builtin_amdgcn_cvt_pk_u8_f32(p1[4 * g + i], i, b); }
        w[g] = a; w[4 + g] = b; }
    pa = (v8i){(int)w[0], (int)w[1], (int)w[2], (int)w[3], (int)w[4], (int)w[5], (int)w[6], (int)w[7]};
}
template <int LDP, int LDO>
__device__ __forceinline__ void attn_dense_body8x(const bf16* __restrict__ Qb, const bf16* __restrict__ Kh, const unsigned char* __restrict__ Vt, bf16* __restrict__ Ob, int seq, char* lds, const int wid) {
    const int lane = lane_id(), tid = wid * 64 + lane, r32 = lane & 31, hi = lane >> 5;
    char* V_lds = lds; char* K_lds = lds + 3 * SHM_V8;
    float* ws = (float*)(lds + 3 * SHM_V8 + 3 * SHM_K) + wid * 64; float* al_l = ws + 32;
    f32x16 o[5] = {}; bf16x8 qr[4];
    f32x16 cvec; { _Pragma("unroll") for (int r = 0; r < 16; ++r) cvec[r] = 56.5f; }
    const int scale1 = 0x7F7F7F7F;
    const bf16* Qw = Qb + (long)(wid * QBLK + r32) * LDP + hi * 8;
#pragma unroll
    for (int d0 = 0; d0 < 4; ++d0) qr[d0] = *reinterpret_cast<const bf16x8*>(Qw + d0 * 16);
    const int vcol = tid >> 2, vq = tid & 3, vst = vcol * 80 + vq * 16;
    const unsigned char* vsrc = Vt + (long)vcol * RB + vq * 16;
    const int kr = tid >> 3, kc = (tid & 7) * 8, kst = KSWZ64(kr, kc * 2);
    v4i vs0; bf16x8 ks0;
#define SLOAD(k0) do { vs0 = *reinterpret_cast<const v4i*>(vsrc + (k0)); ks0 = *reinterpret_cast<const bf16x8*>(&Kh[(long)((k0) + kr) * LDP + kc]); } while (0)
#define SWRITE(s) do { *(v4i*)(V_lds + (s) * SHM_V8 + vst) = vs0; *(bf16x8*)(K_lds + (s) * SHM_K + kst) = ks0; } while (0)
#define RESC(a) do { if (__any((a) < 1.f)) { if (hi == 0) al_l[r32] = (a); asm volatile("s_waitcnt lgkmcnt(0)" ::: "memory"); \
    _Pragma("unroll") for (int d = 0; d < 5; ++d) _Pragma("unroll") for (int r = 0; r < 16; ++r) o[d][r] *= al_l[crow(r, hi)]; } } while (0)
#define LBAR() do { asm volatile("s_waitcnt lgkmcnt(0)" ::: "memory"); __builtin_amdgcn_s_barrier(); asm volatile("" ::: "memory"); } while (0)
#define REFUPD(X0, X1, alX, FIRST) do { float pmax_ = X0[0]; \
        _Pragma("unroll") for (int r = 1; r < 16; ++r) pmax_ = fmaxf(pmax_, X0[r]); \
        _Pragma("unroll") for (int r = 0; r < 16; ++r) pmax_ = fmaxf(pmax_, X1[r]); \
        { auto rr = __builtin_amdgcn_permlane32_swap(__float_as_uint(pmax_), __float_as_uint(pmax_), false, false); pmax_ = fmaxf(__uint_as_float(rr[0]), __uint_as_float(rr[1])); } \
        alX = 1.f; \
        if ((FIRST) || !__all(pmax_ <= 56.5f + 8.0f * THR)) { const float d8_ = (FIRST) ? pmax_ - 56.5f : fmaxf(pmax_ - 56.5f, 0.f); \
            _Pragma("unroll") for (int r = 0; r < 16; ++r) { X0[r] -= d8_; X1[r] -= d8_; cvec[r] -= d8_; } \
            alX = __builtin_amdgcn_exp2f(-0.125f * d8_); } } while (0)
#define PV5(Vs) do { v8i vb_[4]; \
        _Pragma("unroll") for (int d0 = 0; d0 < 4; ++d0) { const char* p_ = (Vs) + (d0 * 32 + r32) * 80 + hi * 32; const v4i lo_ = *reinterpret_cast<const v4i*>(p_), hh_ = *reinterpret_cast<const v4i*>(p_ + 16); \
            vb_[d0] = (v8i){lo_[0], lo_[1], lo_[2], lo_[3], hh_[0], hh_[1], hh_[2], hh_[3]}; } \
        asm volatile("s_waitcnt lgkmcnt(0)\n\ts_nop 3" ::: "memory"); SBAR(); \
        _Pragma("unroll") for (int d0 = 0; d0 < 4; ++d0) asm volatile("v_mfma_f32_32x32x64_f8f6f4 %0, %1, %2, %0" : "+v"(o[d0]) : "v"(pa), "v"(vb_[d0]), "v"(scale1)); \
        { int k38_ = 0x38383838; asm volatile("" : "+v"(k38_)); const v8i ones_ = {k38_, k38_, k38_, k38_, k38_, k38_, k38_, k38_};        \
          asm volatile("s_nop 1\n\tv_mfma_f32_32x32x64_f8f6f4 %0, %1, %2, %0" : "+v"(o[4]) : "v"(pa), "v"(ones_), "v"(scale1)); } SBAR(); } while (0)
    f32x16 pA0, pA1, pB0, pB1; float alA, alB; v8i pa; const int NT = seq / KVBLK;
    int s0 = 0, s1 = 1, s2 = 2;
#define ROT3() do { const int t_ = s0; s0 = s1; s1 = s2; s2 = t_; } while (0)
#define QKT8(P0, P1, Ks) do { const char* kb_ = (Ks); \
        _Pragma("unroll") for (int d0 = 0; d0 < 4; ++d0) { const int cb = (d0 * 16 + hi * 8) * 2; \
            const bf16x8 b0 = *reinterpret_cast<const bf16x8*>(kb_ + KSWZ64(r32, cb)); const bf16x8 b1 = *reinterpret_cast<const bf16x8*>(kb_ + KSWZ64(32 + r32, cb)); \
            if (d0 == 0) { P0 = __builtin_amdgcn_mfma_f32_32x32x16_bf16(b0, qr[0], cvec, 0, 0, 0); P1 = __builtin_amdgcn_mfma_f32_32x32x16_bf16(b1, qr[0], cvec, 0, 0, 0); } \
            else { P0 = __builtin_amdgcn_mfma_f32_32x32x16_bf16(b0, qr[d0], P0, 0, 0, 0); P1 = __builtin_amdgcn_mfma_f32_32x32x16_bf16(b1, qr[d0], P1, 0, 0, 0); } } } while (0)
    SLOAD(0); SWRITE(0); SLOAD(KVBLK); LBAR();
    QKT8(pA0, pA1, K_lds); REFUPD(pA0, pA1, alA, true);
    SWRITE(1); if (2 < NT) SLOAD(2 * KVBLK); LBAR();
#define STEP3(X0, X1, alX, Y0, Y1, j) do { \
        if ((j) + 1 < NT) SWRITE(s2); SBAR(); \
        if ((j) + 2 < NT) SLOAD(((j) + 2) * KVBLK); SBAR(); \
        QKT8(X0, X1, K_lds + s1 * SHM_K); \
        pack8x(Y0, Y1, pa); SBAR(); \
        PV5(V_lds + s0 * SHM_V8); \
        REFUPD(X0, X1, alX, false); \
        RESC(alX); LBAR(); ROT3(); } while (0)
    int j = 1;
    for (; j + 1 < NT; j += 2) {
        STEP3(pB0, pB1, alB, pA0, pA1, j);
        STEP3(pA0, pA1, alA, pB0, pB1, j + 1);
    }
    STEP3(pB0, pB1, alB, pA0, pA1, NT - 1);
    pack8x(pB0, pB1, pa); SBAR();
    PV5(V_lds + s0 * SHM_V8);
    asm volatile("s_nop 15\n\ts_nop 15\n\ts_nop 15\n\ts_nop 15\n\ts_nop 15\n\ts_nop 15" ::: "memory");
    asm volatile("" : "+v"(o[0]), "+v"(o[1]), "+v"(o[2]), "+v"(o[3]), "+v"(o[4]));
    bf16* Ow = Ob + (long)(wid * QBLK) * LDO;
#pragma unroll
    for (int r = 0; r < 16; ++r) { const int orow = crow(r, hi); const float rl = __builtin_amdgcn_rcpf(o[4][r]);
#pragma unroll
        for (int d0 = 0; d0 < 4; ++d0) Ow[(long)orow * LDO + d0 * 32 + r32] = (bf16)f2bf(o[d0][r] * rl); }
    LBAR();
#undef SLOAD
#undef SWRITE
#undef RESC
#undef LBAR
#undef REFUPD
#undef PV5
#undef QKT8
#undef ROT3
#undef STEP3
}
template <int N> struct VStage { typedef v4i T; };
template <> struct VStage<2> { typedef v2u T; };
template <int NDB, int KP, int LDO, bool SWA>
__device__ __forceinline__ void attn8(const unsigned char* __restrict__ Qb, const unsigned char* __restrict__ Kh, const unsigned char* __restrict__ Vt, bf16* __restrict__ Ob, const int NT, const int boff, const int qrow0, const float sinkl2, char* lds, const int wid) {
    const int lane = lane_id(), tid = wid * 64 + lane, r32 = lane & 31, hi = lane >> 5;
    constexpr int SHM_K8 = 64 * 80;
    constexpr int SHM_VT = 32 * NDB * 80;
    char* V_lds = lds; char* K_lds = lds + 4 * SHM_VT;
    float* ws = (float*)(lds + 4 * SHM_VT + 4 * SHM_K8) + wid * 64; float* al_l = ws + 32;
    f32x16 o[NDB + 1] = {}; v8i qf;
    f32x16 cvec; { _Pragma("unroll") for (int r = 0; r < 16; ++r) cvec[r] = 56.5f; }
    const int scale1 = 0x7F7F7F7F;
    { const unsigned char* Qw = Qb + (long)(wid * QBLK + r32) * 1024 + hi * 32; const v4i lo_ = *reinterpret_cast<const v4i*>(Qw), hh_ = *reinterpret_cast<const v4i*>(Qw + 16);
      qf = (v8i){lo_[0], lo_[1], lo_[2], lo_[3], hh_[0], hh_[1], hh_[2], hh_[3]}; }
    constexpr int VW = NDB * 4, VPR = 64 / VW;
    typedef typename VStage<NDB>::T vst_t;
    const int vcol = tid / VPR, vq = tid % VPR, vst = vcol * 80 + vq * VW;
    const unsigned char* vsrc = Vt + (long)vcol * RB + vq * VW;
    const int kr = tid >> 3, kst = kr * 80 + (tid & 7) * 8;
    const unsigned char* ksrc = Kh + (long)kr * KP + (tid & 7) * 8;
    vst_t vs0, vs1; v2u ks0, ks1;
#define TILE(t) (((t) < 4) ? (t) : ((t) + boff))
#define SLOADX(t, VS, KS) do { const int t_ = (t) < NT ? (t) : NT - 1; const int k0_ = TILE(t_) * KVBLK; VS = *reinterpret_cast<const vst_t*>(vsrc + k0_); KS = *reinterpret_cast<const v2u*>(ksrc + (long)k0_ * KP); } while (0)
#define SWRITEX(s, VS, KS) do { *(vst_t*)(V_lds + (s) * SHM_VT + vst) = VS; *(v2u*)(K_lds + (s) * SHM_K8 + kst) = KS; } while (0)
#define SLOAD(t) SLOADX(t, vs0, ks0)
#define SWRITE(s) SWRITEX(s, vs0, ks0)
#define RESC(a) do { if (__any((a) < 1.f)) { if (hi == 0) al_l[r32] = (a); asm volatile("s_waitcnt lgkmcnt(0)" ::: "memory"); \
    _Pragma("unroll") for (int d = 0; d < NDB + 1; ++d) _Pragma("unroll") for (int r = 0; r < 16; ++r) o[d][r] *= al_l[crow(r, hi)]; } } while (0)
#define LBAR() do { asm volatile("s_waitcnt lgkmcnt(0)" ::: "memory"); __builtin_amdgcn_s_barrier(); asm volatile("" ::: "memory"); } while (0)
#define REFUPD(X0, X1, alX, FIRST) do { float pmax_ = X0[0]; \
        _Pragma("unroll") for (int r = 1; r < 16; ++r) pmax_ = fmaxf(pmax_, X0[r]); \
        _Pragma("unroll") for (int r = 0; r < 16; ++r) pmax_ = fmaxf(pmax_, X1[r]); \
        { auto rr = __builtin_amdgcn_permlane32_swap(__float_as_uint(pmax_), __float_as_uint(pmax_), false, false); pmax_ = fmaxf(__uint_as_float(rr[0]), __uint_as_float(rr[1])); } \
        alX = 1.f; \
        if ((FIRST) || !__all(pmax_ <= 56.5f + 8.0f * THR)) { const float d8_ = (FIRST) ? pmax_ - 56.5f : fmaxf(pmax_ - 56.5f, 0.f); \
            _Pragma("unroll") for (int r = 0; r < 16; ++r) { X0[r] -= d8_; X1[r] -= d8_; cvec[r] -= d8_; } \
            alX = __builtin_amdgcn_exp2f(-0.125f * d8_); } } while (0)
    v8i vb[NDB], kf0, kf1;
#define VREAD(d0, Vs) do { const char* p_ = (Vs) + ((d0) * 32 + r32) * 80 + hi * 32; const v4i lo_ = *reinterpret_cast<const v4i*>(p_), hh_ = *reinterpret_cast<const v4i*>(p_ + 16); \
        vb[d0] = (v8i){lo_[0], lo_[1], lo_[2], lo_[3], hh_[0], hh_[1], hh_[2], hh_[3]}; } while (0)
#define KREAD(Ks) do { const char* kb_ = (Ks) + r32 * 80 + hi * 32; \
        const v4i a0_ = *reinterpret_cast<const v4i*>(kb_), a1_ = *reinterpret_cast<const v4i*>(kb_ + 16), b0_ = *reinterpret_cast<const v4i*>(kb_ + 32 * 80), b1_ = *reinterpret_cast<const v4i*>(kb_ + 32 * 80 + 16); \
        kf0 = (v8i){a0_[0], a0_[1], a0_[2], a0_[3], a1_[0], a1_[1], a1_[2], a1_[3]}; kf1 = (v8i){b0_[0], b0_[1], b0_[2], b0_[3], b1_[0], b1_[1], b1_[2], b1_[3]}; } while (0)
#define QKM(P0, P1) do { asm volatile("s_nop 1\n\tv_mfma_f32_32x32x64_f8f6f4 %0, %2, %4, %5\n\tv_mfma_f32_32x32x64_f8f6f4 %1, %3, %4, %5" \
                     : "=&v"(P0), "=&v"(P1) : "v"(kf0), "v"(kf1), "v"(qf), "v"(cvec), "v"(scale1)); SBAR(); } while (0)
#define PVM() do { asm volatile("s_nop 3" ::: "memory"); \
        _Pragma("unroll") for (int d0 = 0; d0 < NDB; ++d0) asm volatile("v_mfma_f32_32x32x64_f8f6f4 %0, %1, %2, %0" : "+v"(o[d0]) : "v"(pa), "v"(vb[d0]), "v"(scale1)); \
        { int k38_ = 0x38383838; asm volatile("" : "+v"(k38_)); const v8i ones_ = {k38_, k38_, k38_, k38_, k38_, k38_, k38_, k38_};        \
          asm volatile("s_nop 1\n\tv_mfma_f32_32x32x64_f8f6f4 %0, %1, %2, %0" : "+v"(o[NDB]) : "v"(pa), "v"(ones_), "v"(scale1)); } SBAR(); } while (0)
    f32x16 X0, X1; float al; v8i pa; unsigned pn[8];
    const int q0w = qrow0 + wid * QBLK, qrel = q0w + r32;
#define AMASK(X0, X1, t) do { if (SWA) { if ((t) >= 4) { const int kv0_ = 64 * TILE(t); if (!((kv0_ + 63 - q0w <= 128) && (q0w + 31 - kv0_ <= 128))) attn_body::wmask(X0, X1, kv0_ - qrel, hi); } } } while (0)
#define PVONE(d0) asm volatile("v_mfma_f32_32x32x64_f8f6f4 %0, %1, %2, %0" : "+v"(o[d0]) : "v"(pa), "v"(vb[d0]), "v"(scale1))
#define PVSUM() do { int k38_ = 0x38383838; asm volatile("" : "+v"(k38_)); const v8i ones_ = {k38_, k38_, k38_, k38_, k38_, k38_, k38_, k38_};        \
          asm volatile("s_nop 1\n\tv_mfma_f32_32x32x64_f8f6f4 %0, %1, %2, %0" : "+v"(o[NDB]) : "v"(pa), "v"(ones_), "v"(scale1)); } while (0)
#define PACKH(X, base) do { _Pragma("unroll") for (int g = 0; g < 4; ++g) { unsigned a_ = 0; _Pragma("unroll") for (int i = 0; i < 4; ++i) a_ = __builtin_amdgcn_cvt_pk_u8_f32(X[4 * g + i], i, a_); pn[(base) + g] = a_; } } while (0)
    int s0 = 0, s1 = 1, s2 = 2, s3 = 3;
#define ROT4() do { const int t_ = s0; s0 = s1; s1 = s2; s2 = s3; s3 = t_; } while (0)
    { vst_t vsA, vsB; v2u ksA, ksB;
      SLOADX(0, vs0, ks0); SLOADX(1, vsA, ksA); SLOADX(2, vsB, ksB); SBAR();
      SWRITEX(0, vs0, ks0); SWRITEX(1, vsA, ksA); SWRITEX(2, vsB, ksB); SBAR();
      SLOADX(3, vs0, ks0); SLOADX(4, vs1, ks1); LBAR(); }
    KREAD(K_lds); SBAR();
    QKM(X0, X1);
    KREAD(K_lds + SHM_K8); SBAR();
    asm volatile("s_nop 15\n\ts_nop 15\n\ts_nop 15\n\ts_nop 15\n\ts_nop 15\n\ts_nop 15\n\ts_nop 15\n\ts_nop 15\n\ts_nop 15" : "+v"(X0), "+v"(X1)); REFUPD(X0, X1, al, true);
    pack8x(X0, X1, pa); SBAR();
#define STEP5(j, VS, KS) do { \
        SBAR(); \
        _Pragma("unroll") for (int d0 = 0; d0 < NDB / 2; ++d0) VREAD(d0, V_lds + s0 * SHM_VT); \
        SBAR(); \
        SWRITEX(s3, VS, KS);                         \
        SBAR(); \
        SLOADX((j) + 4, VS, KS); \
        SBAR(); \
        QKM(X0, X1); \
        _Pragma("unroll") for (int d0 = NDB / 2; d0 < NDB; ++d0) VREAD(d0, V_lds + s0 * SHM_VT); \
        SBAR(); \
        asm volatile("s_nop 3" ::: "memory"); \
        _Pragma("unroll") for (int d0 = 0; d0 < NDB / 2; ++d0) PVONE(d0); \
        SBAR(); \
        if ((j) + 1 < NT) KREAD(K_lds + s2 * SHM_K8); \
        SBAR(); \
        AMASK(X0, X1, (j)); \
        float pmax_ = X0[0]; \
        _Pragma("unroll") for (int r = 1; r < 16; ++r) pmax_ = fmaxf(pmax_, X0[r]); \
        SBAR(); \
        PVONE(NDB / 2); \
        SBAR(); \
        _Pragma("unroll") for (int r = 0; r < 16; ++r) pmax_ = fmaxf(pmax_, X1[r]); \
        { auto rr = __builtin_amdgcn_permlane32_swap(__float_as_uint(pmax_), __float_as_uint(pmax_), false, false); pmax_ = fmaxf(__uint_as_float(rr[0]), __uint_as_float(rr[1])); } \
        al = 1.f; \
        if (!__all(pmax_ <= 56.5f + 8.0f * THR)) { const float d8_ = fmaxf(pmax_ - 56.5f, 0.f); \
            _Pragma("unroll") for (int r = 0; r < 16; ++r) { X0[r] -= d8_; X1[r] -= d8_; cvec[r] -= d8_; } \
            al = __builtin_amdgcn_exp2f(-0.125f * d8_); } \
        SBAR(); \
        if (NDB == 4) { PVONE(NDB - 1); SBAR(); } \
        PACKH(X0, 0); \
        asm volatile("" : "+v"(pn[0]), "+v"(pn[1]), "+v"(pn[2]), "+v"(pn[3])); \
        SBAR(); \
        PVSUM(); \
        SBAR(); \
        PACKH(X1, 4); \
        asm volatile("" : "+v"(pn[4]), "+v"(pn[5]), "+v"(pn[6]), "+v"(pn[7])); \
        SBAR(); \
        if (__any(al < 1.f)) { if (hi == 0) al_l[r32] = al; \
            asm volatile("s_nop 15\n\ts_nop 15\n\ts_nop 15\n\ts_nop 15\n\ts_nop 15\n\ts_nop 15\n\ts_nop 15\n\ts_nop 15\n\ts_waitcnt lgkmcnt(0)" ::: "memory"); \
            _Pragma("unroll") for (int d = 0; d < NDB + 1; ++d) asm volatile("" : "+v"(o[d])); \
            _Pragma("unroll") for (int d = 0; d < NDB + 1; ++d) _Pragma("unroll") for (int r = 0; r < 16; ++r) o[d][r] *= al_l[crow(r, hi)]; } \
        pa = (v8i){(int)pn[0], (int)pn[1], (int)pn[2], (int)pn[3], (int)pn[4], (int)pn[5], (int)pn[6], (int)pn[7]}; \
        LBAR(); ROT4(); \
    } while (0)
    { int j = 1;
      for (; j + 1 < NT; j += 2) { STEP5(j, vs0, ks0); STEP5(j + 1, vs1, ks1); }
      STEP5(NT - 1, vs0, ks0); }
    _Pragma("unroll") for (int d0 = 0; d0 < NDB; ++d0) VREAD(d0, V_lds + s0 * SHM_VT);
    SBAR();
    PVM();
    asm volatile("s_nop 15\n\ts_nop 15\n\ts_nop 15\n\ts_nop 15\n\ts_nop 15\n\ts_nop 15" ::: "memory");
    _Pragma("unroll") for (int d = 0; d < NDB + 1; ++d) asm volatile("" : "+v"(o[d]));
    if (SWA) { if (hi == 0) ws[r32] = sinkl2 - (56.5f - cvec[0]) * 0.125f; asm volatile("s_waitcnt lgkmcnt(0)" ::: "memory");
        _Pragma("unroll") for (int r = 0; r < 16; ++r) o[NDB][r] += __builtin_amdgcn_exp2f(ws[crow(r, hi)]); }
    bf16* Ow = Ob + (long)(wid * QBLK) * LDO;
#pragma unroll
    for (int r = 0; r < 16; ++r) { const int orow = crow(r, hi); const float rl = __builtin_amdgcn_rcpf(o[NDB][r]);
#pragma unroll
        for (int d0 = 0; d0 < NDB; ++d0) Ow[(long)orow * LDO + d0 * 32 + r32] = (bf16)f2bf(o[d0][r] * rl); }
    LBAR();
#undef SLOAD
#undef SLOADX
#undef TILE
#undef AMASK
#undef SWRITE
#undef SWRITEX
#undef RESC
#undef LBAR
#undef REFUPD
#undef PVM
#undef QKM
#undef VREAD
#undef KREAD
#undef ROT4
#undef PVONE
#undef STEP5
#undef PVSUM
#undef PACKH
}
__device__ __forceinline__ void attn_swa_grp(const unsigned char* __restrict__ Qg, const unsigned char* __restrict__ Kh, const bf16* __restrict__ Vr, bf16* __restrict__ Og, const float* __restrict__ sinks8,
                                             const int NT, const int boff, const int qrow0, char* lds, const int wid) {
    constexpr int NDB = 2, SHM = 64 * 80, MAXT = 12;
    const int lane = lane_id(), tid = wid * 64 + lane, r32 = lane & 31, hi = lane >> 5;
    char* V_lds = lds; char* K_lds = lds + MAXT * SHM;
    float* ws = (float*)(lds + 2 * MAXT * SHM) + wid * 64; float* al_l = ws + 32;
#define TILE(t) (((t) < 4) ? (t) : ((t) + boff))
    { v4i kst[6];
#pragma unroll
      for (int i = 0; i < 6; ++i) { const int T = tid + 512 * i, t = T >> 8, rw = (T & 255) >> 2, ch = T & 3; const int tt = t < NT ? t : NT - 1;
          kst[i] = *reinterpret_cast<const v4i*>(Kh + ((long)TILE(tt) * 64 + rw) * 128 + ch * 16); }
      v4u vst[3][4];
#pragma unroll
      for (int i = 0; i < 3; ++i) { const int T = tid + 512 * i, t = T >> 7, g = (T & 127) >> 3, c = T & 7; const int tt = t < NT ? t : NT - 1;
          const bf16* vp = Vr + ((long)TILE(tt) * 64 + 4 * g) * N_QKV1 + 8 * c;
#pragma unroll
          for (int q = 0; q < 4; ++q) vst[i][q] = *reinterpret_cast<const v4u*>(vp + (long)q * N_QKV1); }
#pragma unroll
      for (int i = 0; i < 6; ++i) { const int T = tid + 512 * i, t = T >> 8, rw = (T & 255) >> 2, ch = T & 3; *reinterpret_cast<v4i*>(K_lds + t * SHM + rw * 80 + ch * 16) = kst[i]; }
#pragma unroll
      for (int i = 0; i < 3; ++i) { const int T = tid + 512 * i, t = T >> 7, g = (T & 127) >> 3, c = T & 7; char* vd = V_lds + t * SHM + (8 * c) * 80 + vt8_slot(4 * g);
#pragma unroll
          for (int w = 0; w < 4; ++w) {
              const unsigned lo = (unsigned)cvt4_fp8(bf2f(vst[i][0][w] & 0xffffu), bf2f(vst[i][1][w] & 0xffffu), bf2f(vst[i][2][w] & 0xffffu), bf2f(vst[i][3][w] & 0xffffu));
              const unsigned hh = (unsigned)cvt4_fp8(bf2f(vst[i][0][w] >> 16), bf2f(vst[i][1][w] >> 16), bf2f(vst[i][2][w] >> 16), bf2f(vst[i][3][w] >> 16));
              *reinterpret_cast<unsigned*>(vd + (2 * w) * 80) = lo; *reinterpret_cast<unsigned*>(vd + (2 * w + 1) * 80) = hh; } }
      asm volatile("s_waitcnt lgkmcnt(0)" ::: "memory"); __builtin_amdgcn_s_barrier(); asm volatile("" ::: "memory"); }
    const int q0w = qrow0 + wid * QBLK, qrel = q0w + r32;
    int tlo = ((q0w - 191 + 63) >> 6) - boff, thi = ((q0w + 159) >> 6) - boff; if (tlo < 4) tlo = 4; if (thi > NT - 1) thi = NT - 1;
    const int NTw = 4 + (thi >= tlo ? thi - tlo + 1 : 0);
#define SEQ(j) (((j) < 4) ? (j) : ((j) - 4 + tlo))
    v8i vb[NDB], kf0, kf1;
#define VREAD(d0, Vs) do { const char* p_ = (Vs) + ((d0) * 32 + r32) * 80 + hi * 32; const v4i lo_ = *reinterpret_cast<const v4i*>(p_), hh_ = *reinterpret_cast<const v4i*>(p_ + 16); \
        vb[d0] = (v8i){lo_[0], lo_[1], lo_[2], lo_[3], hh_[0], hh_[1], hh_[2], hh_[3]}; } while (0)
#define KREAD(Ks) do { const char* kb_ = (Ks) + r32 * 80 + hi * 32; \
        const v4i a0_ = *reinterpret_cast<const v4i*>(kb_), a1_ = *reinterpret_cast<const v4i*>(kb_ + 16), b0_ = *reinterpret_cast<const v4i*>(kb_ + 32 * 80), b1_ = *reinterpret_cast<const v4i*>(kb_ + 32 * 80 + 16); \
        kf0 = (v8i){a0_[0], a0_[1], a0_[2], a0_[3], a1_[0], a1_[1], a1_[2], a1_[3]}; kf1 = (v8i){b0_[0], b0_[1], b0_[2], b0_[3], b1_[0], b1_[1], b1_[2], b1_[3]}; } while (0)
#define AMASK(t) do { if ((t) >= 4) { const int kv0_ = 64 * TILE(t); if (!((kv0_ + 63 - q0w <= 128) && (q0w + 31 - kv0_ <= 128))) attn_body::wmask(X0, X1, kv0_ - qrel, hi); } } while (0)
    const unsigned char* Qw0 = Qg + (long)(wid * QBLK + r32) * 1024 + hi * 32;
    v4i qnl = *reinterpret_cast<const v4i*>(Qw0), qnh = *reinterpret_cast<const v4i*>(Qw0 + 16);
#pragma unroll 1
    for (int hh = 0; hh < 8; ++hh) {
        bf16* Ob = Og + hh * 64;
        f32x16 o[NDB + 1] = {}; v8i qf;
        f32x16 cvec; { _Pragma("unroll") for (int r = 0; r < 16; ++r) cvec[r] = 56.5f; }
        qf = (v8i){qnl[0], qnl[1], qnl[2], qnl[3], qnh[0], qnh[1], qnh[2], qnh[3]};
        { const unsigned char* Qn = Qw0 + (hh < 7 ? hh + 1 : 7) * 64; qnl = *reinterpret_cast<const v4i*>(Qn); qnh = *reinterpret_cast<const v4i*>(Qn + 16); }
#define QKM(P0, P1) do { asm volatile("s_nop 1\n\tv_mfma_f32_32x32x64_f8f6f4 %0, %2, %4, %5\n\tv_mfma_f32_32x32x64_f8f6f4 %1, %3, %4, %5" \
                     : "=&v"(P0), "=&v"(P1) : "v"(kf0), "v"(kf1), "v"(qf), "v"(cvec)); SBAR(); } while (0)
#define PVONE(d0) asm volatile("v_mfma_f32_32x32x64_f8f6f4 %0, %1, %2, %0" : "+v"(o[d0]) : "v"(pa), "v"(vb[d0]))
#define PVSUM() do { int k38_ = 0x38383838; asm volatile("" : "+v"(k38_)); const v8i ones_ = {k38_, k38_, k38_, k38_, k38_, k38_, k38_, k38_}; \
          asm volatile("s_nop 1\n\tv_mfma_f32_32x32x64_f8f6f4 %0, %1, %2, %0" : "+v"(o[NDB]) : "v"(pa), "v"(ones_)); } while (0)
#define PACKH(X, base) do { _Pragma("unroll") for (int g = 0; g < 4; ++g) { unsigned a_ = 0; _Pragma("unroll") for (int i = 0; i < 4; ++i) a_ = __builtin_amdgcn_cvt_pk_u8_f32(X[4 * g + i], i, a_); pn[(base) + g] = a_; } } while (0)
        f32x16 X0, X1; float al; v8i pa; unsigned pn[8];
        KREAD(K_lds); SBAR();
        QKM(X0, X1);
        KREAD(K_lds + SHM); SBAR();
        asm volatile("s_nop 15\n\ts_nop 15\n\ts_nop 15\n\ts_nop 15\n\ts_nop 15\n\ts_nop 15\n\ts_nop 15\n\ts_nop 15\n\ts_nop 15" : "+v"(X0), "+v"(X1));
        { float pmax_ = X0[0];
          _Pragma("unroll") for (int r = 1; r < 16; ++r) pmax_ = fmaxf(pmax_, X0[r]);
          _Pragma("unroll") for (int r = 0; r < 16; ++r) pmax_ = fmaxf(pmax_, X1[r]);
          { auto rr = __builtin_amdgcn_permlane32_swap(__float_as_uint(pmax_), __float_as_uint(pmax_), false, false); pmax_ = fmaxf(__uint_as_float(rr[0]), __uint_as_float(rr[1])); }
          const float d8_ = pmax_ - 56.5f;
          _Pragma("unroll") for (int r = 0; r < 16; ++r) { X0[r] -= d8_; X1[r] -= d8_; cvec[r] -= d8_; } }
        pack8x(X0, X1, pa); SBAR();
#pragma unroll 1
        for (int j = 1; j < NTw; ++j) {
            const char* Vs = V_lds + SEQ(j - 1) * SHM;
            SBAR();
            VREAD(0, Vs);
            SBAR();
            QKM(X0, X1);
            VREAD(1, Vs);
            SBAR();
            asm volatile("s_nop 3" ::: "memory");
            PVONE(0);
            SBAR();
            if (j + 1 < NTw) KREAD(K_lds + SEQ(j + 1) * SHM);
            SBAR();
            AMASK(SEQ(j));
            float pmax_ = X0[0];
            _Pragma("unroll") for (int r = 1; r < 16; ++r) pmax_ = fmaxf(pmax_, X0[r]);
            SBAR();
            PVONE(1);
            SBAR();
            _Pragma("unroll") for (int r = 0; r < 16; ++r) pmax_ = fmaxf(pmax_, X1[r]);
            { auto rr = __builtin_amdgcn_permlane32_swap(__float_as_uint(pmax_), __float_as_uint(pmax_), false, false); pmax_ = fmaxf(__uint_as_float(rr[0]), __uint_as_float(rr[1])); }
            al = 1.f;
            if (!__all(pmax_ <= 56.5f + 8.0f * THR)) { const float d8_ = fmaxf(pmax_ - 56.5f, 0.f);
                _Pragma("unroll") for (int r = 0; r < 16; ++r) { X0[r] -= d8_; X1[r] -= d8_; cvec[r] -= d8_; }
                al = __builtin_amdgcn_exp2f(-0.125f * d8_); }
            SBAR();
            PACKH(X0, 0);
            asm volatile("" : "+v"(pn[0]), "+v"(pn[1]), "+v"(pn[2]), "+v"(pn[3]));
            SBAR();
            PVSUM();
            SBAR();
            PACKH(X1, 4);
            asm volatile("" : "+v"(pn[4]), "+v"(pn[5]), "+v"(pn[6]), "+v"(pn[7]));
            SBAR();
            if (__any(al < 1.f)) { if (hi == 0) al_l[r32] = al;
                asm volatile("s_nop 15\n\ts_nop 15\n\ts_nop 15\n\ts_nop 15\n\ts_nop 15\n\ts_nop 15\n\ts_nop 15\n\ts_nop 15\n\ts_waitcnt lgkmcnt(0)" ::: "memory");
                _Pragma("unroll") for (int d = 0; d < NDB + 1; ++d) asm volatile("" : "+v"(o[d]));
                _Pragma("unroll") for (int d = 0; d < NDB + 1; ++d) _Pragma("unroll") for (int r = 0; r < 16; ++r) o[d][r] *= al_l[crow(r, hi)]; }
            pa = (v8i){(int)pn[0], (int)pn[1], (int)pn[2], (int)pn[3], (int)pn[4], (int)pn[5], (int)pn[6], (int)pn[7]};
        }
        { const char* Vs = V_lds + SEQ(NTw - 1) * SHM; VREAD(0, Vs); VREAD(1, Vs); }
        SBAR();
        asm volatile("s_nop 3" ::: "memory");
        PVONE(0); PVONE(1); PVSUM(); SBAR();
        asm volatile("s_nop 15\n\ts_nop 15\n\ts_nop 15\n\ts_nop 15\n\ts_nop 15\n\ts_nop 15" ::: "memory");
        _Pragma("unroll") for (int d = 0; d < NDB + 1; ++d) asm volatile("" : "+v"(o[d]));
        { const float sinkl2 = sinks8[hh] * LOG2E;
          if (hi == 0) ws[r32] = sinkl2 - (56.5f - cvec[0]) * 0.125f; asm volatile("s_waitcnt lgkmcnt(0)" ::: "memory");
          _Pragma("unroll") for (int r = 0; r < 16; ++r) o[NDB][r] += __builtin_amdgcn_exp2f(ws[crow(r, hi)]); }
        bf16* Ow = Ob + (long)(wid * QBLK) * D;
        { const bool odd = (lane & 1) != 0;
#pragma unroll
          for (int r = 0; r < 16; r += 2) { const float rl0 = __builtin_amdgcn_rcpf(o[NDB][r]), rl1 = __builtin_amdgcn_rcpf(o[NDB][r + 1]);
              const int orow = crow(odd ? r + 1 : r, hi);
#pragma unroll
              for (int d0 = 0; d0 < NDB; ++d0) { const float v0 = o[d0][r] * rl0, v1 = o[d0][r + 1] * rl1;
                  const float got = __int_as_float(__builtin_amdgcn_update_dpp(0, __float_as_int(odd ? v0 : v1), 0xB1, 0xF, 0xF, false));
                  if (OUT_FP8) { const unsigned w8 = (unsigned)(odd ? cvt4_fp8(got * OUT_ASC, v1 * OUT_ASC, 0.f, 0.f) : cvt4_fp8(v0 * OUT_ASC, got * OUT_ASC, 0.f, 0.f));
                      *reinterpret_cast<unsigned short*>((unsigned char*)Og + hh * 64 + (long)(wid * QBLK + orow) * D + d0 * 32 + (r32 & ~1)) = (unsigned short)(w8 & 0xffffu); }
                  else { const unsigned w = odd ? cvt_pk_bf16(got, v1) : cvt_pk_bf16(v0, got);
                      *reinterpret_cast<unsigned*>(&Ow[(long)orow * D + d0 * 32 + (r32 & ~1)]) = w; } } } }
        asm volatile("s_waitcnt lgkmcnt(0)" ::: "memory");
#undef QKM
#undef PVONE
#undef PVSUM
#undef PACKH
    }
    asm volatile("s_waitcnt lgkmcnt(0)" ::: "memory"); __builtin_amdgcn_s_barrier(); asm volatile("" ::: "memory");
#undef TILE
#undef VREAD
#undef KREAD
#undef AMASK
#undef SEQ
}
#undef SBAR
#undef KSWZ64
}

#define XB_TMO      128
#define XB_XCNT(j)  (256  + 64 * (j))
#define XB_XSUB(j)  (1280 + 64 * (j))
#define XB_XGEN(j)  (2304 + 64 * (j))
#define XB_TOP      3328
#define XB_TOPGEN   3392
#define XCD_BAR_WORDS 3456
#define XB_SPIN_CAP (1u << 18)
__device__ __forceinline__ unsigned xb_ld(unsigned* p)              { return __hip_atomic_load(p, __ATOMIC_RELAXED, __HIP_MEMORY_SCOPE_AGENT); }
__device__ __forceinline__ unsigned xb_add(unsigned* p, unsigned v) { return __hip_atomic_fetch_add(p, v, __ATOMIC_RELAXED, __HIP_MEMORY_SCOPE_AGENT); }
__device__ __forceinline__ unsigned xb_xcc_id() { return (unsigned)__builtin_amdgcn_s_getreg((3 << 11) | 20) & 0xFu; }
#define XB_SPIN(cond, bar) do { unsigned _sp = 0; while (cond) { __builtin_amdgcn_s_sleep(1); \
    if ((++_sp & 255u) == 0u) { if (xb_ld(&(bar)[XB_TMO])) break; if (_sp > XB_SPIN_CAP) { atomicAdd(&(bar)[XB_TMO], 1u); break; } } } } while (0)
struct XcdBarrier { unsigned* bar; unsigned x; volatile LAS unsigned* st; int wave; };
__device__ __forceinline__ XcdBarrier xcd_barrier_post(unsigned* bar, volatile LAS unsigned* st) {
    XcdBarrier b; b.bar = bar; b.x = xb_xcc_id(); b.st = st; b.wave = 0;
    if (threadIdx.x == 0) (void)xb_add(&bar[XB_XCNT(b.x)], 1u);
    return b;
}
__device__ __forceinline__ void xcd_barrier_complete(unsigned* bar, unsigned x, unsigned& nloc, unsigned& nx) {
    const unsigned G = gridDim.x * gridDim.y * gridDim.z;
    unsigned sum, cnt, mine, sp = 0u;
    for (;;) {
        sum = 0u; cnt = 0u; mine = 0u;
#pragma unroll
        for (unsigned j = 0; j < 16; ++j) { const unsigned c = xb_ld(&bar[XB_XCNT(j)]); sum += c; cnt += (c > 0u) ? 1u : 0u; mine = (j == x) ? c : mine; }
        if (sum == G) break;
        __builtin_amdgcn_s_sleep(1);
        if ((++sp & 255u) == 0u) { if (xb_ld(&bar[XB_TMO])) break; if (sp > XB_SPIN_CAP) { atomicAdd(&bar[XB_TMO], 1u); break; } }
    }
    nloc = mine > 0u ? mine : 1u; nx = cnt > 0u ? cnt : 1u;
}
__device__ __forceinline__ void xcd_barrier(const XcdBarrier& b) {
    asm volatile("s_waitcnt vmcnt(0)" ::: "memory");
    __syncthreads();
    if (b.wave == 0 && lane_id() == 0) {
        unsigned* bar = b.bar;
        __builtin_amdgcn_s_waitcnt(0);
        unsigned nloc = b.st[0], nx = b.st[1];
        if (nloc == 0u) { xcd_barrier_complete(bar, b.x, nloc, nx); b.st[0] = nloc; b.st[1] = nx; }
        const unsigned gen = b.st[2] + 1u; b.st[2] = gen;
        const unsigned old = xb_add(&bar[XB_XSUB(b.x)], 1u);
        if (old + 1u == gen * nloc) {
            __builtin_amdgcn_fence(__ATOMIC_RELEASE, "agent");
            asm volatile("s_waitcnt vmcnt(0)" ::: "memory");
            (void)xb_add(&bar[XB_TOP], 1u);
        }
        XB_SPIN(xb_ld(&bar[XB_TOP]) < gen * nx, bar);
        __builtin_amdgcn_fence(__ATOMIC_ACQUIRE, "agent");
        asm volatile("s_waitcnt vmcnt(0)" ::: "memory");
    }
    __syncthreads();
}

constexpr int NWAVES = 8;
struct Args { const float* in[24]; float* out; unsigned char* ws; int ph_lo, ph_hi; };
typedef __attribute__((address_space(4))) const Args* kargs_t;
__device__ __forceinline__ kargs_t kargs() { kargs_t p = (kargs_t)__builtin_amdgcn_kernarg_segment_ptr(); asm volatile("" : "+s"(p)); return p; }
struct Frame {
    LAS unsigned char* lds;
    volatile LAS unsigned* MISC;
    int tid, lane, wave;
    int vcu, G;
    __device__ __forceinline__ const float* in(int k) const { return kargs()->in[k]; }
    __device__ __forceinline__ unsigned char* ws() const { return kargs()->ws; }
    __device__ __forceinline__ gu32* ctl() const { return (gu32*)(ws() + WS_CTL); }
#define FIN(name, k) __device__ __forceinline__ const float* name() const { return in(k); }
    FIN(x, 0) FIN(c, 1) FIN(ctx, 2) FIN(c_ctx, 3) FIN(mod_w, 4) FIN(mod_b, 5) FIN(norm1_w, 6) FIN(norm2_w, 7) FIN(w_in, 8) FIN(w_out0, 9) FIN(diff_lam, 10) FIN(diff_norm_w, 11)
    FIN(ret_decay, 12) FIN(ret_norm_w, 13) FIN(w_qkv1, 14) FIN(w_out1, 15) FIN(sinks, 16) FIN(router_w, 17) FIN(router_b, 18) FIN(moe_w1, 19) FIN(moe_b1, 20) FIN(moe_w2, 21) FIN(moe_b2, 22) FIN(final_norm_w, 23)
#undef FIN
    __device__ __forceinline__ float* out() const { return kargs()->out; }
#define FWS(type, name, off) __device__ __forceinline__ type* name() const { return (type*)(ws() + off); }
    FWS(float, MODP, WS_MODP) FWS(float, MOD, WS_MOD) FWS(bf16, H, WS_H) FWS(float, GATE, WS_GATE) FWS(float, CKV, WS_CKV) FWS(int, LIST, WS_LIST) FWS(int, POS, WS_POS)
    FWS(bf16, WIN, WS_WIN) FWS(bf16, WOUT0, WS_WOUT0) FWS(bf16, WQKV1, WS_WQKV1) FWS(bf16, WOUT1, WS_WOUT1) FWS(bf16, A, WS_A) FWS(bf16, QKV, WS_QKV) FWS(bf16, OD, WS_OD) FWS(bf16, CAT, WS_CAT)
    FWS(bf16, RVT, WS_RVT) FWS(bf16, RKT, WS_RKT) FWS(unsigned char, K81, WS_K81) FWS(unsigned char, VT81, WS_VT81) FWS(unsigned char, QK8, WS_QK8) FWS(unsigned char, VT8, WS_VT8) FWS(bf16, PREV, WS_PREV) FWS(bf16, ACT, WS_ACT) FWS(bf16, Y, WS_Y) FWS(bf16, W1T, WS_W1T) FWS(bf16, W2T, WS_W2T)
#undef FWS
};
__device__ __forceinline__ void phase_ids(Frame& F) { int l = lane_id(); asm volatile("" : "+v"(l)); F.lane = l; F.tid = F.wave * 64 + l; }
__device__ __forceinline__ int row_v(int r) { const int b = r / RB; return (r - b * RB) < CTXL ? 4 : b; }

__device__ __forceinline__ void p0_transpose_item(const float* W, int N, int K, bf16* wt_row0, float scale, LAS float* scr, int k0, int n0, int lane) {
    float v[32];
#pragma unroll
    for (int i = 0; i < 32; ++i) { const int kk = 2 * i + (lane >> 5); v[i] = W[(size_t)(k0 + kk) * N + n0 + (lane & 31)]; }
#pragma unroll
    for (int i = 0; i < 32; ++i) { const int kk = 2 * i + (lane >> 5); scr[kk * 33 + (lane & 31)] = v[i] * scale; }
    LDS_WAIT(); asm volatile("" ::: "memory");
    const int c = lane & 7;
#pragma unroll
    for (int j = 0; j < 4; ++j) { const int n = (lane >> 3) + 8 * j; const LAS float* s = scr + (8 * c) * 33 + n;
        v4u o; o.x = pk2(s[0 * 33], s[1 * 33]); o.y = pk2(s[2 * 33], s[3 * 33]); o.z = pk2(s[4 * 33], s[5 * 33]); o.w = pk2(s[6 * 33], s[7 * 33]);
        *(GAS v4u*)(wt_row0 + (size_t)n * K + k0 + 8 * c) = o; }
    LDS_WAIT(); asm volatile("" ::: "memory");
}
__device__ __forceinline__ void p0_transpose_item8(const float* W, int N, int K, unsigned char* wt_row0, float scale, LAS float* scr, int k0, int n0, int lane) {
    float v[32];
#pragma unroll
    for (int i = 0; i < 32; ++i) { const int kk = 2 * i + (lane >> 5); v[i] = W[(size_t)(k0 + kk) * N + n0 + (lane & 31)]; }
#pragma unroll
    for (int i = 0; i < 32; ++i) { const int kk = 2 * i + (lane >> 5); scr[kk * 33 + (lane & 31)] = v[i] * scale; }
    LDS_WAIT(); asm volatile("" ::: "memory");
    const int c = lane & 7;
#pragma unroll
    for (int j = 0; j < 4; ++j) { const int n = (lane >> 3) + 8 * j; const LAS float* s = scr + (8 * c) * 33 + n;
        v2u o; o.x = (unsigned)cvt4_fp8(s[0 * 33], s[1 * 33], s[2 * 33], s[3 * 33]); o.y = (unsigned)cvt4_fp8(s[4 * 33], s[5 * 33], s[6 * 33], s[7 * 33]);
        *(GAS v2u*)(wt_row0 + (size_t)n * K + k0 + 8 * c) = o; }
    LDS_WAIT(); asm volatile("" ::: "memory");
}
namespace p0i {
constexpr int I_IN = 16 * (N_IN0 / 32), I_O = 16 * 32, I_QKV = 16 * (N_QKV1 / 32);
constexpr int I_SMALL = I_IN + I_O + I_QKV + I_O;
constexpr int I_W1 = 16 * 64, I_W2 = 16 * 32, I_EXP = I_W1 + I_W2;
constexpr int NITEMS = I_SMALL + 2 * NEXP * I_EXP;
constexpr int Q3 = 6, Q8 = 6, Q13 = 3;
constexpr int U3 = MT * (N_IN0 / 256), U8 = MT * (D / 256), U13 = MT * (N_QKV1 / 256);
__device__ __forceinline__ int short_wgs(int units, int G) { const int r = units % G; return r ? G - r : 0; }
__device__ __forceinline__ int deferred(int G) { return NWAVES * (short_wgs(U3, G) * Q3 + short_wgs(U8, G) * Q8 + short_wgs(U13, G) * Q13); }
}
__device__ __forceinline__ void p0_do_item(Frame& F, int it, LAS float* scr) {
    using namespace p0i;
    int r = it;
        if (r < I_IN) { const int nb = r % (N_IN0 / 32), kb = r / (N_IN0 / 32), n0 = nb * 32; const float sc = (n0 < 512) ? C2 * (ATTN_FASTEXP ? 8.0f : 1.0f) : ((n0 >= C_RQ && n0 < C_RK) ? 0.125f : 1.0f);
            p0_transpose_item(F.w_in(), N_IN0, D, F.WIN() + (size_t)n0 * D, sc, scr, kb * 64, n0, F.lane); return; } r -= I_IN;
        if (r < I_O) { const int nb = r % 32, kb = r / 32; if (OUT_FP8) p0_transpose_item8(F.w_out0(), D, D, (unsigned char*)F.WOUT0() + (size_t)nb * 32 * D, W8_SCALE, scr, kb * 64, nb * 32, F.lane); else p0_transpose_item(F.w_out0(), D, D, F.WOUT0() + (size_t)nb * 32 * D, 1.0f, scr, kb * 64, nb * 32, F.lane); return; } r -= I_O;
        if (r < I_QKV) { const int nb = r % (N_QKV1 / 32), kb = r / (N_QKV1 / 32), n0 = nb * 32; const float sc = (n0 < 1024) ? C2 * (SWA_FP8 ? 8.0f : 1.0f) : 1.0f;
            if (QKV1_FP8) p0_transpose_item8(F.w_qkv1(), N_QKV1, D, (unsigned char*)F.WQKV1() + (size_t)n0 * D, sc * W8_SCALE, scr, kb * 64, n0, F.lane);
            else p0_transpose_item(F.w_qkv1(), N_QKV1, D, F.WQKV1() + (size_t)n0 * D, sc, scr, kb * 64, n0, F.lane); return; } r -= I_QKV;
        if (r < I_O) { const int nb = r % 32, kb = r / 32; if (OUT_FP8) p0_transpose_item8(F.w_out1(), D, D, (unsigned char*)F.WOUT1() + (size_t)nb * 32 * D, W8_SCALE, scr, kb * 64, nb * 32, F.lane); else p0_transpose_item(F.w_out1(), D, D, F.WOUT1() + (size_t)nb * 32 * D, 1.0f, scr, kb * 64, nb * 32, F.lane); return; } r -= I_O;
        const int le = r / I_EXP; r -= le * I_EXP;
        if (r < I_W1) { const int nb = r % 64, kb = r / 64, n0 = nb * 32;
            const int nn = n0 & 1023, drow = (nn >> 7) * 256 + (n0 >= 1024 ? 128 : 0) + (nn & 127);
            p0_transpose_item8(F.moe_w1() + (size_t)le * D * 2048, 2048, D, (unsigned char*)F.W1T() + ((size_t)le * 2048 + drow) * D, W8_SCALE, scr, kb * 64, n0, F.lane); return; } r -= I_W1;
        { const int nb = r % 32, kb = r / 32; p0_transpose_item8(F.moe_w2() + (size_t)le * DFF * D, D, DFF, (unsigned char*)F.W2T() + ((size_t)le * D + nb * 32) * DFF, W8_SCALE, scr, kb * 64, nb * 32, F.lane); }
}
__device__ __forceinline__ void p0_tail_items(Frame& F, int units, int Q, int base) {
    const int rem = units % F.G; if (rem == 0 || (int)blockIdx.x < rem) return;
    phase_ids(F);
    LAS float* scr = (LAS float*)(F.lds + F.wave * 16384);
    const int k = ((int)blockIdx.x - rem) * NWAVES + F.wave;
    for (int q = 0; q < Q; ++q) p0_do_item(F, base + k * Q + q, scr);
}
__device__ __forceinline__ void p0_prologue(Frame& F) {
    {
        LAS float* sl = (LAS float*)F.lds;
        const float* cvec = F.c(); const float* cctx = F.c_ctx(); const float* modw = F.mod_w(); float* MODPp = F.MODP(); gu32* ctlp = F.ctl(); const float* modb = F.mod_b(); float* MODo = F.MOD();
        for (int it = blockIdx.x; it < 2 * 16 * 12; it += F.G) {
            const int nc = it % 12, kc = (it / 12) % 16, l = it / (12 * 16);
            __syncthreads();
            if (F.tid < 320) { const int v = F.tid / 64, k = kc * 64 + (F.tid & 63); const float cv = (v < 4) ? cvec[v * D + k] : cctx[k]; sl[F.tid] = cv * sigmoidf_(cv); }
            __syncthreads();
            const int n = nc * 512 + F.tid;
            const float* wp = modw + ((size_t)l * D + kc * 64) * 6144 + n;
            float a0 = 0.f, a1 = 0.f, a2 = 0.f, a3 = 0.f, a4 = 0.f;
#pragma unroll 16
            for (int k = 0; k < 64; ++k) { const float w = wp[(size_t)k * 6144]; a0 += sl[k] * w; a1 += sl[64 + k] * w; a2 += sl[128 + k] * w; a3 += sl[192 + k] * w; a4 += sl[256 + k] * w; }
            float* o = MODPp + ((size_t)(kc * 2 + l) * 5) * 6144 + n;
            o[0] = a0; o[6144] = a1; o[2 * 6144] = a2; o[3 * 6144] = a3; o[4 * 6144] = a4;
        }
        __syncthreads();
    }
    const int gw = F.vcu * NWAVES + F.wave, NGW = F.G * NWAVES;
    LAS float* scr = (LAS float*)(F.lds + F.wave * 16384);
    const int nhere = p0i::NITEMS - p0i::deferred(F.G);
    for (int it = gw; it < nhere; it += NGW) p0_do_item(F, it, scr);
}
__device__ __forceinline__ void p1_mod_reduce(Frame& F) {
    const float* mb = F.mod_b(); const float* mp = F.MODP(); float* mo = F.MOD();
    for (int i = blockIdx.x * 512 + F.tid; i < 2 * 5 * 6144; i += F.G * 512) {
        const int n = i % 6144, l = i / (5 * 6144);
        float s = mb[l * 6144 + n];
#pragma unroll
        for (int kc = 0; kc < 16; ++kc) s += mp[(size_t)kc * (2 * 5 * 6144) + i];
        mo[i] = s;
    }
}

__device__ __forceinline__ void norm_mod_row(const f32x4 (&h)[4], const float* nw, const float* sc, const float* sh, bf16* orow, int lane, bool fp8out = false) {
    float s = 0.f;
#pragma unroll
    for (int j = 0; j < 4; ++j) s += (h[j].x * h[j].x + h[j].y * h[j].y) + (h[j].z * h[j].z + h[j].w * h[j].w);
    const float rs = 1.0f / sqrtf(wave_sum(s) * (1.0f / D) + EPS);
    GAS v2u* o8 = (GAS v2u*)orow + lane;
#pragma unroll
    for (int j = 0; j < 4; ++j) {
        const f32x4 w = ((const GAS f32x4*)nw)[lane + 64 * j], a = ((const GAS f32x4*)sc)[lane + 64 * j], b = ((const GAS f32x4*)sh)[lane + 64 * j];
        const f32x4 y = h[j] * rs * w * (1.0f + a) + b;
        if (fp8out) ((GAS unsigned*)orow)[lane + 64 * j] = (unsigned)cvt4_fp8(y.x, y.y, y.z, y.w);
        else { v2u o; o.x = pk2(y.x, y.y); o.y = pk2(y.z, y.w); o8[64 * j] = o; }
    }
}
__device__ __forceinline__ void p_norm1(Frame& F, int layer) {
    const int gw = F.vcu * NWAVES + F.wave, NGW = F.G * NWAVES;
    const float* MODp = F.MOD(); const float* xin = F.x(); const float* cin = F.ctx(); bf16* Ap = F.A(); const float* n1w = F.norm1_w() + layer * D;
    for (int r = gw; r < M; r += NGW) {
        const int v = row_v(r); const float* mod = MODp + ((size_t)layer * 5 + v) * 6144;
        const int b = r / RB, p = r - b * RB;
        const float* src = (p < CTXL) ? cin + ((size_t)b * CTXL + p) * D : xin + ((size_t)b * SEQ + (p - CTXL)) * D;
        f32x4 h[4]; const GAS f32x4* hp = (const GAS f32x4*)src + F.lane;
#pragma unroll
        for (int j = 0; j < 4; ++j) h[j] = hp[64 * j];
        norm_mod_row(h, n1w, mod + 1024, mod, Ap + (size_t)r * D, F.lane);
    }
}
template <int PITCH, int NHEADS>
__device__ __forceinline__ void p_rope(Frame& F, bf16* buf) {
    const int gw = F.vcu * NWAVES + F.wave, NGW = F.G * NWAVES;
    for (int i = gw; i < NB * SEQ; i += NGW) {
        const int b = i / SEQ, t = i - b * SEQ; const size_t r = (size_t)b * RB + CTXL + t;
        const float prow = (float)(t >> 6), pcol = (float)(t & 63);
#pragma unroll
        for (int pass = 0; pass < (NHEADS * 4 + 63) / 64; ++pass) {
            const int slot = pass * 64 + F.lane;
            if (slot < NHEADS * 4) {
                const int head = slot >> 2, part = (slot >> 1) & 1, jh = slot & 1;
                bf16* p = buf + r * PITCH + head * 64 + part * 32 + jh * 8;
                const v4u av = *(const GAS v4u*)p, bv = *(const GAS v4u*)(p + 16);
                const float pos = part ? pcol : prow;
                unsigned ao[4], bo[4];
#pragma unroll
                for (int q = 0; q < 4; ++q) {
                    float a0 = bf2f(av[q] & 0xffffu), a1 = bf2f(av[q] >> 16), b0 = bf2f(bv[q] & 0xffffu), b1 = bf2f(bv[q] >> 16);
                    const int j0 = jh * 8 + 2 * q;
                    const float ang0 = pos * exp2f(-(float)j0 * (13.287712379549449f / 16.0f)), ang1 = pos * exp2f(-(float)(j0 + 1) * (13.287712379549449f / 16.0f));
                    float s0, c0, s1, c1; __sincosf(ang0, &s0, &c0); __sincosf(ang1, &s1, &c1);
                    ao[q] = pk2(a0 * c0 - b0 * s0, a1 * c1 - b1 * s1); bo[q] = pk2(a0 * s0 + b0 * c0, a1 * s1 + b1 * c1);
                }
                *(GAS v4u*)p = (v4u){ao[0], ao[1], ao[2], ao[3]}; *(GAS v4u*)(p + 16) = (v4u){bo[0], bo[1], bo[2], bo[3]};
            }
        }
    }
}

__device__ __forceinline__ float ret_lg2(const Frame& F, int dir, int h) { const float x = F.ret_decay()[dir * 4 + h]; return -log1pf(__expf(-x)) * LOG2E; }
typedef __attribute__((address_space(3))) bf16 lbf16;
__device__ __forceinline__ void ret_stage_vt(const bf16* vbase, lbf16* Vt, int tid) {
#pragma unroll
    for (int pass = 0; pass < 4; ++pass) { const int j = tid & 127, c = (tid >> 7) + 4 * pass;
        const v4u v = *(const GAS v4u*)(vbase + (size_t)j * 3072 + c * 8);
#pragma unroll
        for (int q = 0; q < 4; ++q) { Vt[(c * 8 + 2 * q) * 136 + j] = (bf16)(v[q] & 0xffffu); Vt[(c * 8 + 2 * q + 1) * 136 + j] = (bf16)(v[q] >> 16); } }
}
__device__ __forceinline__ void ret_kv_item(Frame& F, int item) {
    const int n = item % NCH, h = (item / NCH) & 3, b = item / (NCH * 4);
    int lane = F.lane; asm volatile("" : "+v"(lane));
    const int w = F.wave, tid = w * 64 + lane, fr = lane & 15, fq = lane >> 4;
    lbf16* Vt = (lbf16*)F.lds; lbf16* Kft = (lbf16*)(F.lds + 34816); lbf16* Kbt = (lbf16*)(F.lds + 34816 + 17408);
    const bf16* base = F.QKV() + (size_t)(b * RB + n * 128) * 3072;
    const float lgf = ret_lg2(F, 0, h), lgb = ret_lg2(F, 1, h);
    ret_stage_vt(base + C_RV + h * 128, Vt, tid);
#pragma unroll
    for (int pass = 0; pass < 2; ++pass) { const int j = tid & 127, c = (tid >> 7) + 4 * pass;
        const v4u v = *(const GAS v4u*)(base + (size_t)j * 3072 + C_RK + h * 64 + c * 8);
        const float wf = fast_exp2(lgf * (float)(127 - j)), wb = fast_exp2(lgb * (float)j);
#pragma unroll
        for (int q = 0; q < 4; ++q) { const float k0 = bf2f(v[q] & 0xffffu), k1 = bf2f(v[q] >> 16);
            Kft[(c * 8 + 2 * q) * 136 + j] = (bf16)f2bf(k0 * wf); Kft[(c * 8 + 2 * q + 1) * 136 + j] = (bf16)f2bf(k1 * wf);
            Kbt[(c * 8 + 2 * q) * 136 + j] = (bf16)f2bf(k0 * wb); Kbt[(c * 8 + 2 * q + 1) * 136 + j] = (bf16)f2bf(k1 * wb); } }
    __syncthreads();
    const int dir = w & 1, eb = (w >> 1) * 32;
    lbf16* Kt = dir ? Kbt : Kft;
    f32x4 acc[2][4];
#pragma unroll
    for (int a = 0; a < 2; ++a)
#pragma unroll
        for (int d = 0; d < 4; ++d) acc[a][d] = (f32x4){0.f, 0.f, 0.f, 0.f};
#pragma unroll
    for (int ks = 0; ks < 4; ++ks) {
        bf16x8 af[2], bfr[4];
#pragma unroll
        for (int a = 0; a < 2; ++a) af[a] = *(const LAS bf16x8*)(Vt + (eb + a * 16 + fr) * 136 + ks * 32 + fq * 8);
#pragma unroll
        for (int d = 0; d < 4; ++d) bfr[d] = *(const LAS bf16x8*)(Kt + (d * 16 + fr) * 136 + ks * 32 + fq * 8);
#pragma unroll
        for (int a = 0; a < 2; ++a)
#pragma unroll
            for (int d = 0; d < 4; ++d) acc[a][d] = __builtin_amdgcn_mfma_f32_16x16x32_bf16(af[a], bfr[d], acc[a][d], 0, 0, 0);
        __builtin_amdgcn_sched_barrier(0);
    }
    float* out = F.CKV() + ((size_t)(((b * 4 + h) * 2 + dir) * NCH + n)) * 8192;
#pragma unroll
    for (int a = 0; a < 2; ++a)
#pragma unroll
        for (int d = 0; d < 4; ++d)
#pragma unroll
            for (int v = 0; v < 4; ++v) out[(eb + a * 16 + 4 * fq + v) * 64 + d * 16 + fr] = acc[a][d][v];
    __syncthreads();
}
template <int NH, int NC, int COL0>
__device__ __forceinline__ void p_tr16(Frame& F, bf16* dstb) {
    const int gw = F.vcu * NWAVES + F.wave, NGW = F.G * NWAVES;
    lbf16* sc = (lbf16*)(F.lds + F.wave * 16384);
    const bf16* qkv = F.QKV();
    for (int it = gw; it < NB * NH * (RB / 64); it += NGW) {
        const int t = it % (RB / 64), h = (it / (RB / 64)) % NH, b = it / ((RB / 64) * NH);
        const bf16* src = qkv + ((size_t)b * RB + t * 64 + F.lane) * N_IN0 + COL0 + h * NC;
#pragma unroll
        for (int c = 0; c < NC / 8; ++c) { const v4u v = *(const GAS v4u*)(src + c * 8);
#pragma unroll
            for (int q = 0; q < 4; ++q) { sc[(c * 8 + 2 * q) * 64 + F.lane] = (bf16)(v[q] & 0xffffu); sc[(c * 8 + 2 * q + 1) * 64 + F.lane] = (bf16)(v[q] >> 16); } }
        LDS_WAIT(); asm volatile("" ::: "memory");
        bf16* dst = dstb + ((size_t)((b * NH + h) * NC)) * RB + t * 64;
#pragma unroll
        for (int i = 0; i < NC / 8; ++i) { const int ch = i * 64 + F.lane, col = ch >> 3, q = ch & 7; *(GAS v4u*)(dst + (size_t)col * RB + q * 8) = *(const LAS v4u*)(sc + col * 64 + q * 8); }
        LDS_WAIT(); asm volatile("" ::: "memory");
    }
}
__device__ __forceinline__ void ret_kv_item2(Frame& F, int item) {
    const int n = item % NCH, h = (item / NCH) & 3, b = item / (NCH * 4);
    int lane = F.lane; asm volatile("" : "+v"(lane));
    const int w = F.wave, tid = w * 64 + lane, fr = lane & 15, fq = lane >> 4;
    lbf16* Vt = (lbf16*)F.lds; lbf16* Kft = (lbf16*)(F.lds + 34816); lbf16* Kbt = (lbf16*)(F.lds + 34816 + 17408);
    const bf16* vt = F.RVT() + ((size_t)((b * 4 + h) * 128)) * RB + n * 128; const bf16* kt = F.RKT() + ((size_t)((b * 4 + h) * 64)) * RB + n * 128;
    const float lgf = ret_lg2(F, 0, h), lgb = ret_lg2(F, 1, h);
#pragma unroll
    for (int p = 0; p < 4; ++p) { const int ch = tid + 512 * p, e = ch >> 4, c = ch & 15; *(LAS v4u*)(Vt + e * 136 + c * 8) = *(const GAS v4u*)(vt + (size_t)e * RB + c * 8); }
#pragma unroll
    for (int p = 0; p < 2; ++p) { const int ch = tid + 512 * p, d = ch >> 4, c = ch & 15; const v4u v = *(const GAS v4u*)(kt + (size_t)d * RB + c * 8);
        v4u of, ob;
#pragma unroll
        for (int q = 0; q < 4; ++q) { const int j = c * 8 + 2 * q; const float k0 = bf2f(v[q] & 0xffffu), k1 = bf2f(v[q] >> 16);
            of[q] = pk2(k0 * fast_exp2(lgf * (float)(127 - j)), k1 * fast_exp2(lgf * (float)(126 - j)));
            ob[q] = pk2(k0 * fast_exp2(lgb * (float)j), k1 * fast_exp2(lgb * (float)(j + 1))); }
        *(LAS v4u*)(Kft + d * 136 + c * 8) = of; *(LAS v4u*)(Kbt + d * 136 + c * 8) = ob; }
    __syncthreads();
    const int dir = w & 1, eb = (w >> 1) * 32;
    lbf16* Kt = dir ? Kbt : Kft;
    f32x4 acc[2][4];
#pragma unroll
    for (int a = 0; a < 2; ++a)
#pragma unroll
        for (int d = 0; d < 4; ++d) acc[a][d] = (f32x4){0.f, 0.f, 0.f, 0.f};
#pragma unroll
    for (int ks = 0; ks < 4; ++ks) {
        bf16x8 af[2], bfr[4];
#pragma unroll
        for (int a = 0; a < 2; ++a) af[a] = *(const LAS bf16x8*)(Vt + (eb + a * 16 + fr) * 136 + ks * 32 + fq * 8);
#pragma unroll
        for (int d = 0; d < 4; ++d) bfr[d] = *(const LAS bf16x8*)(Kt + (d * 16 + fr) * 136 + ks * 32 + fq * 8);
#pragma unroll
        for (int a = 0; a < 2; ++a)
#pragma unroll
            for (int d = 0; d < 4; ++d) acc[a][d] = __builtin_amdgcn_mfma_f32_16x16x32_bf16(af[a], bfr[d], acc[a][d], 0, 0, 0);
        __builtin_amdgcn_sched_barrier(0);
    }
    float* out = F.CKV() + ((size_t)(((b * 4 + h) * 2 + dir) * NCH + n)) * 8192;
#pragma unroll
    for (int a = 0; a < 2; ++a)
#pragma unroll
        for (int d = 0; d < 4; ++d)
#pragma unroll
            for (int v = 0; v < 4; ++v) out[(eb + a * 16 + 4 * fq + v) * 64 + d * 16 + fr] = acc[a][d][v];
    __syncthreads();
}
__device__ __forceinline__ void ret_out_item2(Frame& F, int item) {
    const int n = item % NCH, h = (item / NCH) & 3, b = item / (NCH * 4);
    int lane = F.lane; asm volatile("" : "+v"(lane));
    const int w = F.wave, tid = w * 64 + lane, fr = lane & 15, fq = lane >> 4;
    lbf16* Qs = (lbf16*)F.lds; lbf16* Ks = (lbf16*)(F.lds + 18432); lbf16* Vt = (lbf16*)(F.lds + 36864);
    lbf16* Pf = (lbf16*)(F.lds + 71680); lbf16* Pb = (lbf16*)(F.lds + 90112); lbf16* Ps = (lbf16*)F.lds;
    const size_t row0 = (size_t)b * RB + n * 128;
    const bf16* base = F.QKV() + row0 * 3072;
    const float lgf = ret_lg2(F, 0, h), lgb = ret_lg2(F, 1, h);
    bf16* cat = F.CAT(); const float* rnw = F.ret_norm_w();
    const bf16* pf = F.PREV() + ((size_t)(((b * 4 + h) * 2 + 0) * NCH + n)) * 8192; const bf16* pb = F.PREV() + ((size_t)(((b * 4 + h) * 2 + 1) * NCH + n)) * 8192;
    const bf16* vt = F.RVT() + ((size_t)((b * 4 + h) * 128)) * RB + n * 128;
#pragma unroll
    for (int pass = 0; pass < 2; ++pass) { const int ch = tid + 512 * pass, row = ch >> 3, c = ch & 7;
        *(LAS v4u*)(Qs + row * 72 + c * 8) = *(const GAS v4u*)(base + (size_t)row * 3072 + C_RQ + h * 64 + c * 8);
        *(LAS v4u*)(Ks + row * 72 + c * 8) = *(const GAS v4u*)(base + (size_t)row * 3072 + C_RK + h * 64 + c * 8);
        *(LAS v4u*)(Pf + row * 72 + c * 8) = *(const GAS v4u*)(pf + row * 64 + c * 8);
        *(LAS v4u*)(Pb + row * 72 + c * 8) = *(const GAS v4u*)(pb + row * 64 + c * 8); }
#pragma unroll
    for (int p = 0; p < 4; ++p) { const int ch = tid + 512 * p, e = ch >> 4, c = ch & 15; *(LAS v4u*)(Vt + e * 136 + c * 8) = *(const GAS v4u*)(vt + (size_t)e * RB + c * 8); }
    __syncthreads();
    const int i0 = 16 * w, i = i0 + fr;
    v2u gr[8]; { const GAS v2u* gp_ = (const GAS v2u*)(base + (size_t)i * 3072 + C_RG + h * 128 + 4 * fq);
#pragma unroll
        for (int t = 0; t < 8; ++t) gr[t] = gp_[4 * t]; }
    f32x4 as[8], af_[8], ab_[8];
#pragma unroll
    for (int t = 0; t < 8; ++t) { as[t] = (f32x4){0.f, 0.f, 0.f, 0.f}; af_[t] = as[t]; ab_[t] = as[t]; }
#pragma unroll
    for (int ks = 0; ks < 2; ++ks) {
        const bf16x8 q = *(const LAS bf16x8*)(Qs + (i0 + fr) * 72 + ks * 32 + fq * 8);
#pragma unroll
        for (int t = 0; t < 8; ++t) {
            as[t]  = __builtin_amdgcn_mfma_f32_16x16x32_bf16(*(const LAS bf16x8*)(Ks + (t * 16 + fr) * 72 + ks * 32 + fq * 8), q, as[t], 0, 0, 0);
            af_[t] = __builtin_amdgcn_mfma_f32_16x16x32_bf16(*(const LAS bf16x8*)(Pf + (t * 16 + fr) * 72 + ks * 32 + fq * 8), q, af_[t], 0, 0, 0);
            ab_[t] = __builtin_amdgcn_mfma_f32_16x16x32_bf16(*(const LAS bf16x8*)(Pb + (t * 16 + fr) * 72 + ks * 32 + fq * 8), q, ab_[t], 0, 0, 0);
            if (t & 1) __builtin_amdgcn_sched_barrier(0);
        }
    }
    __syncthreads();
#pragma unroll
    for (int t = 0; t < 8; ++t) { float pv_[4];
#pragma unroll
        for (int v = 0; v < 4; ++v) { const int j = t * 16 + 4 * fq + v, dl = i - j;
            const float dec = dl > 0 ? fast_exp2(lgf * (float)dl) : (dl < 0 ? fast_exp2(lgb * (float)(-dl)) : 2.0f);
            pv_[v] = as[t][v] * dec; }
        *(LAS v2u*)(Ps + i * 136 + t * 16 + 4 * fq) = (v2u){pk2(pv_[0], pv_[1]), pk2(pv_[2], pv_[3])}; }
    __syncthreads();
    f32x4 ao[8];
#pragma unroll
    for (int t = 0; t < 8; ++t) ao[t] = (f32x4){0.f, 0.f, 0.f, 0.f};
#pragma unroll
    for (int ks = 0; ks < 4; ++ks) {
        const bf16x8 p = *(const LAS bf16x8*)(Ps + (i0 + fr) * 136 + ks * 32 + fq * 8);
#pragma unroll
        for (int t = 0; t < 8; ++t) ao[t] = __builtin_amdgcn_mfma_f32_16x16x32_bf16(*(const LAS bf16x8*)(Vt + (t * 16 + fr) * 136 + ks * 32 + fq * 8), p, ao[t], 0, 0, 0);
        __builtin_amdgcn_sched_barrier(0);
    }
    {
        const float df = fast_exp2(lgf * (float)(i + 1)), db = fast_exp2(lgb * (float)(128 - i));
        float ss = 0.f;
#pragma unroll
        for (int t = 0; t < 8; ++t) { ao[t] = ao[t] + df * af_[t] + db * ab_[t]; ss += (ao[t][0] * ao[t][0] + ao[t][1] * ao[t][1]) + (ao[t][2] * ao[t][2] + ao[t][3] * ao[t][3]); }
        ss += __shfl_xor(ss, 16); ss += __shfl_xor(ss, 32);
        const float rs = 1.0f / sqrtf(ss * (1.0f / 128.0f) + EPS);
        bf16* orow = cat + (row0 + i) * D + 512 + h * 128 + 4 * fq;
#pragma unroll
        for (int t = 0; t < 8; ++t) { const f32x4 g = (f32x4){bf2f(gr[t].x & 0xffffu), bf2f(gr[t].x >> 16), bf2f(gr[t].y & 0xffffu), bf2f(gr[t].y >> 16)}; const f32x4 wv = *(const GAS f32x4*)(rnw + t * 16 + 4 * fq);
            f32x4 sg; sg[0] = g[0] * sigmoidf_(g[0]); sg[1] = g[1] * sigmoidf_(g[1]); sg[2] = g[2] * sigmoidf_(g[2]); sg[3] = g[3] * sigmoidf_(g[3]);
            const f32x4 ov = ao[t] * rs * wv * sg;
            if (OUT_FP8) *(GAS unsigned*)((unsigned char*)cat + (row0 + i) * D + 512 + h * 128 + 4 * fq + t * 16) = (unsigned)cvt4_fp8(ov[0] * OUT_ASC, ov[1] * OUT_ASC, ov[2] * OUT_ASC, ov[3] * OUT_ASC);
            else st4bf(orow + t * 16, ov); }
    }
    __syncthreads();
}
template <int NH, int NC, int PITCH, int COL0>
__device__ __forceinline__ void p_vt8(Frame& F, unsigned char* vt) {
    const int gw = F.vcu * NWAVES + F.wave, NGW = F.G * NWAVES;
    LAS unsigned char* sc8 = (LAS unsigned char*)(F.lds + F.wave * 8192);
    const bf16* qkv = F.QKV();
    for (int it = gw; it < NB * NH * (RB / 64); it += NGW) {
        const int t = it % (RB / 64), h = (it / (RB / 64)) % NH, b = it / ((RB / 64) * NH);
        const bf16* src = qkv + ((size_t)b * RB + t * 64 + F.lane) * PITCH + COL0 + h * NC;
        const int slot = attn_dv::vt8_slot(F.lane);
#pragma unroll
        for (int c = 0; c < NC / 8; ++c) { const v4u v = *(const GAS v4u*)(src + c * 8);
#pragma unroll
            for (int q = 0; q < 4; ++q) { const int w = cvt4_fp8(bf2f(v[q] & 0xffffu), bf2f(v[q] >> 16), 0.f, 0.f);
                sc8[(c * 8 + 2 * q) * 64 + slot] = (unsigned char)(w & 0xff); sc8[(c * 8 + 2 * q + 1) * 64 + slot] = (unsigned char)((w >> 8) & 0xff); } }
        LDS_WAIT(); asm volatile("" ::: "memory");
        unsigned char* dst = vt + ((size_t)((b * NH + h) * NC)) * RB + t * 64;
#pragma unroll
        for (int i = 0; i < NC / 16; ++i) { const int ch = i * 64 + F.lane, col = ch >> 2, q = ch & 3; *(GAS v4u*)(dst + (size_t)col * RB + q * 16) = *(const LAS v4u*)(sc8 + col * 64 + q * 16); }
        LDS_WAIT(); asm volatile("" ::: "memory");
    }
}
__device__ __forceinline__ void p_ret_scan(Frame& F) {
    const float* ckv = F.CKV(); bf16* prev = F.PREV(); const float* rdl = F.ret_decay();
    for (int i = blockIdx.x * 512 + F.tid; i < NB * 4 * 2 * 4096; i += F.G * 512) {
        const int el = i & 4095, seq = i >> 12, dir = seq & 1, h = (seq >> 1) & 3;
        const float gC = fast_exp2(-log1pf(__expf(-rdl[dir * 4 + h])) * LOG2E * 128.0f);
        const float* src = ckv + (size_t)seq * NCH * 8192 + el * 2; bf16* dst = prev + (size_t)seq * NCH * 8192 + el * 2;
        float s0 = 0.f, s1 = 0.f;
#pragma unroll 33
        for (int s = 0; s < NCH; ++s) {
            const int n = dir ? (s < 2 ? 1 - s : NCH + 1 - s) : s;
            const f32x2 v = *(const GAS f32x2*)(src + (size_t)n * 8192);
            *(GAS unsigned*)(dst + (size_t)n * 8192) = pk2(s0, s1);
            s0 = gC * s0 + v.x; s1 = gC * s1 + v.y;
        }
    }
}
__device__ __forceinline__ void ret_out_item(Frame& F, int item) {
    const int n = item % NCH, h = (item / NCH) & 3, b = item / (NCH * 4);
    int lane = F.lane; asm volatile("" : "+v"(lane));
    const int w = F.wave, tid = w * 64 + lane, fr = lane & 15, fq = lane >> 4;
    lbf16* Qs = (lbf16*)F.lds; lbf16* Ks = (lbf16*)(F.lds + 18432); lbf16* Vt = (lbf16*)(F.lds + 36864);
    lbf16* Pf = (lbf16*)(F.lds + 71680); lbf16* Pb = (lbf16*)(F.lds + 90112); lbf16* Ps = (lbf16*)F.lds;
    const size_t row0 = (size_t)b * RB + n * 128;
    const bf16* base = F.QKV() + row0 * 3072;
    const float lgf = ret_lg2(F, 0, h), lgb = ret_lg2(F, 1, h);
    bf16* cat = F.CAT(); const float* rnw = F.ret_norm_w();
    const bf16* pf = F.PREV() + ((size_t)(((b * 4 + h) * 2 + 0) * NCH + n)) * 8192; const bf16* pb = F.PREV() + ((size_t)(((b * 4 + h) * 2 + 1) * NCH + n)) * 8192;
#pragma unroll
    for (int pass = 0; pass < 2; ++pass) { const int ch = tid + 512 * pass, row = ch >> 3, c = ch & 7;
        *(LAS v4u*)(Qs + row * 72 + c * 8) = *(const GAS v4u*)(base + (size_t)row * 3072 + C_RQ + h * 64 + c * 8);
        *(LAS v4u*)(Ks + row * 72 + c * 8) = *(const GAS v4u*)(base + (size_t)row * 3072 + C_RK + h * 64 + c * 8);
        *(LAS v4u*)(Pf + row * 72 + c * 8) = *(const GAS v4u*)(pf + row * 64 + c * 8);
        *(LAS v4u*)(Pb + row * 72 + c * 8) = *(const GAS v4u*)(pb + row * 64 + c * 8); }
    ret_stage_vt(base + C_RV + h * 128, Vt, tid);
    __syncthreads();
    const int i0 = 16 * w;
    f32x4 as[8], af_[8], ab_[8];
#pragma unroll
    for (int t = 0; t < 8; ++t) { as[t] = (f32x4){0.f, 0.f, 0.f, 0.f}; af_[t] = as[t]; ab_[t] = as[t]; }
#pragma unroll
    for (int ks = 0; ks < 2; ++ks) {
        const bf16x8 a = *(const LAS bf16x8*)(Qs + (i0 + fr) * 72 + ks * 32 + fq * 8);
#pragma unroll
        for (int t = 0; t < 8; ++t) {
            as[t]  = __builtin_amdgcn_mfma_f32_16x16x32_bf16(a, *(const LAS bf16x8*)(Ks + (t * 16 + fr) * 72 + ks * 32 + fq * 8), as[t], 0, 0, 0);
            af_[t] = __builtin_amdgcn_mfma_f32_16x16x32_bf16(a, *(const LAS bf16x8*)(Pf + (t * 16 + fr) * 72 + ks * 32 + fq * 8), af_[t], 0, 0, 0);
            ab_[t] = __builtin_amdgcn_mfma_f32_16x16x32_bf16(a, *(const LAS bf16x8*)(Pb + (t * 16 + fr) * 72 + ks * 32 + fq * 8), ab_[t], 0, 0, 0);
            if (t & 1) __builtin_amdgcn_sched_barrier(0);
        }
    }
    __syncthreads();
#pragma unroll
    for (int t = 0; t < 8; ++t)
#pragma unroll
        for (int v = 0; v < 4; ++v) { const int i = i0 + 4 * fq + v, j = t * 16 + fr, dl = i - j;
            const float dec = dl > 0 ? fast_exp2(lgf * (float)dl) : (dl < 0 ? fast_exp2(lgb * (float)(-dl)) : 2.0f);
            Ps[i * 136 + j] = (bf16)f2bf(as[t][v] * dec); }
    __syncthreads();
    f32x4 ao[8];
#pragma unroll
    for (int t = 0; t < 8; ++t) ao[t] = (f32x4){0.f, 0.f, 0.f, 0.f};
#pragma unroll
    for (int ks = 0; ks < 4; ++ks) {
        const bf16x8 a = *(const LAS bf16x8*)(Ps + (i0 + fr) * 136 + ks * 32 + fq * 8);
#pragma unroll
        for (int t = 0; t < 8; ++t) ao[t] = __builtin_amdgcn_mfma_f32_16x16x32_bf16(a, *(const LAS bf16x8*)(Vt + (t * 16 + fr) * 136 + ks * 32 + fq * 8), ao[t], 0, 0, 0);
        __builtin_amdgcn_sched_barrier(0);
    }
#pragma unroll
    for (int v = 0; v < 4; ++v) {
        const int i = i0 + 4 * fq + v;
        const float df = fast_exp2(lgf * (float)(i + 1)), db = fast_exp2(lgb * (float)(128 - i));
        float o[8], ss = 0.f;
#pragma unroll
        for (int t = 0; t < 8; ++t) { o[t] = ao[t][v] + df * af_[t][v] + db * ab_[t][v]; ss += o[t] * o[t]; }
        ss += __shfl_xor(ss, 1); ss += __shfl_xor(ss, 2); ss += __shfl_xor(ss, 4); ss += __shfl_xor(ss, 8);
        const float rs = 1.0f / sqrtf(ss * (1.0f / 128.0f) + EPS);
        const size_t r = row0 + i;
#pragma unroll
        for (int t = 0; t < 8; ++t) { const int e = t * 16 + fr;
            const float g = bf2f(base[(size_t)i * 3072 + C_RG + h * 128 + e]);
            cat[r * D + 512 + h * 128 + e] = (bf16)f2bf(o[t] * rs * rnw[e] * (g * sigmoidf_(g))); }
    }
    __syncthreads();
}
__device__ __forceinline__ void p_dfinish(Frame& F) {
    const int extra = (NB * 4 * NCH) % F.G;
    if ((int)blockIdx.x < extra) return;
    const int gw = ((int)blockIdx.x - extra) * NWAVES + F.wave, NGW = (F.G - extra) * NWAVES;
    const float* dl_ = F.diff_lam(); bf16* cat = F.CAT();
    const float s1 = wave_sum(dl_[F.lane] * dl_[64 + F.lane]), s2 = wave_sum(dl_[128 + F.lane] * dl_[192 + F.lane]);
    const float lam = __expf(s1) - __expf(s2) + 0.2f;
    const bf16* O0 = F.OD(); const bf16* O1 = O0 + (size_t)M * 512; const float* dnw = F.diff_norm_w();
    float nw[8];
#pragma unroll
    for (int q = 0; q < 8; ++q) nw[q] = dnw[(F.lane & 15) * 8 + q] * 0.8f;
    for (int r = gw; r < M; r += NGW) {
        const v4u a = *(const GAS v4u*)(O0 + (size_t)r * 512 + F.lane * 8), b = *(const GAS v4u*)(O1 + (size_t)r * 512 + F.lane * 8);
        float d[8], ss = 0.f;
#pragma unroll
        for (int q = 0; q < 4; ++q) { d[2 * q] = bf2f(a[q] & 0xffffu) - lam * bf2f(b[q] & 0xffffu); d[2 * q + 1] = bf2f(a[q] >> 16) - lam * bf2f(b[q] >> 16); ss += d[2 * q] * d[2 * q] + d[2 * q + 1] * d[2 * q + 1]; }
        ss += __shfl_xor(ss, 1); ss += __shfl_xor(ss, 2); ss += __shfl_xor(ss, 4); ss += __shfl_xor(ss, 8);
        const float rs = 1.0f / sqrtf(ss * (1.0f / 128.0f) + EPS);
        if (OUT_FP8) { const float rq = rs * OUT_ASC;
            *(GAS v2u*)((unsigned char*)cat + (size_t)r * D + F.lane * 8) = (v2u){(unsigned)cvt4_fp8(d[0] * rq * nw[0], d[1] * rq * nw[1], d[2] * rq * nw[2], d[3] * rq * nw[3]), (unsigned)cvt4_fp8(d[4] * rq * nw[4], d[5] * rq * nw[5], d[6] * rq * nw[6], d[7] * rq * nw[7])};
            continue; }
        v4u o;
#pragma unroll
        for (int q = 0; q < 4; ++q) o[q] = pk2(d[2 * q] * rs * nw[2 * q], d[2 * q + 1] * rs * nw[2 * q + 1]);
        *(GAS v4u*)(cat + (size_t)r * D + F.lane * 8) = o;
    }
}

template <class Epi, bool F8 = false> struct DenseProb {
    static constexpr bool PERM = Epi::PERM;
    const bf16* A; const bf16* Bt; int K, nM, nN, G, c; bool skipctx; Epi E;
    __device__ __forceinline__ bool next(int i, pg8::Unit& u) const {
        const int nwg = nM * nN; const long L = (long)i * G + c; if (L >= nwg) return false;
        int wgid = (int)L; { const int q = nwg / pg8::NXCD, r = nwg % pg8::NXCD, xcd = wgid % pg8::NXCD, off = wgid / pg8::NXCD; wgid = (xcd < r ? xcd * (q + 1) : r * (q + 1) + (xcd - r) * q) + off; }
        const int nig = pg8::WGM * nN, gid = wgid / nig, fm = gid * pg8::WGM, gsz = (nM - fm) < pg8::WGM ? (nM - fm) : pg8::WGM;
        int pm = fm + ((wgid % nig) % gsz); u.pn = (wgid % nig) / gsz; u.e = 0;
        if (skipctx) pm = (pm >> 5) * TPB + 1 + (pm & 31);
        u.pm = pm; return true;
    }
    __device__ __forceinline__ const char* a_base() const { return (const char*)A; }
    __device__ __forceinline__ void a_offs(const pg8::Unit& u, const int (&R)[2], const int (&C)[2], unsigned (&o)[2][2]) const {
#pragma unroll
        for (int h = 0; h < 2; ++h)
#pragma unroll
            for (int i = 0; i < 2; ++i) o[h][i] = (unsigned)((u.pm * 256 + h * 128 + R[i]) * K + C[i]) * 2u;
    }
    __device__ __forceinline__ const char* b_base(const pg8::Unit& u) const { return (const char*)Bt + (size_t)u.pn * 256 * K * 2; }
    static constexpr int NBIAS = 0; static constexpr bool FP8 = F8;
    __device__ __forceinline__ unsigned a_fix(unsigned x, int) const { return x; }
    __device__ __forceinline__ const float* bias_src(const pg8::Unit&, int) const { return nullptr; }
    __device__ __forceinline__ void epi(const f32x4 (&acc)[2][2][4][2], const pg8::Unit& u, int wr, int wc, int fr, int fq, const LAS float*) const { E(acc, u, wr, wc, fr, fq); }
};
struct EpiStoreBf16 {
    static constexpr bool PERM = true;
    bf16* O; int ldc; int rope_cols; float ascale; unsigned char* qk8; unsigned char* k8;
    __device__ __forceinline__ void operator()(const f32x4 (&acc)[2][2][4][2], const pg8::Unit& u, int wr, int wc, int fr, int fq) const {
        const int row0 = u.pm * 256 + wr * 64 + fr, col0 = u.pn * 256 + wc * 32 + 8 * fq;
        const int bq = u.pm / TPB, tt = u.pm - bq * TPB;
        const bool rope_tile = (tt != 0) && (u.pn * 256 < rope_cols);
        const float sgn = fq < 2 ? -1.0f : 1.0f;
#pragma unroll
        for (int ai = 0; ai < 2; ++ai)
#pragma unroll
            for (int m = 0; m < 4; ++m) { bf16* rowp = O + (size_t)(row0 + ai * 128 + m * 16) * ldc + col0;
                float y[2][8];
#pragma unroll
                for (int bj = 0; bj < 2; ++bj)
#pragma unroll
                    for (int i = 0; i < 8; ++i) y[bj][i] = acc[ai][bj][m][i >> 2][i & 3] * ascale;
                if (rope_tile) { const int t = (tt - 1) * 256 + ai * 128 + wr * 64 + m * 16 + fr; const float pos = (wc & 1) ? (float)(t & 63) : (float)(t >> 6);
#pragma unroll
                    for (int i = 0; i < 8; ++i) { float sn, cs; __sincosf(pos * exp2f(-(float)(8 * (fq & 1) + i) * (13.287712379549449f / 16.0f)), &sn, &cs);
#pragma unroll
                        for (int bj = 0; bj < 2; ++bj) if (u.pn * 256 + bj * 128 < rope_cols) { const float p = __shfl_xor(y[bj][i], 32); y[bj][i] = y[bj][i] * cs + sgn * p * sn; } } }
#pragma unroll
                for (int bj = 0; bj < 2; ++bj) {
                    if (k8 && u.pn == 4 && bj == 0) { *(GAS v2u*)(k8 + (size_t)(row0 + ai * 128 + m * 16) * 128 + wc * 32 + 8 * fq) = (v2u){(unsigned)cvt4_fp8(y[bj][0], y[bj][1], y[bj][2], y[bj][3]), (unsigned)cvt4_fp8(y[bj][4], y[bj][5], y[bj][6], y[bj][7])}; continue; }
                    if (qk8 && u.pn < 4) { *(GAS v2u*)(qk8 + (size_t)(row0 + ai * 128 + m * 16) * 1024 + col0 + bj * 128) = (v2u){(unsigned)cvt4_fp8(y[bj][0], y[bj][1], y[bj][2], y[bj][3]), (unsigned)cvt4_fp8(y[bj][4], y[bj][5], y[bj][6], y[bj][7])}; continue; }
                    v4u w; w.x = cvt_pk_bf16(y[bj][0], y[bj][1]); w.y = cvt_pk_bf16(y[bj][2], y[bj][3]); w.z = cvt_pk_bf16(y[bj][4], y[bj][5]); w.w = cvt_pk_bf16(y[bj][6], y[bj][7]);
                    *(GAS v4u*)(rowp + bj * 128) = w; } }
    }
};
struct EpiResid {
    static constexpr bool PERM = false;
    bf16* H; const float* MODL; int goff; const float* xin; const float* cin; float ascale;
    __device__ __forceinline__ void operator()(const f32x4 (&acc)[2][2][4][2], const pg8::Unit& u, int wr, int wc, int fr, int fq) const {
        const int row0 = u.pm * 256 + wr * 64 + fr, col0 = u.pn * 256 + wc * 32 + 4 * fq;
        const int b = u.pm / TPB, tt = u.pm - b * TPB, v = tt == 0 ? 4 : b;
        const float* src = xin ? (tt == 0 ? cin + (size_t)b * CTXL * D : xin + ((size_t)b * SEQ + (tt - 1) * 256) * D) + (size_t)(wr * 64 + fr) * D + col0 : nullptr;
        const float* g = MODL + (size_t)v * 6144 + goff + col0;
        f32x4 gv[2][2];
#pragma unroll
        for (int bj = 0; bj < 2; ++bj)
#pragma unroll
            for (int n = 0; n < 2; ++n) gv[bj][n] = *(const GAS f32x4*)(g + bj * 128 + n * 16);
#pragma unroll
        for (int ai = 0; ai < 2; ++ai)
#pragma unroll
            for (int m = 0; m < 4; ++m) { bf16* rowp = H + (size_t)(row0 + ai * 128 + m * 16) * D + col0; const float* srow = src + (size_t)(ai * 128 + m * 16) * D;
#pragma unroll
                for (int bj = 0; bj < 2; ++bj)
#pragma unroll
                    for (int n = 0; n < 2; ++n) { bf16* p = rowp + bj * 128 + n * 16; const f32x4 res = xin ? *(const GAS f32x4*)(srow + bj * 128 + n * 16) : ld4bf(p); st4bf(p, res + gv[bj][n] * (acc[ai][bj][m][n] * ascale)); } }
    }
};
__device__ __forceinline__ void moe_tables(Frame& F, int layer) {
    __syncthreads();
    if (F.tid < 64) {
        const int e = F.lane & 31;
        const unsigned c = __hip_atomic_load(F.ctl() + CW_CNT + (layer * 32 + e) * 64, RLX_AGENT);
        const unsigned tl = (c + 255u) >> 8; unsigned inc = tl;
#pragma unroll
        for (int o = 1; o < 32; o <<= 1) { const unsigned up = __shfl_up(inc, o); if (e >= o) inc += up; }
        if (F.lane < 32) { F.MISC[MW_CNT + e] = c; F.MISC[MW_TST + e] = inc - tl; if (e == 31) F.MISC[MW_TST + NEXP] = inc; } }
    __syncthreads();
    { LAS unsigned char* te = (LAS unsigned char*)(F.lds + TILE_E_OFF);
      for (int t = F.tid; t < 576; t += NWAVES * 64) { int e = 0;
#pragma unroll
          for (int st = 16; st >= 1; st >>= 1) { if (t >= (int)F.MISC[MW_TST + e + st]) e += st; }
          te[t] = (unsigned char)e; } }
    __syncthreads();
}
struct Moe1Prob {
    static constexpr bool PERM = true;
    const bf16* Fin; const bf16* W1l; const float* b1l; const int* LIST; bf16* ACT; volatile LAS unsigned* MISC; int K, G, c;
    __device__ __forceinline__ bool next(int i, pg8::Unit& u) const {
        const int L = i * G + c, tt = (int)MISC[MW_TST + NEXP]; if (L >= tt * 8) return false;
        const int tr = L >> 3;
        u.pm = tr; u.pn = L & 7; u.e = (int)((const volatile LAS unsigned char*)((const volatile LAS unsigned char*)MISC - MISC_OFF + TILE_E_OFF))[tr]; return true;
    }
    __device__ __forceinline__ const char* a_base() const { return (const char*)Fin; }
    __device__ __forceinline__ void a_offs(const pg8::Unit& u, const int (&R)[2], const int (&C)[2], unsigned (&o)[2][2]) const {
        const int p0 = (u.pm - (int)MISC[MW_TST + u.e]) * 256, cnt = (int)MISC[MW_CNT + u.e];
#pragma unroll
        for (int h = 0; h < 2; ++h)
#pragma unroll
            for (int i = 0; i < 2; ++i) { const int p = p0 + h * 128 + R[i]; o[h][i] = (unsigned)LIST[(size_t)u.e * LIST_CAP + (p < cnt ? p : 0)]; }
    }
    static constexpr int NBIAS = 256; static constexpr bool FP8 = true;
    __device__ __forceinline__ unsigned a_fix(unsigned tok, int Ci) const { return (tok * (unsigned)K + (unsigned)Ci) * 2u; }
    __device__ __forceinline__ const float* bias_src(const pg8::Unit& u, int lane) const { return b1l + (size_t)u.e * 2048 + u.pn * 128 + (lane < 32 ? lane * 4 : 1024 + (lane - 32) * 4); }
    __device__ __forceinline__ const char* b_base(const pg8::Unit& u) const { return (const char*)W1l + ((size_t)u.e * 2048 + (size_t)u.pn * 256) * K * 2; }
    __device__ __forceinline__ void epi(const f32x4 (&acc)[2][2][4][2], const pg8::Unit& u, int wr, int wc, int fr, int fq, const LAS float* bias) const {
        const int row0 = u.pm * 256 + wr * 64 + fr, colt = wc * 32 + 8 * fq;
        f32x4 bgv[2], blv[2];
#pragma unroll
        for (int n = 0; n < 2; ++n) { bgv[n] = *(const LAS f32x4*)(bias + colt + 4 * n); blv[n] = *(const LAS f32x4*)(bias + 128 + colt + 4 * n); }
#pragma unroll
        for (int ai = 0; ai < 2; ++ai)
#pragma unroll
            for (int m = 0; m < 4; ++m) {
                unsigned w[2];
#pragma unroll
                for (int n = 0; n < 2; ++n) { const f32x4 gl = acc[ai][0][m][n] * W8_INV + bgv[n], li = acc[ai][1][m][n] * W8_INV + blv[n];
                    f32x4 g, l, e;
#pragma unroll
                    for (int j = 0; j < 4; ++j) { g[j] = fminf(gl[j], 7.0f); l[j] = __builtin_amdgcn_fmed3f(li[j], -7.0f, 7.0f); }
                    const f32x4 z = g * (-1.702f * 1.4426950408889634f);
#pragma unroll
                    for (int j = 0; j < 4; ++j) e[j] = __builtin_amdgcn_exp2f(z[j]);
                    const f32x4 den = e + 1.0f; f32x4 r;
#pragma unroll
                    for (int j = 0; j < 4; ++j) r[j] = __builtin_amdgcn_rcpf(den[j]);
                    const f32x4 a = (g * r) * (l + 1.0f);
                    w[n] = (unsigned)attn_dv::cvt4_nc(a[0], a[1], a[2], a[3]); }
                *(GAS v2u*)((unsigned char*)ACT + (size_t)(row0 + ai * 128 + m * 16) * DFF + u.pn * 128 + colt) = (v2u){w[0], w[1]}; }
    }
};
struct Moe2Prob {
    static constexpr bool PERM = true;
    const bf16* ACT; const bf16* W2l; const float* b2l; bf16* Y; volatile LAS unsigned* MISC; int K, G, c;
    __device__ __forceinline__ bool next(int i, pg8::Unit& u) const {
        const int L = i * G + c, tt = (int)MISC[MW_TST + NEXP]; if (L >= tt * 4) return false;
        const int tr = L >> 2;
        u.pm = tr; u.pn = L & 3; u.e = (int)((const volatile LAS unsigned char*)((const volatile LAS unsigned char*)MISC - MISC_OFF + TILE_E_OFF))[tr]; return true;
    }
    __device__ __forceinline__ const char* a_base() const { return (const char*)ACT; }
    __device__ __forceinline__ void a_offs(const pg8::Unit& u, const int (&R)[2], const int (&C)[2], unsigned (&o)[2][2]) const {
#pragma unroll
        for (int h = 0; h < 2; ++h)
#pragma unroll
            for (int i = 0; i < 2; ++i) o[h][i] = (unsigned)((u.pm * 256 + h * 128 + R[i]) * K + C[i]) * 2u;
    }
    __device__ __forceinline__ const char* b_base(const pg8::Unit& u) const { return (const char*)W2l + ((size_t)u.e * D + (size_t)u.pn * 256) * K * 2; }
    static constexpr int NBIAS = 256; static constexpr bool FP8 = true;
    __device__ __forceinline__ unsigned a_fix(unsigned x, int) const { return x; }
    __device__ __forceinline__ const float* bias_src(const pg8::Unit& u, int lane) const { return b2l + (size_t)u.e * D + u.pn * 256 + lane * 4; }
    __device__ __forceinline__ void epi(const f32x4 (&acc)[2][2][4][2], const pg8::Unit& u, int wr, int wc, int fr, int fq, const LAS float* bias) const {
        const int row0 = u.pm * 256 + wr * 64 + fr, col0 = u.pn * 256 + wc * 32 + 8 * fq;
        f32x4 bv[2][2];
#pragma unroll
        for (int bj = 0; bj < 2; ++bj)
#pragma unroll
            for (int n = 0; n < 2; ++n) bv[bj][n] = *(const LAS f32x4*)(bias + wc * 32 + 8 * fq + bj * 128 + 4 * n);
#pragma unroll
        for (int ai = 0; ai < 2; ++ai)
#pragma unroll
            for (int m = 0; m < 4; ++m) { bf16* rowp = Y + (size_t)(row0 + ai * 128 + m * 16) * D + col0;
#pragma unroll
                for (int bj = 0; bj < 2; ++bj) { const f32x4 v0 = acc[ai][bj][m][0] * W8_INV + bv[bj][0], v1 = acc[ai][bj][m][1] * W8_INV + bv[bj][1];
                    if (Y_FP8) { *(GAS v2u*)((unsigned char*)Y + (size_t)(row0 + ai * 128 + m * 16) * D + col0 + bj * 128) = (v2u){(unsigned)cvt4_fp8(v0[0], v0[1], v0[2], v0[3]), (unsigned)cvt4_fp8(v1[0], v1[1], v1[2], v1[3])}; continue; }
                    v4u w; w.x = cvt_pk_bf16(v0[0], v0[1]); w.y = cvt_pk_bf16(v0[2], v0[3]); w.z = cvt_pk_bf16(v1[0], v1[1]); w.w = cvt_pk_bf16(v1[2], v1[3]);
                    *(GAS v4u*)(rowp + bj * 128) = w; } }
    }
};

constexpr int PROV_OFF = MISC_OFF + 1024, PROV_CAP = 2048;
constexpr int LDS_TOTAL = PROV_OFF + PROV_CAP * 4;
__device__ __forceinline__ int tok_row(int layer, int i) { if (layer == 0) return i; const int b = i / SEQ; return b * RB + CTXL + (i - b * SEQ); }
__device__ __forceinline__ void tok_finish(Frame& F, int i, int i0, int r, const f32x2 (&pq)[16], float rbias, volatile LAS unsigned* prov, float* GATEp) {
    float p[32];
#pragma unroll
    for (int e = 0; e < 16; ++e) { p[2 * e] = pq[e].x; p[2 * e + 1] = pq[e].y; }
        float q16[16], q8[8], q4[4], q2[2], q1;
#pragma unroll
        for (int t = 0; t < 16; ++t) { const auto rr = __builtin_amdgcn_permlane32_swap(__float_as_uint(p[t]), __float_as_uint(p[16 + t]), false, false); q16[t] = __uint_as_float(rr[0]) + __uint_as_float(rr[1]); }
#pragma unroll
        for (int t = 0; t < 8; ++t) { const auto rr = __builtin_amdgcn_permlane16_swap(__float_as_uint(q16[t]), __float_as_uint(q16[8 + t]), false, false); q8[t] = __uint_as_float(rr[0]) + __uint_as_float(rr[1]); }
        { const bool up = (F.lane & 8) != 0;
#pragma unroll
          for (int t = 0; t < 4; ++t) { const float mine = up ? q8[4 + t] : q8[t], send = up ? q8[t] : q8[4 + t]; q4[t] = mine + dpp_xor<8>(send); } }
        { const bool up = (F.lane & 4) != 0;
#pragma unroll
          for (int t = 0; t < 2; ++t) { const float mine = up ? q4[2 + t] : q4[t], send = up ? q4[t] : q4[2 + t]; q2[t] = mine + dpp_xor<4>(send); } }
        { const bool up = (F.lane & 2) != 0; const float mine = up ? q2[1] : q2[0], send = up ? q2[0] : q2[1]; q1 = mine + dpp_xor<2>(send); }
        q1 += dpp_xor<1>(q1);
        const int myE = F.lane >> 1;
        float val = q1 + rbias;
        float tv[4]; int ti[4];
        { int rank = 0; const int vali = __float_as_int(val);
          const float vbelow = __int_as_float(vali > 0 ? vali - 1 : ((vali & 0x7fffffff) == 0 ? (int)0x80000001u : vali + 1));
#pragma unroll
          for (int e = 0; e < 32; ++e) { const float ve = __int_as_float(__builtin_amdgcn_readlane(vali, 2 * e)); const float th = (e < myE) ? vbelow : val; rank += (ve > th) ? 1 : 0; }
#pragma unroll
          for (int k = 0; k < 4; ++k) { const unsigned long long mk = __ballot(rank == k); const int ln = (int)__builtin_ctzll(mk); ti[k] = ln >> 1; tv[k] = __int_as_float(__builtin_amdgcn_readlane(vali, ln)); } }
        const float w1 = __expf(tv[1] - tv[0]), w2 = __expf(tv[2] - tv[0]), w3 = __expf(tv[3] - tv[0]); const float inv = 1.0f / (1.0f + w1 + w2 + w3);
        if (F.lane < 4) {
            const int ek = F.lane == 0 ? ti[0] : F.lane == 1 ? ti[1] : F.lane == 2 ? ti[2] : ti[3];
            const float gk = (F.lane == 0 ? 1.0f : F.lane == 1 ? w1 : F.lane == 2 ? w2 : w3) * inv;
            const unsigned ls = __hip_atomic_fetch_add((LAS unsigned*)(F.lds + MISC_OFF) + MW_LCNT + ek, 1u, __ATOMIC_RELAXED, __HIP_MEMORY_SCOPE_WORKGROUP);
            prov[(i - i0) * 4 + F.lane] = ((unsigned)ek << 16) | ls;
            GATEp[(size_t)r * 4 + F.lane] = gk;
        }
    }
__device__ __forceinline__ void p_token(Frame& F, int layer) {
    const int nrows = layer == 0 ? M : NB * SEQ, RPB = (nrows + F.G - 1) / F.G;
    const int i0 = blockIdx.x * RPB, i1 = (i0 + RPB < nrows) ? i0 + RPB : nrows;
    LAS float* WL = (LAS float*)F.lds;
    volatile LAS unsigned* prov = (volatile LAS unsigned*)(F.lds + PROV_OFF);
    __syncthreads();
    if (F.tid < 32) F.MISC[MW_LCNT + F.tid] = 0u;
    const float* rw = F.router_w() + (size_t)layer * D * NEXP;
#pragma unroll
    for (int p = 0; p < 2; ++p) { const int k = F.tid + 512 * p, rowL = ((k & 3) + 4 * (k >> 8)) * 64 + ((k >> 2) & 63);
#pragma unroll
        for (int q = 0; q < 8; ++q) *(LAS f32x4*)(WL + rowL * 36 + 4 * q) = *(const GAS f32x4*)(rw + (size_t)k * NEXP + 4 * q); }
    __syncthreads();
    const float* n2 = F.norm2_w() + layer * D;
    const float rbias = F.router_b()[layer * NEXP + (F.lane >> 1)];
    const float* MODl = F.MOD() + (size_t)layer * 5 * 6144; const bf16* Hp = F.H(); bf16* Ap = F.A(); float* GATEp = F.GATE();
    if (RPB * 4 <= PROV_CAP)
    for (int i = i0 + F.wave; i < i1; i += 2 * NWAVES) {
        const int iB = i + NWAVES; const bool hasB = iB < i1;
        const int rA = tok_row(layer, i), rB = tok_row(layer, hasB ? iB : i);
        const float* modA = MODl + (size_t)row_v(rA) * 6144; const float* modB = MODl + (size_t)row_v(rB) * 6144;
        f32x4 hA[4], hB[4]; const bf16* hpA = Hp + (size_t)rA * D + F.lane * 4; const bf16* hpB = Hp + (size_t)rB * D + F.lane * 4;
        float sA = 0.f, sB = 0.f;
#pragma unroll
        for (int j = 0; j < 4; ++j) { hA[j] = ld4bf(hpA + 256 * j); hB[j] = ld4bf(hpB + 256 * j); }
#pragma unroll
        for (int j = 0; j < 4; ++j) { sA += (hA[j].x * hA[j].x + hA[j].y * hA[j].y) + (hA[j].z * hA[j].z + hA[j].w * hA[j].w); sB += (hB[j].x * hB[j].x + hB[j].y * hB[j].y) + (hB[j].z * hB[j].z + hB[j].w * hB[j].w); }
        const float rsA = 1.0f / sqrtf(wave_sum(sA) * (1.0f / D) + EPS), rsB = 1.0f / sqrtf(wave_sum(sB) * (1.0f / D) + EPS);
        GAS unsigned* o8A = (GAS unsigned*)((unsigned char*)Ap + (size_t)rA * D) + F.lane;
        GAS unsigned* o8B = (GAS unsigned*)((unsigned char*)Ap + (size_t)rB * D) + F.lane;
        f32x2 pA[16], pB[16];
#pragma unroll
        for (int e = 0; e < 16; ++e) { pA[e] = (f32x2){0.f, 0.f}; pB[e] = (f32x2){0.f, 0.f}; }
#pragma unroll
        for (int j = 0; j < 4; ++j) {
            asm volatile("" ::: "memory");
            const f32x4 w = ((const GAS f32x4*)n2)[F.lane + 64 * j];
            const f32x4 aA = ((const GAS f32x4*)(modA + 4096))[F.lane + 64 * j], bA = ((const GAS f32x4*)(modA + 3072))[F.lane + 64 * j];
            const f32x4 aB = ((const GAS f32x4*)(modB + 4096))[F.lane + 64 * j], bB = ((const GAS f32x4*)(modB + 3072))[F.lane + 64 * j];
            const f32x4 yA = hA[j] * rsA * w * (1.0f + aA) + bA, yB = hB[j] * rsB * w * (1.0f + aB) + bB;
            o8A[64 * j] = (unsigned)cvt4_fp8(yA.x, yA.y, yA.z, yA.w);
            if (hasB) o8B[64 * j] = (unsigned)cvt4_fp8(yB.x, yB.y, yB.z, yB.w);
#pragma unroll
            for (int c = 0; c < 4; ++c) { const f32x2 fA = (f32x2){yA[c], yA[c]}, fB = (f32x2){yB[c], yB[c]}; const LAS float* wr_ = WL + ((c + 4 * j) * 64 + F.lane) * 36;
#pragma unroll
                for (int q = 0; q < 8; ++q) { const f32x4 w4 = *(const LAS f32x4*)(wr_ + 4 * q); const f32x2 wl = (f32x2){w4.x, w4.y}, wh = (f32x2){w4.z, w4.w};
                    pA[2 * q] += fA * wl; pA[2 * q + 1] += fA * wh; pB[2 * q] += fB * wl; pB[2 * q + 1] += fB * wh; }
                asm volatile("" : "+v"(pA[0]), "+v"(pA[1]), "+v"(pA[2]), "+v"(pA[3]), "+v"(pA[4]), "+v"(pA[5]), "+v"(pA[6]), "+v"(pA[7]), "+v"(pA[8]), "+v"(pA[9]), "+v"(pA[10]), "+v"(pA[11]), "+v"(pA[12]), "+v"(pA[13]), "+v"(pA[14]), "+v"(pA[15]) :: "memory");
                asm volatile("" : "+v"(pB[0]), "+v"(pB[1]), "+v"(pB[2]), "+v"(pB[3]), "+v"(pB[4]), "+v"(pB[5]), "+v"(pB[6]), "+v"(pB[7]), "+v"(pB[8]), "+v"(pB[9]), "+v"(pB[10]), "+v"(pB[11]), "+v"(pB[12]), "+v"(pB[13]), "+v"(pB[14]), "+v"(pB[15]) :: "memory");
                __builtin_amdgcn_sched_barrier(0); }
        }
        tok_finish(F, i, i0, rA, pA, rbias, prov, GATEp);
        if (hasB) tok_finish(F, iB, i0, rB, pB, rbias, prov, GATEp);
    }
    __syncthreads();
    int* POSp = F.POS(); int* LISTp = F.LIST();
    if (F.tid < 32) F.MISC[MW_BASE + F.tid] = __hip_atomic_fetch_add(F.ctl() + CW_CNT + (layer * 32 + F.tid) * 64, F.MISC[MW_LCNT + F.tid], RLX_AGENT);
    __syncthreads();
    if (RPB * 4 <= PROV_CAP)
    for (int idx = F.tid; idx < (i1 - i0) * 4; idx += 512) {
        const unsigned pv = prov[idx]; const int e = (int)(pv >> 16), slot = (int)(pv & 0xffffu) + (int)F.MISC[MW_BASE + e];
        const int r = tok_row(layer, i0 + (idx >> 2));
        POSp[(size_t)r * 4 + (idx & 3)] = (e << 16) | slot;
        LISTp[(size_t)e * LIST_CAP + slot] = r;
    }
    __syncthreads();
}
__device__ __forceinline__ void p_combine(Frame& F, int layer, bool tables) {
    if (tables) moe_tables(F, layer);
    __syncthreads();
    const int gw = F.vcu * NWAVES + F.wave, NGW = F.G * NWAVES, nrows = layer == 0 ? M : NB * SEQ;
    const float* MODp = F.MOD(); bf16* Hp = F.H(); const int* POSp = F.POS(); const float* GATEp = F.GATE(); const bf16* Yp = F.Y(); bf16* Ap = F.A(); float* outp = F.out();
    const float* n1w = F.norm1_w() + D; const float* fnw = F.final_norm_w();
    const int lane = F.lane;
#define CB_PG(i_, P_, G_) do { const int r_ = tok_row(layer, (i_)); _Pragma("unroll") for (int k = 0; k < 4; ++k) { P_[k] = POSp[(size_t)r_ * 4 + k]; G_[k] = GATEp[(size_t)r_ * 4 + k]; } } while (0)
#define CB_ISSUE(i_, P_, Y_, H_) do { const int r_ = tok_row(layer, (i_)); const GAS v2u* hq_ = (const GAS v2u*)(Hp + (size_t)r_ * D) + lane; \
        _Pragma("unroll") for (int j = 0; j < 4; ++j) H_[j] = hq_[64 * j]; \
        _Pragma("unroll") for (int k = 0; k < 4; ++k) { const int e_ = P_[k] >> 16, slot_ = P_[k] & 0xffff; const size_t prow_ = (size_t)F.MISC[MW_TST + e_] * 256 + slot_; \
            const GAS int* y8_ = (const GAS int*)((const unsigned char*)Yp + prow_ * D) + lane; \
            _Pragma("unroll") for (int j = 0; j < 4; ++j) Y_[k * 4 + j] = y8_[64 * j]; } } while (0)
#define CB_FINISH(i_, G_, Y_, H_) do { const int r_ = tok_row(layer, (i_)), v_ = row_v(r_); const float* mod_ = MODp + ((size_t)layer * 5 + v_) * 6144; \
        f32x4 h[4], acc[4]; \
        _Pragma("unroll") for (int j = 0; j < 4; ++j) { h[j] = (f32x4){bf2f(H_[j].x & 0xffffu), bf2f(H_[j].x >> 16), bf2f(H_[j].y & 0xffffu), bf2f(H_[j].y >> 16)}; acc[j] = (f32x4){0.f, 0.f, 0.f, 0.f}; } \
        _Pragma("unroll") for (int k = 0; k < 4; ++k) { const float g_ = G_[k]; \
            _Pragma("unroll") for (int j = 0; j < 4; ++j) { const int w_ = Y_[k * 4 + j]; acc[j].x += g_ * __builtin_amdgcn_cvt_f32_fp8(w_, 0); acc[j].y += g_ * __builtin_amdgcn_cvt_f32_fp8(w_, 1); \
                acc[j].z += g_ * __builtin_amdgcn_cvt_f32_fp8(w_, 2); acc[j].w += g_ * __builtin_amdgcn_cvt_f32_fp8(w_, 3); } } \
        _Pragma("unroll") for (int j = 0; j < 4; ++j) { const f32x4 g2 = ((const GAS f32x4*)(mod_ + 5120))[lane + 64 * j]; h[j] = h[j] + g2 * acc[j]; } \
        if (layer == 0) { bf16* hp_ = Hp + (size_t)r_ * D + lane * 4; \
            _Pragma("unroll") for (int j = 0; j < 4; ++j) st4bf(hp_ + 256 * j, h[j]); \
            const float* mod1 = MODp + ((size_t)5 + v_) * 6144; \
            norm_mod_row(h, n1w, mod1 + 1024, mod1, (bf16*)((unsigned char*)Ap + (size_t)r_ * D * (QKV1_FP8 ? 1 : 2)), lane, QKV1_FP8 != 0); \
        } else { float s_ = 0.f; \
            _Pragma("unroll") for (int j = 0; j < 4; ++j) s_ += (h[j].x * h[j].x + h[j].y * h[j].y) + (h[j].z * h[j].z + h[j].w * h[j].w); \
            const float rs_ = 1.0f / sqrtf(wave_sum(s_) * (1.0f / D) + EPS); \
            GAS f32x4* op_ = (GAS f32x4*)(outp + (size_t)(i_) * D) + lane; \
            _Pragma("unroll") for (int j = 0; j < 4; ++j) op_[64 * j] = h[j] * rs_ * ((const GAS f32x4*)fnw)[lane + 64 * j]; } } while (0)
    static_assert(Y_FP8, "the pipelined combine reads fp8 expert rows");
    int pA[4], pB[4]; float gA[4], gB[4], gC[4]; int yA[16], yB[16]; v2u hA[4], hB[4];
    int i = gw;
    if (i < nrows) { CB_PG(i, pA, gA); CB_ISSUE(i, pA, yA, hA); }
    if (i + NGW < nrows) CB_PG(i + NGW, pB, gB);
    for (; i < nrows; i += 2 * NGW) {
        const bool hasB = i + NGW < nrows, hasA2 = i + 2 * NGW < nrows, hasB2 = i + 3 * NGW < nrows;
        if (hasB) CB_ISSUE(i + NGW, pB, yB, hB);
        _Pragma("unroll") for (int k = 0; k < 4; ++k) gC[k] = gA[k];
        if (hasA2) CB_PG(i + 2 * NGW, pA, gA);
        CB_FINISH(i, gC, yA, hA);
        if (!hasB) break;
        if (hasA2) CB_ISSUE(i + 2 * NGW, pA, yA, hA);
        _Pragma("unroll") for (int k = 0; k < 4; ++k) gC[k] = gB[k];
        if (hasB2) CB_PG(i + 3 * NGW, pB, gB);
        CB_FINISH(i + NGW, gC, yB, hB);
    }
#undef CB_PG
#undef CB_ISSUE
#undef CB_FINISH
}

constexpr int N_PHASES = 21;
__global__ void __launch_bounds__(NWAVES * 64, 2) fwd(Args args) {
    extern __shared__ __attribute__((aligned(16))) unsigned char lds[];
    Frame F;
    F.lds = (LAS unsigned char*)lds;
    F.MISC = (volatile LAS unsigned*)(F.lds + MISC_OFF);
    F.tid = threadIdx.x; F.lane = F.tid & 63; F.wave = __builtin_amdgcn_readfirstlane(F.tid >> 6);
    F.G = gridDim.x; { const int bx = blockIdx.x; F.vcu = (F.G % 8 == 0) ? (bx % 8) * (F.G / 8) + bx / 8 : bx; }
    for (int u = F.tid; u < 256; u += NWAVES * 64) ((LAS unsigned*)(F.lds + MISC_OFF))[u] = 0u;
    __syncthreads();
    const int lo = args.ph_lo, hi = args.ph_hi;
    const bool one = (hi - lo) > 1;
    if (one) (void)xcd_barrier_post((unsigned*)(F.ctl() + CW_BAR), F.MISC + 8);
#define bar (XcdBarrier{(unsigned*)(F.ctl() + CW_BAR), xb_xcc_id(), F.MISC + 8, F.wave})
#ifndef PROBE_DUP
#define PROBE_DUP -1
#endif
#define IN(k) (phase_ids(F), (lo <= (k) && (k) < hi))
#define SEAM(k) do { if (IN(k) && IN((k) + 1)) xcd_barrier(bar); } while (0)

#define PH0_BODY p0_prologue(F);
    if (IN(0)) { PH0_BODY } if (PROBE_DUP == 0 && IN(0)) { PH0_BODY } SEAM(0);
    if (IN(1)) { p1_mod_reduce(F); } SEAM(1);
    if (IN(2)) { p_norm1(F, 0); } SEAM(2);
#define PH3_BODY    \
        DenseProb<EpiStoreBf16> P{F.A(), F.WIN(), D, MT, N_IN0 / 256, F.G, (int)blockIdx.x, false, EpiStoreBf16{F.QKV(), N_IN0, 1024, 1.0f, (ATTN_QK8 && ATTN_FP8PV && ATTN_FASTEXP) ? F.QK8() : nullptr, nullptr}}; \
        pg8::gemm_phase(F.lds, P, F.wave);
#define P0_BASE3  (p0i::NITEMS - p0i::deferred(F.G))
#define P0_BASE8  (P0_BASE3 + NWAVES * p0i::short_wgs(p0i::U3, F.G) * p0i::Q3)
#define P0_BASE13 (P0_BASE8 + NWAVES * p0i::short_wgs(p0i::U8, F.G) * p0i::Q8)
    if (IN(3)) { PH3_BODY p0_tail_items(F, p0i::U3, p0i::Q3, P0_BASE3); } if (PROBE_DUP == 3 && IN(3)) { PH3_BODY } if (IN(3) && IN(5)) xcd_barrier(bar);
#if ATTN_FASTEXP && ATTN_QK8
#define ATTN_CALL attn_dv::attn8<4, 1024, 512, false>(F.QK8() + ((size_t)b * RB + qb * 256) * 1024 + (2 * h + cc) * 64, F.QK8() + (size_t)b * RB * 1024 + 512 + (2 * h + cc) * 64, F.VT8() + (size_t)((b * 4 + h) * 128) * RB, \
                F.OD() + (size_t)cc * M * 512 + ((size_t)b * RB + qb * 256) * 512 + h * 128, (qb == 0 ? CTXL : RB) / 64, 0, 0, 0.f, (char*)lds, F.wave);
#define ATTN_BODY8 attn_dense_body8x
#elif ATTN_FASTEXP
#define ATTN_BODY8 attn_dense_body8x
#else
#define ATTN_BODY8 attn_dense_body8
#endif
#if ATTN_FP8PV && ATTN_FASTEXP && ATTN_QK8
#elif ATTN_FP8PV
#define ATTN_CALL attn_dv::ATTN_BODY8<N_IN0, 512>(base + (size_t)qb * 256 * N_IN0 + C_DQ + (2 * h + cc) * 64, base + C_DK + (2 * h + cc) * 64, F.VT8() + (size_t)((b * 4 + h) * 128) * RB, \
                F.OD() + (size_t)cc * M * 512 + ((size_t)b * RB + qb * 256) * 512 + h * 128, qb == 0 ? CTXL : RB, (char*)lds, F.wave);
#else
#define ATTN_CALL attn_dv::attn_dense_body<N_IN0, 512>(base + (size_t)qb * 256 * N_IN0 + C_DQ + (2 * h + cc) * 64, base + C_DK + (2 * h + cc) * 64, base + C_DV + h * 128, \
                F.OD() + (size_t)cc * M * 512 + ((size_t)b * RB + qb * 256) * 512 + h * 128, qb == 0 ? CTXL : RB, (char*)lds, F.wave);
#endif
    if (ATTN_FP8PV && IN(4)) { p_vt8<4, 128, N_IN0, C_DV>(F, F.VT8()); __syncthreads();
        if (RET_V2) { p_tr16<4, 128, C_RV>(F, F.RVT()); p_tr16<4, 64, C_RK>(F, F.RKT()); } else for (int it = blockIdx.x; it < NB * 4 * NCH; it += F.G) ret_kv_item(F, it); }
    if (ATTN_FP8PV && IN(4) && IN(5)) xcd_barrier(bar);
#define PH5_BODY    \
        for (int u = F.vcu; u < 5 * 256; u += F.G) {      \
            const int combo = (u & 255) >> 3, sub = (u & 7) + 8 * (u >> 8); \
            if (sub > 32) continue; \
            const int b = combo >> 3, h = (combo >> 1) & 3, cc = combo & 1; \
            const int qb = sub < 32 ? sub + 1 : 0;                                   \
            const bf16* base = F.QKV() + (size_t)b * RB * N_IN0; \
            ATTN_CALL \
        } \
        __syncthreads(); \
        if (!ATTN_FP8PV) for (int it = blockIdx.x; it < NB * 4 * NCH; it += F.G) ret_kv_item(F, it); \
        if (ATTN_FP8PV && RET_V2) for (int it = ((int)blockIdx.x + F.G - 8) % F.G; it < NB * 4 * NCH; it += F.G) ret_kv_item2(F, it);
    if (IN(5)) { PH5_BODY } if (PROBE_DUP == 5 && IN(5)) { PH5_BODY } SEAM(5);
#define PH6_BODY p_ret_scan(F);
    if (IN(6)) { PH6_BODY } if (PROBE_DUP == 6 && IN(6)) { PH6_BODY } SEAM(6);
#define PH7_BODY for (int it = blockIdx.x; it < NB * 4 * NCH; it += F.G) { if (RET_V2) ret_out_item2(F, it); else ret_out_item(F, it); } p_dfinish(F);
    if (IN(7)) { PH7_BODY } if (PROBE_DUP == 7 && IN(7)) { PH7_BODY } SEAM(7);
    if (IN(8)) {
        DenseProb<EpiResid, OUT_FP8 != 0> P{F.CAT(), F.WOUT0(), OUT_FP8 ? D / 2 : D, MT, D / 256, F.G, (int)blockIdx.x, false, EpiResid{F.H(), F.MOD(), 2048, F.x(), F.ctx(), OUT_FP8 ? W8_INV / OUT_ASC : 1.0f}};
        pg8::gemm_phase(F.lds, P, F.wave);
        p0_tail_items(F, p0i::U8, p0i::Q8, P0_BASE8);
    } SEAM(8);
    if (IN(9)) { p_token(F, 0); } SEAM(9);
#define PH10_BODY moe_tables(F, 0); Moe1Prob P{F.A(), F.W1T(), F.moe_b1(), F.LIST(), F.ACT(), F.MISC, D / 2, F.G, F.vcu}; pg8::gemm_phase(F.lds, P, F.wave);
    if (IN(10)) { PH10_BODY } if (PROBE_DUP == 10 && IN(10)) { PH10_BODY } SEAM(10);
#define PH11_BODY if (lo == 11) moe_tables(F, 0);     Moe2Prob P{F.ACT(), F.W2T(), F.moe_b2(), F.Y(), F.MISC, DFF / 2, F.G, F.vcu}; pg8::gemm_phase(F.lds, P, F.wave);
    if (IN(11)) { PH11_BODY } if (PROBE_DUP == 11 && IN(11)) { PH11_BODY } SEAM(11);
    if (IN(12)) { p_combine(F, 0, lo == 12); } SEAM(12);
#define PH13_BODY   \
        DenseProb<EpiStoreBf16, QKV1_FP8 != 0> P{F.A(), F.WQKV1(), QKV1_FP8 ? D / 2 : D, MT, N_QKV1 / 256, F.G, (int)blockIdx.x, false, EpiStoreBf16{F.QKV(), N_QKV1, 1152, QKV1_FP8 ? W8_INV : 1.0f, SWA_FP8 ? F.QK8() : nullptr, SWA_FP8 ? F.K81() : nullptr}}; \
        pg8::gemm_phase(F.lds, P, F.wave);
    if (IN(13)) { PH13_BODY p0_tail_items(F, p0i::U13, p0i::Q13, P0_BASE13); } if (PROBE_DUP == 13 && IN(13)) { PH13_BODY } if (IN(13) && IN(15)) xcd_barrier(bar);
#define PH15_BODY   \
        for (int u = F.vcu; u < NB * 2 * 32; u += F.G) {        \
            const int sub = u & 31, combo = u >> 5, b = combo >> 1, kv = combo & 1, qb = sub + 1; \
            int bs = 4 * qb - 2; if (bs < 4) bs = 4; int be = 4 * qb + 6; if (be > RB / 64) be = RB / 64; \
            attn_dv::attn_swa_grp(F.QK8() + ((size_t)b * RB + qb * 256) * 1024 + kv * 8 * 64, F.K81() + (size_t)b * RB * 128 + kv * 64, F.QKV() + (size_t)b * RB * N_QKV1 + C_V1 + kv * 64, \
                OUT_FP8 ? (bf16*)((unsigned char*)F.OD() + ((size_t)b * RB + qb * 256) * D + kv * 8 * 64) : F.OD() + ((size_t)b * RB + qb * 256) * D + kv * 8 * 64, F.sinks() + kv * 8, 4 + (be - bs), bs - 4, qb * 256, (char*)lds, F.wave); \
        } \
        __syncthreads();
    if (IN(15)) { PH15_BODY } if (PROBE_DUP == 15 && IN(15)) { PH15_BODY } SEAM(15);
    if (IN(16)) {
        DenseProb<EpiResid, OUT_FP8 != 0> P{F.OD(), F.WOUT1(), OUT_FP8 ? D / 2 : D, NB * 32, D / 256, F.G, (int)blockIdx.x, true, EpiResid{F.H(), F.MOD() + 5 * 6144, 2048, nullptr, nullptr, OUT_FP8 ? W8_INV / OUT_ASC : 1.0f}};
        pg8::gemm_phase(F.lds, P, F.wave);
    } SEAM(16);
    if (IN(17)) { p_token(F, 1); } SEAM(17);
#define PH18_BODY moe_tables(F, 1); Moe1Prob P{F.A(), F.W1T() + (size_t)NEXP * 2048 * D / 2, F.moe_b1() + NEXP * 2048, F.LIST(), F.ACT(), F.MISC, D / 2, F.G, F.vcu}; pg8::gemm_phase(F.lds, P, F.wave);
    if (IN(18)) { PH18_BODY } if (PROBE_DUP == 18 && IN(18)) { PH18_BODY } SEAM(18);
#define PH19_BODY if (lo == 19) moe_tables(F, 1); Moe2Prob P{F.ACT(), F.W2T() + (size_t)NEXP * D * DFF / 2, F.moe_b2() + NEXP * D, F.Y(), F.MISC, DFF / 2, F.G, F.vcu}; pg8::gemm_phase(F.lds, P, F.wave);
    if (IN(19)) { PH19_BODY } if (PROBE_DUP == 19 && IN(19)) { PH19_BODY } SEAM(19);
#define PH20_BODY p_combine(F, 1, lo == 20);
    if (IN(20)) { PH20_BODY } if (PROBE_DUP == 20 && IN(20)) { PH20_BODY }
#undef IN
#undef SEAM
}

extern "C" void kernel_launch(void* const* d_in, const int* in_sizes, int n_in, void* d_out, int out_size, void* d_ws, size_t ws_size, hipStream_t stream) {
    static int grid = 0;
    if (grid == 0) {
        if (n_in != 24 || in_sizes[0] != NB * SEQ * D || out_size != NB * SEQ * D || ws_size < WS_END) {
            fprintf(stderr, "kernel_launch: unexpected shapes (n_in %d, in0 %d, out %d, ws %zu, need %zu); nothing launched\n", n_in, n_in > 0 ? in_sizes[0] : -1, out_size, ws_size, (size_t)WS_END); grid = -1; return; }
        int dev = 0, cus = 0, per_cu = 0;
        if (hipGetDevice(&dev) != hipSuccess || hipDeviceGetAttribute(&cus, hipDeviceAttributeMultiprocessorCount, dev) != hipSuccess) { grid = -1; return; }
        if (hipFuncSetAttribute((const void*)fwd, hipFuncAttributeMaxDynamicSharedMemorySize, LDS_TOTAL) != hipSuccess) { fprintf(stderr, "kernel_launch: hipFuncSetAttribute failed\n"); grid = -1; return; }
        if (hipOccupancyMaxActiveBlocksPerMultiprocessor(&per_cu, (const void*)fwd, NWAVES * 64, LDS_TOTAL) != hipSuccess || per_cu < 1)
            fprintf(stderr, "kernel_launch: note: occupancy query reports %d workgroups per CU\n", per_cu);
        (void)hipGetLastError();
        grid = cus;
    }
    if (grid < 0) return;
    if (hipMemsetAsync((char*)d_ws + WS_CTL, 0, CTL_ZERO_BYTES, stream) != hipSuccess) return;
    Args a{};
    for (int i = 0; i < 24; ++i) a.in[i] = (const float*)d_in[i];
    a.out = (float*)d_out; a.ws = (unsigned char*)d_ws;
#if MK_ONE_LAUNCH
    a.ph_lo = 0; a.ph_hi = N_PHASES;
    hipLaunchKernelGGL(fwd, dim3(grid), dim3(NWAVES * 64), LDS_TOTAL, stream, a);
#else
    for (int p = 0; p < N_PHASES; ++p) { a.ph_lo = p; a.ph_hi = p + 1; hipLaunchKernelGGL(fwd, dim3(grid), dim3(NWAVES * 64), LDS_TOTAL, stream, a); }
#endif
}
```
